# Optimizing an MI355X kernel written in HIP

```python
import jax, jax.numpy as jnp
from jax import lax
import numpy as np

D_MODEL = 1024
BATCH = 8
SEQ = 2048
DEPTH = 4
DEC_BATCH = 128
DEC_SEQ = 1
PAST_LEN = 16384
PAGE_SIZE = 128

HEAD_DIM = 64
C_RWKV = 3 * D_MODEL // 8
C_HGRN = 3 * D_MODEL // 8
C_LRU = D_MODEL - C_RWKV - C_HGRN
D_MIX = C_RWKV + C_HGRN + C_LRU
RWKV_HEADS = C_RWKV // HEAD_DIM
HGRN_HEADS = C_HGRN // HEAD_DIM
HGRN_KDIM = 64
HGRN_FDIM = HGRN_HEADS * HGRN_KDIM
HGRN_CHUNK = 64
LRU_BLOCKS = 4
LRU_BLOCK = C_LRU // LRU_BLOCKS
CONV_WIDTH = 4
LRU_C = 8.0
W_LORA = 64
A_LORA = 64
G_LORA = 128
RWKV_COLS = 3 * C_RWKV + W_LORA + A_LORA + G_LORA
HGRN_COLS = 2 * HGRN_FDIM + 2 * C_HGRN
LRU_COLS = 2 * C_LRU
C_IN = RWKV_COLS + HGRN_COLS + LRU_COLS
D_FF = 4 * D_MODEL
NORM_EPS = 1e-6
GN_EPS = 64e-5

kernel_name = 'hybrid_rwkv7_hgrn2_rglru_decode_step'

F32 = jnp.float32


def _rmsnorm(x, g):
    xf = x.astype(F32)
    return (xf * lax.rsqrt(jnp.mean(xf * xf, -1, keepdims=True) + NORM_EPS) * g).astype(x.dtype)


def _rwkv7(pm, S0, w0, w_up, a0, a_up, g_up, k_k, k_a, r_k, ln_w, ln_b):
    B, T, _ = pm.shape
    H, N, c = RWKV_HEADS, HEAD_DIM, C_RWKV
    r, k, v, xw, xa, xg = jnp.split(pm, [c, 2 * c, 3 * c, 3 * c + W_LORA, 3 * c + W_LORA + A_LORA], axis=-1)
    w_log = -jax.nn.softplus(-(w0 + jnp.tanh(xw) @ w_up)) - 0.5
    decay = jnp.exp(-jnp.exp(w_log))
    a = jax.nn.sigmoid(a0 + xa @ a_up)
    g = jax.nn.sigmoid(xg) @ g_up
    hd = lambda t: t.reshape(B, T, H, N)
    kk = hd(k * k_k)
    kk = kk * lax.rsqrt(jnp.maximum(jnp.sum(kk * kk, -1, keepdims=True), 1e-24))
    k = k * (1.0 + (a - 1.0) * k_a)
    r_h, k_h, v_h, a_h, w_h = hd(r), hd(k), hd(v), hd(a), hd(decay)

    def step(S, inp):
        rt, wt, kt, vt, kkt, at = inp
        sa = jnp.einsum('bhvk,bhk->bhv', S, -kkt)
        S = S * wt[:, :, None, :] + sa[..., None] * (kkt * at)[:, :, None, :] + vt[..., None] * kt[:, :, None, :]
        return S, jnp.einsum('bhvk,bhk->bhv', S, rt)

    tm = lambda t: jnp.moveaxis(t, 1, 0)
    S_T, out = lax.scan(step, S0, (tm(r_h), tm(w_h), tm(k_h), tm(v_h), tm(kk), tm(a_h)))
    out = jnp.moveaxis(out, 0, 1)
    mean = jnp.mean(out, -1, keepdims=True)
    var = jnp.mean(jnp.square(out - mean), -1, keepdims=True)
    gn = ((out - mean) * lax.rsqrt(var + GN_EPS)).reshape(B, T, c) * ln_w + ln_b
    bonus = (jnp.sum(r_h * k_h * r_k, -1, keepdims=True) * v_h).reshape(B, T, c)
    return (gn + bonus) * g, S_T


def _hgrn2(ph, S0, lb, norm_g):
    B, T, _ = ph.shape
    H, K, V = HGRN_HEADS, HGRN_KDIM, HEAD_DIM
    q, fpre, iv, g = jnp.split(ph, [HGRN_FDIM, 2 * HGRN_FDIM, 2 * HGRN_FDIM + C_HGRN], axis=-1)
    f = lb + (1.0 - lb) * jax.nn.sigmoid(fpre)
    logf = jnp.log(f)
    kin = (1.0 - lb) * jax.nn.sigmoid(-fpre)
    C = HGRN_CHUNK if T % HGRN_CHUNK == 0 else T
    nC = T // C
    ch = lambda t, d: jnp.moveaxis(t.reshape(B, nC, C, H, d), 1, 0)
    causal = jnp.tril(jnp.ones((C, C), bool))[None, :, :, None, None]

    def chunk_step(S, inp):
        qc, kc, vc, lc = inp
        b = jnp.cumsum(lc, axis=1)
        diff = jnp.where(causal, b[:, :, None] - b[:, None, :], 0.0)
        dmat = jnp.where(causal, jnp.exp(diff), 0.0)
        att = jnp.einsum('bthk,bshk,btshk->bhts', qc, kc, dmat)
        o = jnp.einsum('bhts,bshv->bthv', att, vc) + jnp.einsum('bthk,bhkv->bthv', qc * jnp.exp(b), S)
        b_last = b[:, -1]
        S = jnp.exp(b_last)[..., None] * S + jnp.einsum('bshk,bshv->bhkv', kc * jnp.exp(b_last[:, None] - b), vc)
        return S, o

    S_T, o = lax.scan(chunk_step, S0, (ch(q, K), ch(kin, K), ch(iv, V), ch(logf, K)))
    o = jnp.moveaxis(o, 0, 1).reshape(B, T, H, V)
    o = o * lax.rsqrt(jnp.mean(o * o, -1, keepdims=True) + NORM_EPS)
    return o.reshape(B, T, C_HGRN) * norm_g * jax.nn.silu(g), S_T


def _combine(c1, c2):
    a1, b1 = c1
    a2, b2 = c2
    return a1 * a2, a2 * b1 + b2


def _rglru(pl, h0, conv0, conv_w, conv_b, wa, ba, wx, bx, lam):
    B, T, _ = pl.shape
    xb, gate = jnp.split(pl, [C_LRU], axis=-1)
    xpad = jnp.concatenate([conv0, xb], axis=1)
    xc = conv_b + sum(xpad[:, j:j + T] * conv_w[j] for j in range(CONV_WIDTH))
    new_conv = xpad[:, T:]
    xh = xc.reshape(B, T, LRU_BLOCKS, LRU_BLOCK)
    r = jax.nn.sigmoid(jnp.einsum('btnc,ncd->btnd', xh, wa).reshape(B, T, C_LRU) + ba)
    i = jax.nn.sigmoid(jnp.einsum('btnc,ncd->btnd', xh, wx).reshape(B, T, C_LRU) + bx)
    log_a = -LRU_C * r * jax.nn.softplus(-lam)
    a = jnp.exp(log_a)
    u = xc * i * jnp.sqrt(jnp.maximum(-jnp.expm1(2.0 * log_a), 1e-12))
    u = u.at[:, 0].add(a[:, 0] * h0)
    _, h = lax.associative_scan(_combine, (a, u), axis=1)
    return h * jax.nn.gelu(gate), h[:, -1], new_conv


def _trunk(x, wkv, shift, hgrn, lru, conv, prm):
    dt = x.dtype
    s = jax.nn.softmax(prm['hgrn_lb'].astype(F32), axis=0)
    lb_all = jnp.cumsum(s, axis=0) - s[0:1]
    n_wkv, n_shift, n_hgrn, n_lru, n_conv = [], [], [], [], []
    for l in range(DEPTH):
        xn = _rmsnorm(x, prm['norm1_g'][l])
        w_in = prm['w_in'][l]
        P = (xn @ w_in).astype(F32)
        pr, ph, pl = jnp.split(P, [RWKV_COLS, RWKV_COLS + HGRN_COLS], axis=-1)
        p0 = (shift[l].astype(dt) @ w_in[:, :RWKV_COLS]).astype(F32)
        pr_prev = jnp.concatenate([p0[:, None], pr[:, :-1]], axis=1)
        pm = pr + prm['mu_shift'][l] * (pr_prev - pr)
        o_r, S_r = _rwkv7(pm, wkv[l].astype(F32), prm['rwkv_w0'][l], prm['rwkv_w_up'][l], prm['rwkv_a0'][l],
                          prm['rwkv_a_up'][l], prm['rwkv_g_up'][l], prm['rwkv_k_k'][l], prm['rwkv_k_a'][l],
                          prm['rwkv_r_k'][l], prm['rwkv_ln_w'][l], prm['rwkv_ln_b'][l])
        o_h, S_h = _hgrn2(ph, hgrn[l].astype(F32), lb_all[l], prm['hgrn_norm_g'][l])
        o_l, h_l, c_l = _rglru(pl, lru[l].astype(F32), conv[l].astype(F32), prm['lru_conv_w'][l],
                               prm['lru_conv_b'][l], prm['lru_wa'][l], prm['lru_ba'][l], prm['lru_wx'][l],
                               prm['lru_bx'][l], prm['lru_lambda'][l])
        mix = jnp.concatenate([o_r, o_h, o_l], axis=-1).astype(dt)
        x = x + mix @ prm['w_out'][l]
        xn2 = _rmsnorm(x, prm['norm2_g'][l])
        x = x + jnp.square(jax.nn.relu(xn2 @ prm['mlp_w1'][l])) @ prm['mlp_w2'][l]
        n_wkv.append(S_r.astype(dt)); n_shift.append(xn[:, -1]); n_hgrn.append(S_h.astype(dt))
        n_lru.append(h_l.astype(dt)); n_conv.append(c_l.astype(dt))
    y = _rmsnorm(x, prm['final_g'])
    return (y, jnp.stack(n_wkv), jnp.stack(n_shift), jnp.stack(n_hgrn), jnp.stack(n_lru), jnp.stack(n_conv))


def setup_inputs(seed: int = 0) -> dict:
    key = jax.random.key(seed)
    ks = jax.random.split(key, 40)
    nrm = lambda i, shape, sc: jax.random.normal(ks[i], shape, F32) * sc
    u = jax.random.uniform(ks[30], (DEPTH, C_LRU), F32, 0.9, 0.999) ** (1.0 / LRU_C)
    return {
        'x_prompt': nrm(0, (BATCH, SEQ, D_MODEL), 1.0),
        'x_sample': nrm(1, (DEC_BATCH, DEC_SEQ, D_MODEL), 1.0),
        'state_wkv': nrm(2, (DEPTH, DEC_BATCH, RWKV_HEADS, HEAD_DIM, HEAD_DIM), 0.3),
        'state_shift': nrm(3, (DEPTH, DEC_BATCH, D_MODEL), 1.0),
        'state_hgrn': nrm(4, (DEPTH, DEC_BATCH, HGRN_HEADS, HGRN_KDIM, HEAD_DIM), 0.3),
        'state_lru': nrm(5, (DEPTH, DEC_BATCH, C_LRU), 0.5),
        'state_conv': nrm(6, (DEPTH, DEC_BATCH, CONV_WIDTH - 1, C_LRU), 1.0),
        'norm1_g': 1.0 + nrm(7, (DEPTH, D_MODEL), 0.02),
        'w_in': nrm(8, (DEPTH, D_MODEL, C_IN), D_MODEL ** -0.5),
        'mu_shift': jax.random.uniform(ks[9], (DEPTH, RWKV_COLS), F32),
        'rwkv_w0': jax.random.uniform(ks[10], (DEPTH, C_RWKV), F32, -6.0, -1.0),
        'rwkv_w_up': nrm(11, (DEPTH, W_LORA, C_RWKV), 0.5 * W_LORA ** -0.5),
        'rwkv_a0': nrm(12, (DEPTH, C_RWKV), 0.1),
        'rwkv_a_up': nrm(13, (DEPTH, A_LORA, C_RWKV), 0.5 * A_LORA ** -0.5),
        'rwkv_g_up': nrm(14, (DEPTH, G_LORA, C_RWKV), G_LORA ** -0.5),
        'rwkv_k_k': 0.85 + nrm(15, (DEPTH, C_RWKV), 0.02),
        'rwkv_k_a': 1.0 + nrm(16, (DEPTH, C_RWKV), 0.02),
        'rwkv_r_k': nrm(17, (DEPTH, RWKV_HEADS, HEAD_DIM), 0.1),
        'rwkv_ln_w': 1.0 + nrm(18, (DEPTH, C_RWKV), 0.02),
        'rwkv_ln_b': nrm(19, (DEPTH, C_RWKV), 0.01),
        'hgrn_lb': nrm(20, (DEPTH, HGRN_FDIM), 0.1),
        'hgrn_norm_g': 1.0 + nrm(21, (DEPTH, C_HGRN), 0.02),
        'lru_conv_w': nrm(22, (DEPTH, CONV_WIDTH, C_LRU), CONV_WIDTH ** -0.5),
        'lru_conv_b': nrm(23, (DEPTH, C_LRU), 0.01),
        'lru_wa': nrm(24, (DEPTH, LRU_BLOCKS, LRU_BLOCK, LRU_BLOCK), LRU_BLOCK ** -0.5),
        'lru_ba': nrm(25, (DEPTH, C_LRU), 0.01),
        'lru_wx': nrm(26, (DEPTH, LRU_BLOCKS, LRU_BLOCK, LRU_BLOCK), LRU_BLOCK ** -0.5),
        'lru_bx': nrm(27, (DEPTH, C_LRU), 0.01),
        'lru_lambda': jnp.log(u) - jnp.log1p(-u),
        'w_out': nrm(28, (DEPTH, D_MIX, D_MODEL), D_MIX ** -0.5),
        'norm2_g': 1.0 + nrm(29, (DEPTH, D_MODEL), 0.02),
        'mlp_w1': nrm(31, (DEPTH, D_MODEL, D_FF), D_MODEL ** -0.5),
        'mlp_w2': nrm(32, (DEPTH, D_FF, D_MODEL), D_FF ** -0.5),
        'final_g': 1.0 + nrm(33, (D_MODEL,), 0.02),
    }


def reference(x_prompt, x_sample, state_wkv, state_shift, state_hgrn, state_lru, state_conv,
              norm1_g, w_in, mu_shift, rwkv_w0, rwkv_w_up, rwkv_a0, rwkv_a_up, rwkv_g_up, rwkv_k_k,
              rwkv_k_a, rwkv_r_k, rwkv_ln_w, rwkv_ln_b, hgrn_lb, hgrn_norm_g, lru_conv_w, lru_conv_b,
              lru_wa, lru_ba, lru_wx, lru_bx, lru_lambda, w_out, norm2_g, mlp_w1, mlp_w2, final_g):
    prm = dict(norm1_g=norm1_g, w_in=w_in, mu_shift=mu_shift, rwkv_w0=rwkv_w0, rwkv_w_up=rwkv_w_up,
               rwkv_a0=rwkv_a0, rwkv_a_up=rwkv_a_up, rwkv_g_up=rwkv_g_up, rwkv_k_k=rwkv_k_k,
               rwkv_k_a=rwkv_k_a, rwkv_r_k=rwkv_r_k, rwkv_ln_w=rwkv_ln_w, rwkv_ln_b=rwkv_ln_b,
               hgrn_lb=hgrn_lb, hgrn_norm_g=hgrn_norm_g, lru_conv_w=lru_conv_w, lru_conv_b=lru_conv_b,
               lru_wa=lru_wa, lru_ba=lru_ba, lru_wx=lru_wx, lru_bx=lru_bx, lru_lambda=lru_lambda,
               w_out=w_out, norm2_g=norm2_g, mlp_w1=mlp_w1, mlp_w2=mlp_w2, final_g=final_g)
    Bp, dt = x_prompt.shape[0], x_prompt.dtype
    z_wkv = jnp.zeros((DEPTH, Bp, RWKV_HEADS, HEAD_DIM, HEAD_DIM), dt)
    z_shift = jnp.zeros((DEPTH, Bp, D_MODEL), dt)
    z_hgrn = jnp.zeros((DEPTH, Bp, HGRN_HEADS, HGRN_KDIM, HEAD_DIM), dt)
    z_lru = jnp.zeros((DEPTH, Bp, C_LRU), dt)
    z_conv = jnp.zeros((DEPTH, Bp, CONV_WIDTH - 1, C_LRU), dt)
    y_prompt, p_wkv, p_shift, p_hgrn, p_lru, p_conv = _trunk(x_prompt, z_wkv, z_shift, z_hgrn, z_lru, z_conv, prm)
    y_sample, s_wkv, s_shift, s_hgrn, s_lru, s_conv = _trunk(x_sample, state_wkv, state_shift, state_hgrn,
                                                             state_lru, state_conv, prm)
    return (y_prompt, y_sample, p_wkv, p_shift, p_hgrn, p_lru, p_conv, s_wkv, s_shift, s_hgrn, s_lru, s_conv)
```

```cpp
#define ONLY_OLD 1
#include <hip/hip_runtime.h>
#include <hip/hip_cooperative_groups.h>
#include <cstdio>
#include <cstdint>
namespace cg = cooperative_groups;
namespace pg8 {
#define PG8_LAS __attribute__((address_space(3)))
typedef unsigned short bf16_t;
typedef short bf16x8 __attribute__((ext_vector_type(8)));
typedef float f32x4 __attribute__((ext_vector_type(4)));
typedef unsigned u32x4 __attribute__((ext_vector_type(4)));
constexpr int BM = 256, BK = 64, HALF = 128, HTB = HALF * BK * 2  , STAGE_BYTES = 8 * HTB, NXCD = 8, WGM = 8;

__host__ __device__ __forceinline__ int lds_byte(int r, int c) { const int st = (r >> 4) * 2 + (c >> 5), rr = r & 15, cc = c & 31, ob = rr * 64 + cc * 2; return st * 1024 + (ob ^ (((ob >> 9) & 1) << 5)); }
__host__ __device__ __forceinline__ void stage_rc(int b, int& R, int& C) { const int st = b / 1024, sb = b % 1024, swz = sb ^ (((sb >> 9) & 1) << 5); R = (st >> 1) * 16 + swz / 64; C = (st & 1) * 32 + (swz % 64) / 2; }
__host__ __device__ __forceinline__ int perm32(int rho) { const int n = rho >> 4, i = rho & 15; return 8 * (i >> 2) + 4 * n + (i & 3); }

struct Unit { int pm, pn; };
struct Gemm { const bf16_t* A; const bf16_t* Bt; int M, N, K; int ld = 0; };

struct StaticOrder {
    int nM, nN, nwg, G, c;
    __host__ __device__ void init(int M, int N, int G_, int c_) { nM = M / BM; nN = N / BM; nwg = nM * nN; G = G_; c = c_; }
    __host__ __device__ bool next(int i, Unit& u) const {
        const long L = (long)i * G + c; if (L >= nwg) return false;
        int wgid = (int)L; { const int q = nwg / NXCD, r = nwg % NXCD, xcd = wgid % NXCD, off = wgid / NXCD; wgid = (xcd < r ? xcd * (q + 1) : r * (q + 1) + (xcd - r) * q) + off; }
        const int nig = WGM * nN, gid = wgid / nig, fm = gid * WGM, gsz = (nM - fm) < WGM ? (nM - fm) : WGM;
        u.pm = fm + ((wgid % nig) % gsz); u.pn = (wgid % nig) / gsz; return true;
    }
    __device__ __forceinline__ void a_ready(const Unit&) const {}
    __device__ __forceinline__ void done(const Unit&) const {}
};

__device__ __forceinline__ unsigned cvt_pk_bf16(float lo, float hi) { unsigned r; asm volatile("v_cvt_pk_bf16_f32 %0, %1, %2" : "=v"(r) : "v"(lo), "v"(hi)); return r; }
typedef float f32x2 __attribute__((ext_vector_type(2)));
template <class Epi, class Sched, bool ALIGN_EPI = false, bool SP2 = false, int HALF_PM = -1>
__device__ __forceinline__ void gemm_phase(PG8_LAS unsigned char* lds, const Gemm g, const Sched& S, const Epi& E) {
    int tid_ = threadIdx.x; asm volatile("" : "+v"(tid_)); const int tid = tid_, wid = __builtin_amdgcn_readfirstlane(tid >> 6), lane = tid & 63, wr = wid >> 2, wc = wid & 3, fr = lane & 15, fq = lane >> 4;
    const int K = g.K, nt = K / BK, LD = g.ld ? g.ld : g.K;
    unsigned voffA[2], voffB[2];
#pragma unroll
    for (int i = 0; i < 2; ++i) { int R, C; stage_rc(tid * 16 + i * 8192, R, C); const int Rb = Epi::PERM ? ((R & ~31) + perm32(R & 31)) : R;
        voffA[i] = (unsigned)(R * LD + C) * 2u; voffB[i] = (unsigned)(Rb * LD + C) * 2u; }
    const size_t kstep = (size_t)(BK * 2);
    const size_t hstep = (size_t)HALF * LD * 2;
    const size_t tstep = 2 * hstep;
    const unsigned ldsw = (unsigned)wid * 1024u;
    const int aoff = lds_byte(wr * 64 + fr, fq * 8), boff = lds_byte(wc * 32 + fr, fq * 8);
#define PG8_SA(b, h) (((b) * 2 + (h)) * HTB)
#define PG8_SB(b, h) ((4 + (b) * 2 + (h)) * HTB)
#define PG8_STAGE(bufoff, gbase, voff) do { _Pragma("unroll") for (int _i = 0; _i < 2; ++_i) \
        __builtin_amdgcn_global_load_lds((const unsigned*)((const char*)(gbase) + (voff)[_i]), (PG8_LAS unsigned*)(lds + (bufoff) + ldsw + _i * 8192), 16, 0, 0); } while (0)
#define PG8_LDA(dst, b, h) do { _Pragma("unroll") for (int m = 0; m < 4; ++m) _Pragma("unroll") for (int k = 0; k < 2; ++k) dst[m][k] = *(const PG8_LAS bf16x8*)(lds + PG8_SA(b, h) + aoff + m * 2048 + k * 1024); } while (0)
#define PG8_LDB(dst, b, h) do { _Pragma("unroll") for (int n = 0; n < 2; ++n) _Pragma("unroll") for (int k = 0; k < 2; ++k) dst[n][k] = *(const PG8_LAS bf16x8*)(lds + PG8_SB(b, h) + boff + n * 2048 + k * 1024); } while (0)
#define PG8_MMA(ai, bj, At, Bt) do { __builtin_amdgcn_s_setprio(1); _Pragma("unroll") for (int m = 0; m < 4; ++m) _Pragma("unroll") for (int n = 0; n < 2; ++n) _Pragma("unroll") for (int k = 0; k < 2; ++k) \
        acc[ai][bj][m][n] = __builtin_amdgcn_mfma_f32_16x16x32_bf16(Bt[n][k], At[m][k], acc[ai][bj][m][n], 0, 0, 0); __builtin_amdgcn_s_setprio(0); } while (0)
#define PG8_WAIT_V(n) asm volatile("s_waitcnt vmcnt(" #n ")" ::: "memory")
#define PG8_WAIT_L(n) asm volatile("s_waitcnt lgkmcnt(" #n ")" ::: "memory")
#define PG8_BAR __builtin_amdgcn_s_barrier()
#define PG8_SCHED __builtin_amdgcn_sched_barrier(0)
    Unit cur, nxt; int ui = 0;
    if (!S.next(0, cur)) return;
    f32x4 acc[2][2][4][2];
#pragma unroll
    for (int a = 0; a < 2; ++a)
#pragma unroll
        for (int b = 0; b < 2; ++b)
#pragma unroll
            for (int m = 0; m < 4; ++m)
#pragma unroll
                for (int n = 0; n < 2; ++n) acc[a][b][m][n] = (f32x4){0.f, 0.f, 0.f, 0.f};
    bf16x8 At[4][2], B0[2][2], B1[2][2];
    const char* cA = (const char*)g.A + (size_t)cur.pm * tstep; const char* cB = (const char*)g.Bt + (size_t)cur.pn * tstep;
    S.a_ready(cur);
    if constexpr (SP2) {
        PG8_STAGE(PG8_SB(0, 0), cB, voffB); PG8_STAGE(PG8_SB(0, 1), cB + hstep, voffB); PG8_STAGE(PG8_SA(0, 0), cA, voffA); PG8_STAGE(PG8_SA(0, 1), cA + hstep, voffA);
        if (wr == 1) PG8_BAR;
        PG8_WAIT_V(2); PG8_BAR;
        PG8_STAGE(PG8_SB(1, 0), cB + kstep, voffB); PG8_STAGE(PG8_SA(1, 0), cA + kstep, voffA); PG8_STAGE(PG8_SB(1, 1), cB + hstep + kstep, voffB);
        PG8_WAIT_V(6); PG8_BAR;
    } else {
        PG8_STAGE(PG8_SB(0, 0), cB, voffB); PG8_STAGE(PG8_SA(0, 0), cA, voffA); PG8_STAGE(PG8_SB(0, 1), cB + hstep, voffB); PG8_STAGE(PG8_SA(0, 1), cA + hstep, voffA);
        if (wr == 1) PG8_BAR;
        PG8_WAIT_V(4); PG8_BAR;
        PG8_STAGE(PG8_SB(1, 0), cB + kstep, voffB); PG8_STAGE(PG8_SA(1, 0), cA + kstep, voffA); PG8_STAGE(PG8_SB(1, 1), cB + hstep + kstep, voffB);
        PG8_WAIT_V(6); PG8_BAR;
    }
    for (;;) {
        const bool has_next = S.next(ui + 1, nxt);
        const char* nA = has_next ? (const char*)g.A + (size_t)nxt.pm * tstep : cA; const char* nB = has_next ? (const char*)g.Bt + (size_t)nxt.pn * tstep : cB;
        for (int t = 0; t < nt; t += 2) {
            const bool last = (t == nt - 2);
            const char* a1 = cA + (size_t)(t + 1) * kstep;
            const char* a2 = last ? nA : cA + (size_t)(t + 2) * kstep; const char* b2 = last ? nB : cB + (size_t)(t + 2) * kstep;
            const char* a3 = a2 + kstep; const char* b3 = b2 + kstep;
            if (last && has_next) S.a_ready(nxt);
            if constexpr (SP2) {
            PG8_LDB(B0, 0, 0); PG8_LDB(B1, 0, 1); PG8_SCHED; PG8_LDA(At, 0, 0); PG8_STAGE(PG8_SA(1, 1), a1 + hstep, voffA);
            PG8_WAIT_V(8); PG8_WAIT_L(0); PG8_BAR; PG8_MMA(0, 0, At, B0); PG8_MMA(0, 1, At, B1); PG8_BAR; PG8_SCHED;
            PG8_LDA(At, 0, 1); PG8_STAGE(PG8_SB(0, 0), b2, voffB); PG8_STAGE(PG8_SB(0, 1), b2 + hstep, voffB); PG8_STAGE(PG8_SA(0, 0), a2, voffA);
            PG8_WAIT_V(8); PG8_WAIT_L(0); PG8_BAR; if (cur.pm != HALF_PM) { PG8_MMA(1, 0, At, B0); PG8_MMA(1, 1, At, B1); } PG8_BAR; PG8_SCHED;
            PG8_LDB(B0, 1, 0); PG8_LDB(B1, 1, 1); PG8_SCHED; PG8_LDA(At, 1, 0); PG8_STAGE(PG8_SA(0, 1), a2 + hstep, voffA);
            PG8_WAIT_V(8); PG8_WAIT_L(0); PG8_BAR; PG8_MMA(0, 0, At, B0); PG8_MMA(0, 1, At, B1); PG8_BAR; PG8_SCHED;
            PG8_LDA(At, 1, 1); PG8_STAGE(PG8_SB(1, 0), b3, voffB); PG8_STAGE(PG8_SB(1, 1), b3 + hstep, voffB); PG8_STAGE(PG8_SA(1, 0), a3, voffA);
            PG8_WAIT_V(8); PG8_WAIT_L(0); PG8_BAR; if (cur.pm != HALF_PM) { PG8_MMA(1, 0, At, B0); PG8_MMA(1, 1, At, B1); } PG8_BAR; PG8_SCHED;
            } else {
            PG8_LDB(B0, 0, 0); PG8_SCHED; PG8_LDA(At, 0, 0); PG8_STAGE(PG8_SA(1, 1), a1 + hstep, voffA);
            PG8_WAIT_L(8); PG8_BAR; PG8_WAIT_L(0); PG8_MMA(0, 0, At, B0); PG8_BAR; PG8_SCHED;
            PG8_LDB(B1, 0, 1); PG8_STAGE(PG8_SB(0, 0), b2, voffB);
            PG8_BAR; PG8_WAIT_L(0); PG8_MMA(0, 1, At, B1); PG8_BAR;
            PG8_LDA(At, 0, 1); PG8_STAGE(PG8_SA(0, 0), a2, voffA);
            PG8_BAR; PG8_WAIT_L(0); PG8_MMA(1, 0, At, B0); PG8_BAR; PG8_SCHED;
            PG8_STAGE(PG8_SB(0, 1), b2 + hstep, voffB);
            PG8_WAIT_V(6); PG8_BAR; PG8_MMA(1, 1, At, B1); PG8_BAR;
            PG8_LDB(B0, 1, 0); PG8_SCHED; PG8_LDA(At, 1, 0); PG8_STAGE(PG8_SA(0, 1), a2 + hstep, voffA);
            PG8_WAIT_L(8); PG8_BAR; PG8_WAIT_L(0); PG8_MMA(0, 0, At, B0); PG8_BAR; PG8_SCHED;
            PG8_LDB(B1, 1, 1); PG8_STAGE(PG8_SB(1, 0), b3, voffB);
            PG8_BAR; PG8_WAIT_L(0); PG8_MMA(0, 1, At, B1); PG8_BAR;
            PG8_LDA(At, 1, 1); PG8_STAGE(PG8_SA(1, 0), a3, voffA);
            PG8_BAR; PG8_WAIT_L(0); PG8_MMA(1, 0, At, B0); PG8_BAR; PG8_SCHED;
            PG8_STAGE(PG8_SB(1, 1), b3 + hstep, voffB);
            PG8_WAIT_V(6); PG8_BAR; PG8_MMA(1, 1, At, B1); PG8_BAR;
            }
        }
        if constexpr (ALIGN_EPI) { if (wr == 0) PG8_BAR; }
        if constexpr (!Epi::AFTER_DRAIN) { E(acc, cur, wr, wc, fr, fq); S.done(cur); }
        if (!has_next) break;
#pragma unroll
        for (int a = 0; a < 2; ++a)
#pragma unroll
            for (int b = 0; b < 2; ++b)
#pragma unroll
                for (int m = 0; m < 4; ++m)
#pragma unroll
                    for (int n = 0; n < 2; ++n) acc[a][b][m][n] = (f32x4){0.f, 0.f, 0.f, 0.f};
        cur = nxt; cA = nA; cB = nB; ++ui;
        if constexpr (ALIGN_EPI) { if (wr == 1) PG8_BAR; }
    }
    PG8_WAIT_V(0);
    if constexpr (!ALIGN_EPI) { if (wr == 0) PG8_BAR; }
    PG8_BAR;
    if constexpr (Epi::AFTER_DRAIN) { E.fused(acc, cur, wr, wc, fr, fq, lds, wid, lane); S.done(cur); }
#undef PG8_SA
#undef PG8_SB
#undef PG8_STAGE
#undef PG8_LDA
#undef PG8_LDB
#undef PG8_MMA
#undef PG8_WAIT_V
#undef PG8_WAIT_L
#undef PG8_BAR
#undef PG8_SCHED
}
}
#define DEV __device__ __forceinline__
#define LAS __attribute__((address_space(3)))
typedef unsigned short bf16;
typedef float f32x4 __attribute__((ext_vector_type(4)));
typedef unsigned u32x4 __attribute__((ext_vector_type(4)));
typedef unsigned u32x2 __attribute__((ext_vector_type(2)));
typedef short bf16x8 __attribute__((ext_vector_type(8)));

constexpr int NT = 512, NWV = 8;
constexpr int DM = 1024, NP = 3584, FF = 4096;
constexpr int MP = 16384, MREAL = 16512, MT = 16640, TT = 2048;
constexpr int REC = 1152;
constexpr float EPS = 1e-6f;
constexpr size_t MiB = 1u << 20;
constexpr size_t WS_RSS = 0;
constexpr size_t WS_LBT = 640 * 1024, WS_BAR = 704 * 1024, BAR_BYTES = 16384;
constexpr size_t WS_WTIN = 1 * MiB, WS_WTOUT = 8 * MiB, WS_WT1 = 10 * MiB, WS_WT2 = 18 * MiB, WS_WLORA = 26 * MiB;
constexpr size_t WS_XS = 27 * MiB, WS_U0 = 28 * MiB, WS_U1 = 61 * MiB, WS_P = 94 * MiB, WS_SCAN = 208 * MiB, WS_SCANS = 316 * MiB;
constexpr size_t WS_H = 94 * MiB;
constexpr size_t WS_OUTR = 317 * MiB, WS_G = 329 * MiB, WS_LA = 342 * MiB, WS_LU = 351 * MiB, WS_RSE = 360 * MiB, WS_RSO = 360 * MiB + 1280 * 1024, WS_END = 360 * MiB + 2560 * 1024;
DEV float row_scale(const float* rs, int row) { const f32x4* p = (const f32x4*)(rs + (size_t)row * 16); const f32x4 a = p[0], b = p[1], c = p[2], d = p[3];
    const float t = ((a[0] + a[1]) + (a[2] + a[3])) + ((b[0] + b[1]) + (b[2] + b[3])) + (((c[0] + c[1]) + (c[2] + c[3])) + ((d[0] + d[1]) + (d[2] + d[3])));
    return rsqrtf(t * (1.f / 1024.f) + 1e-6f); }
static_assert(WS_P + (size_t)MT * NP * 2 <= WS_SCAN && WS_SCAN + (size_t)MP * 6 * REC <= WS_SCANS && WS_H + (size_t)MT * FF * 2 <= WS_SCANS, "ws map");
static_assert(WS_U0 + (size_t)MT * DM * 2 <= WS_U1 && WS_U1 + (size_t)MT * DM * 2 <= WS_P, "ws map 2");
constexpr int WL_STRIDE = 131072, WL_AUP = 24576, WL_GUP = 49152, WL_WA = 98304, WL_WX = 114688;
constexpr size_t O_YP = 0, O_YS = 16777216, O_PWKV = 16908288, O_PSHIFT = 17694720, O_PHGRN = 17727488, O_PLRU = 18513920, O_PCONV = 18522112,
                 O_SWKV = 18546688, O_SSHIFT = 31129600, O_SHGRN = 31653888, O_SLRU = 44236800, O_SCONV = 44367872;
constexpr int LDS_BYTES = 147456;
enum { I_XP = 0, I_XS, I_SWKV, I_SSHIFT, I_SHGRN, I_SLRU, I_SCONV, I_N1G, I_WIN, I_MU, I_W0, I_WUP, I_A0, I_AUP, I_GUP, I_KK, I_KA, I_RK, I_LNW, I_LNB,
       I_HLB, I_HNG, I_CW, I_CB, I_WA, I_BA, I_WX, I_BX, I_LAM, I_WOUT, I_N2G, I_W1, I_W2, I_FG, N_IN };
struct Args { const float* in[N_IN]; float* out; unsigned char* ws; };

DEV int otid() { int t = threadIdx.x; asm volatile("" : "+v"(t)); return t; }
DEV int oblk() { int b = blockIdx.x; asm volatile("" : "+s"(b)); return b; }
DEV float bflo(unsigned u) { return __uint_as_float(u << 16); }
DEV float bfhi(unsigned u) { return __uint_as_float(u & 0xffff0000u); }
DEV float bf2f(unsigned short h) { return __uint_as_float((unsigned)h << 16); }
DEV unsigned pk2(float lo, float hi) { unsigned r; asm("v_cvt_pk_bf16_f32 %0, %1, %2" : "=v"(r) : "v"(lo), "v"(hi)); return r; }
DEV unsigned short f2bf(float f) { return (unsigned short)(pk2(f, 0.f) & 0xffffu); }
DEV float sigm(float x) { return 1.f / (1.f + __expf(-x)); }
template <int CTRL> DEV float dppf(float x) { return __builtin_bit_cast(float, __builtin_amdgcn_update_dpp(0, __builtin_bit_cast(int, x), CTRL, 0xF, 0xF, true)); }
DEV float red16(float x) { x += dppf<0xB1>(x); x += dppf<0x4E>(x); x += dppf<0x141>(x); x += dppf<0x140>(x); return x; }
DEV float rl(float x, int l) { return __builtin_bit_cast(float, __builtin_amdgcn_readlane(__builtin_bit_cast(int, x), l)); }
#ifdef WS_SHFL
DEV float wave_sum(float v) {
#pragma unroll
    for (int o = 1; o < 64; o <<= 1) v += __shfl_xor(v, o);
    return v;
}
#else
DEV float wave_sum(float v) { v = red16(v); return (rl(v, 0) + rl(v, 16)) + (rl(v, 32) + rl(v, 48)); }
#endif
DEV void unpack8(u32x4 u, float* f) { f[0] = bflo(u.x); f[1] = bfhi(u.x); f[2] = bflo(u.y); f[3] = bfhi(u.y); f[4] = bflo(u.z); f[5] = bfhi(u.z); f[6] = bflo(u.w); f[7] = bfhi(u.w); }
DEV float gelu_t(float x) { return 0.5f * x * (1.f + tanhf(0.7978845608f * (x + 0.044715f * x * x * x))); }

struct EpiP {
    static constexpr bool PERM = true, AFTER_DRAIN = false;
    bf16* O; const float* rss;
    DEV void operator()(const pg8::f32x4 (&acc)[2][2][4][2], const pg8::Unit& u, int wr, int wc, int fr, int fq) const {
        const int row0 = u.pm * 256 + wr * 64 + fr, col0 = u.pn * 256 + wc * 32 + 8 * fq;
#pragma unroll
        for (int ai = 0; ai < 2; ++ai)
#pragma unroll
            for (int m = 0; m < 4; ++m) {
                const int row = row0 + ai * 128 + m * 16;
                const float s = row < MREAL ? row_scale(rss, row) : 1.f;
                bf16* rowp = O + (size_t)row * NP + col0;
#pragma unroll
                for (int bj = 0; bj < 2; ++bj) { const pg8::f32x4 v0 = acc[ai][bj][m][0] * s, v1 = acc[ai][bj][m][1] * s;
                    u32x4 w; w.x = pk2(v0[0], v0[1]); w.y = pk2(v0[2], v0[3]); w.z = pk2(v1[0], v1[1]); w.w = pk2(v1[2], v1[3]);
                    *(u32x4*)(rowp + bj * 128) = w; }
            }
    }
};
struct EpiH {
    static constexpr bool PERM = true, AFTER_DRAIN = false;
    bf16* O; const float* rss;
    DEV void operator()(const pg8::f32x4 (&acc)[2][2][4][2], const pg8::Unit& u, int wr, int wc, int fr, int fq) const {
        const int row0 = u.pm * 256 + wr * 64 + fr, col0 = u.pn * 256 + wc * 32 + 8 * fq;
#pragma unroll
        for (int ai = 0; ai < 2; ++ai)
#pragma unroll
            for (int m = 0; m < 4; ++m) {
                const int row = row0 + ai * 128 + m * 16;
                const float s = row < MREAL ? row_scale(rss, row) : 1.f;
                bf16* rowp = O + (size_t)row * FF + col0;
#pragma unroll
                for (int bj = 0; bj < 2; ++bj) { pg8::f32x4 v0 = acc[ai][bj][m][0] * s, v1 = acc[ai][bj][m][1] * s;
#pragma unroll
                    for (int e = 0; e < 4; ++e) { const float a0 = fmaxf(v0[e], 0.f), a1 = fmaxf(v1[e], 0.f); v0[e] = a0 * a0; v1[e] = a1 * a1; }
                    u32x4 w; w.x = pk2(v0[0], v0[1]); w.y = pk2(v0[2], v0[3]); w.z = pk2(v1[0], v1[1]); w.w = pk2(v1[2], v1[3]);
                    *(u32x4*)(rowp + bj * 128) = w; }
            }
    }
};
struct EpiX {
    static constexpr bool PERM = false, AFTER_DRAIN = false;
    float* xp; float* xs; bf16* U; const float* g; float* rss;
    DEV void operator()(const pg8::f32x4 (&acc)[2][2][4][2], const pg8::Unit& u, int wr, int wc, int fr, int fq) const {
        const int row0 = u.pm * 256 + wr * 64 + fr, col0 = u.pn * 256 + wc * 32 + 4 * fq;
#pragma unroll
        for (int ai = 0; ai < 2; ++ai) {
            if (u.pm * 256 + ai * 128 >= MREAL) continue;
#pragma unroll
            for (int m = 0; m < 4; ++m) {
                const int row = row0 + ai * 128 + m * 16;
                float* xr = (row < MP ? xp + (size_t)row * DM : xs + (size_t)(row - MP) * DM) + col0;
                bf16* ur = U + (size_t)row * DM + col0;
                float ss = 0.f;
#pragma unroll
                for (int bj = 0; bj < 2; ++bj)
#pragma unroll
                    for (int n = 0; n < 2; ++n) { const int co = bj * 128 + n * 16;
                        f32x4 x = *(const f32x4*)(xr + co); const pg8::f32x4 a = acc[ai][bj][m][n];
                        x[0] += a[0]; x[1] += a[1]; x[2] += a[2]; x[3] += a[3];
                        *(f32x4*)(xr + co) = x; ss += (x[0] * x[0] + x[1] * x[1]) + (x[2] * x[2] + x[3] * x[3]);
                        const f32x4 gv = *(const f32x4*)(g + col0 + co);
                        u32x2 w; w.x = pk2(x[0] * gv[0], x[1] * gv[1]); w.y = pk2(x[2] * gv[2], x[3] * gv[3]);
                        *(u32x2*)(ur + co) = w; }
                ss += __shfl_xor(ss, 16); ss += __shfl_xor(ss, 32);
                if (fq == 0) rss[(size_t)row * 16 + u.pn * 4 + wc] = ss;
            }
        }
    }
};

DEV void transpose_item(const float* W, int K, int N, bf16* WT, int row_off, LAS float* scr, int item, int lane) {
    const int nblk = N / 32, kb = item / nblk, nb = item % nblk, k0 = 64 * kb, n0 = 32 * nb;
#pragma unroll 8
    for (int i = 0; i < 32; ++i) { const int kk = 2 * i + (lane >> 5); scr[kk * 33 + (lane & 31)] = W[(size_t)(k0 + kk) * N + n0 + (lane & 31)]; }
    asm volatile("s_waitcnt lgkmcnt(0)" ::: "memory");
    const int c = lane & 7;
#pragma unroll
    for (int j = 0; j < 4; ++j) { const int n = (lane >> 3) + 8 * j; const LAS float* s = scr + (8 * c) * 33 + n;
        u32x4 o; o.x = pk2(s[0 * 33], s[1 * 33]); o.y = pk2(s[2 * 33], s[3 * 33]); o.z = pk2(s[4 * 33], s[5 * 33]); o.w = pk2(s[6 * 33], s[7 * 33]);
        *(u32x4*)(WT + (size_t)(row_off + n0 + n) * K + k0 + 8 * c) = o; }
    asm volatile("s_waitcnt lgkmcnt(0)" ::: "memory");
}
DEV void transpose_job(const float* W, int K, int N, bf16* WT, int& it, int NGW, LAS float* scr, int lane) {
    const int n_items = (K / 64) * (N / 32);
    while (it < n_items) { transpose_item(W, K, N, WT, 0, scr, it, lane); it += NGW; }
    it -= n_items;
}

DEV void phase0(const Args& a, LAS unsigned char* lds) {
    const int tid = otid(), lane = tid & 63, wave = tid >> 6;
    const int gw = blockIdx.x * NWV + wave, NGW = gridDim.x * NWV, gt = blockIdx.x * NT + tid, NGT = gridDim.x * NT;
    unsigned char* ws = a.ws;
    float* rss = (float*)(ws + WS_RSE);
    {
        u32x4* z = (u32x4*)(ws + WS_WTIN + (size_t)3456 * DM * 2);
        for (int i = gt; i < 128 * DM * 2 / 16; i += NGT) z[i] = (u32x4){0u, 0u, 0u, 0u};
    }
    if (gt < 384) {
        const float* hl = a.in[I_HLB]; float e[4], mx = -1e30f, sm = 0.f;
        _Pragma("unroll") for (int d = 0; d < 4; ++d) { e[d] = hl[d * 384 + gt]; mx = fmaxf(mx, e[d]); }
        _Pragma("unroll") for (int d = 0; d < 4; ++d) { e[d] = __expf(e[d] - mx); sm += e[d]; }
        float* lbt = (float*)(ws + WS_LBT); float acc = 0.f; lbt[gt] = 0.f;
        _Pragma("unroll") for (int d = 1; d < 4; ++d) { acc += e[d] / sm; lbt[d * 384 + gt] = acc; }
    }
    bf16* U0 = (bf16*)(ws + WS_U0); bf16* U1 = (bf16*)(ws + WS_U1); float* xs = (float*)(ws + WS_XS);
    const f32x4* g4 = (const f32x4*)a.in[I_N1G];
    for (int row = gw; row < MREAL; row += NGW) {
        const f32x4* src = (const f32x4*)(row < MP ? a.in[I_XP] + (size_t)row * DM : a.in[I_XS] + (size_t)(row - MP) * DM);
        f32x4* dst = (f32x4*)(row < MP ? a.out + (size_t)row * DM : xs + (size_t)(row - MP) * DM);
        u32x2* ud = (u32x2*)(U0 + (size_t)row * DM);
        float ss = 0.f;
#pragma unroll
        for (int j = 0; j < 4; ++j) { const f32x4 v = src[lane + 64 * j], g = g4[lane + 64 * j]; dst[lane + 64 * j] = v;
            ss += (v[0] * v[0] + v[1] * v[1]) + (v[2] * v[2] + v[3] * v[3]);
            u32x2 w; w.x = pk2(v[0] * g[0], v[1] * g[1]); w.y = pk2(v[2] * g[2], v[3] * g[3]); ud[lane + 64 * j] = w; }
        ss = wave_sum(ss); if (lane < 16) rss[(size_t)row * 16 + lane] = lane == 0 ? ss : 0.f;
    }
    for (int r = gw; r < 256; r += NGW) { const int lay = r >> 7, i = r & 127;
        const f32x4* src = (const f32x4*)(a.in[I_SSHIFT] + (size_t)(lay * 128 + i) * DM);
        u32x2* ud = (u32x2*)((lay ? U1 : U0) + (size_t)(MREAL + i) * DM);
#pragma unroll
        for (int j = 0; j < 4; ++j) { const f32x4 v = src[lane + 64 * j]; u32x2 w; w.x = pk2(v[0], v[1]); w.y = pk2(v[2], v[3]); ud[lane + 64 * j] = w; }
    }
    LAS float* scr = (LAS float*)(lds + wave * 8448);
    int it = gw;
    transpose_job(a.in[I_WIN], DM, 3456, (bf16*)(ws + WS_WTIN), it, NGW, scr, lane);
    for (int l = 0; l < 4; ++l) {
        bf16* WL = (bf16*)(ws + WS_WLORA) + (size_t)l * WL_STRIDE;
        transpose_job(a.in[I_WUP] + (size_t)l * 64 * 384, 64, 384, WL, it, NGW, scr, lane);
        transpose_job(a.in[I_AUP] + (size_t)l * 64 * 384, 64, 384, WL + WL_AUP, it, NGW, scr, lane);
        transpose_job(a.in[I_GUP] + (size_t)l * 128 * 384, 128, 384, WL + WL_GUP, it, NGW, scr, lane);
        for (int n = 0; n < 4; ++n) {
            transpose_job(a.in[I_WA] + (size_t)(l * 4 + n) * 4096, 64, 64, WL + WL_WA + n * 4096, it, NGW, scr, lane);
            transpose_job(a.in[I_WX] + (size_t)(l * 4 + n) * 4096, 64, 64, WL + WL_WX + n * 4096, it, NGW, scr, lane);
        }
    }
}

constexpr int PL_PRM = 0, PL_AL = 14336, PL_XC = 31232, PL_LW = 48128, PL_LA = 73216, PL_GR = 98304, PL_GI = 115200;
template <int C> DEV float dpp_sum8(float x) { x += __shfl_xor(x, 1); x += __shfl_xor(x, 2); x += __shfl_xor(x, 4); return x; }
DEV void prep_tile(const Args& a, int l, int tt, LAS unsigned char* lds, bool do_gelu = true) {
    const int tid = otid(), lane = tid & 63, wave = __builtin_amdgcn_readfirstlane(tid >> 6);
    unsigned char* ws = a.ws;
    LAS float* PRM = (LAS float*)(lds + PL_PRM);
    LAS bf16* AL = (LAS bf16*)(lds + PL_AL);
    LAS bf16* XC = (LAS bf16*)(lds + PL_XC);
    LAS bf16* LW = (LAS bf16*)(lds + PL_LW);
    LAS bf16* LAo = (LAS bf16*)(lds + PL_LA);
    LAS bf16* GR = (LAS bf16*)(lds + PL_GR);
    LAS bf16* GI = (LAS bf16*)(lds + PL_GI);
    bf16* P = (bf16*)(ws + WS_P);
    const bool samp = tt >= 512;
    const int row0 = tt * 32;
    const float* mu = a.in[I_MU] + l * 1408;
#ifndef SK_PREP_A
#pragma unroll 1
    for (int itx = 0; itx < 2; ++itx) {
        const int idx = itx * NT + tid, r = idx >> 5, col = (idx & 31) * 8, row = row0 + r, t = row & (TT - 1);
        float p[8], pp[8], x[8];
        {
            unpack8(*(const u32x4*)(P + (size_t)row * NP + 1152 + col), p);
            const bool valid = samp || t > 0; const int prow = samp ? row + 128 : row - 1;
            if (valid) unpack8(*(const u32x4*)(P + (size_t)prow * NP + 1152 + col), pp);
            else { _Pragma("unroll") for (int e = 0; e < 8; ++e) pp[e] = 0.f; }
            const f32x4 m0 = *(const f32x4*)(mu + 1152 + col), m1 = *(const f32x4*)(mu + 1152 + col + 4);
#pragma unroll
            for (int e = 0; e < 8; ++e) { const float m = e < 4 ? m0[e] : m1[e - 4]; x[e] = p[e] + m * (pp[e] - p[e]); }
            if (col < 64) { _Pragma("unroll") for (int e = 0; e < 8; ++e) x[e] = tanhf(x[e]); }
            else if (col >= 128) { _Pragma("unroll") for (int e = 0; e < 8; ++e) x[e] = sigm(x[e]); }
            u32x4 w; w.x = pk2(x[0], x[1]); w.y = pk2(x[2], x[3]); w.z = pk2(x[4], x[5]); w.w = pk2(x[6], x[7]);
            *(LAS u32x4*)(AL + r * 264 + col) = w;
        }
        {
            float xr[4][8];
            unpack8(*(const u32x4*)(P + (size_t)row * NP + 2944 + col), xr[0]);
            if (!samp) {
#pragma unroll
                for (int j = 1; j < 4; ++j) { if (t - j >= 0) unpack8(*(const u32x4*)(P + (size_t)(row - j) * NP + 2944 + col), xr[j]); else { _Pragma("unroll") for (int e = 0; e < 8; ++e) xr[j][e] = 0.f; } }
                if (t >= TT - 3) { float* pc = a.out + O_PCONV + ((size_t)((l * 8 + (row >> 11)) * 3 + (t - (TT - 3)))) * 256 + col;
                    *(f32x4*)pc = (f32x4){xr[0][0], xr[0][1], xr[0][2], xr[0][3]}; *(f32x4*)(pc + 4) = (f32x4){xr[0][4], xr[0][5], xr[0][6], xr[0][7]}; }
            } else {
                const int i = row - MP; const float* c0 = a.in[I_SCONV] + (size_t)((l * 128 + i) * 3) * 256 + col;
#pragma unroll
                for (int j = 1; j < 4; ++j) { const f32x4 q0 = *(const f32x4*)(c0 + (3 - j) * 256), q1 = *(const f32x4*)(c0 + (3 - j) * 256 + 4);
                    xr[j][0] = q0[0]; xr[j][1] = q0[1]; xr[j][2] = q0[2]; xr[j][3] = q0[3]; xr[j][4] = q1[0]; xr[j][5] = q1[1]; xr[j][6] = q1[2]; xr[j][7] = q1[3]; }
                float* sc = a.out + O_SCONV + (size_t)((l * 128 + i) * 3) * 256 + col;
                *(f32x4*)(sc) = (f32x4){xr[2][0], xr[2][1], xr[2][2], xr[2][3]}; *(f32x4*)(sc + 4) = (f32x4){xr[2][4], xr[2][5], xr[2][6], xr[2][7]};
                *(f32x4*)(sc + 256) = (f32x4){xr[1][0], xr[1][1], xr[1][2], xr[1][3]}; *(f32x4*)(sc + 260) = (f32x4){xr[1][4], xr[1][5], xr[1][6], xr[1][7]};
                *(f32x4*)(sc + 512) = (f32x4){xr[0][0], xr[0][1], xr[0][2], xr[0][3]}; *(f32x4*)(sc + 516) = (f32x4){xr[0][4], xr[0][5], xr[0][6], xr[0][7]};
            }
            const float* cw = a.in[I_CW] + (size_t)l * 4 * 256 + col; const float* cb = a.in[I_CB] + l * 256 + col;
            float xc[8];
#pragma unroll
            for (int e = 0; e < 8; ++e) xc[e] = cb[e] + cw[e] * xr[3][e] + cw[256 + e] * xr[2][e] + cw[512 + e] * xr[1][e] + cw[768 + e] * xr[0][e];
            u32x4 w; w.x = pk2(xc[0], xc[1]); w.y = pk2(xc[2], xc[3]); w.z = pk2(xc[4], xc[5]); w.w = pk2(xc[6], xc[7]);
            *(LAS u32x4*)(XC + r * 264 + col) = w;
        }
    }
#endif
    __syncthreads();
    const int fr = lane & 15, fq = lane >> 4;
    const bf16* WL = (const bf16*)(ws + WS_WLORA) + (size_t)l * WL_STRIDE;
#ifndef SK_PREP_R
    if (wave < 6) {
        const int h = wave;
        bf16* G = (bf16*)(ws + WS_G);
#ifndef NP_NO_WA
#pragma unroll
        for (int which = 0; which < 2; ++which) {
            const bf16* Wm = WL + (which ? WL_AUP : 0); LAS bf16* Lo = which ? LAo : LW;
            bf16x8 Wf[4][2];
#pragma unroll
            for (int ni = 0; ni < 4; ++ni)
#pragma unroll
                for (int ks = 0; ks < 2; ++ks) Wf[ni][ks] = *(const bf16x8*)(Wm + (h * 64 + ni * 16 + fr) * 64 + ks * 32 + fq * 8);
#pragma unroll
            for (int mi = 0; mi < 2; ++mi) {
                f32x4 acc[4];
#pragma unroll
                for (int ni = 0; ni < 4; ++ni) acc[ni] = (f32x4){0.f, 0.f, 0.f, 0.f};
#pragma unroll
                for (int ks = 0; ks < 2; ++ks) { const bf16x8 Af = *(const LAS bf16x8*)(AL + (mi * 16 + fr) * 264 + which * 64 + ks * 32 + fq * 8);
#pragma unroll
                    for (int ni = 0; ni < 4; ++ni) acc[ni] = __builtin_amdgcn_mfma_f32_16x16x32_bf16(Wf[ni][ks], Af, acc[ni], 0, 0, 0); }
#pragma unroll
                for (int ni = 0; ni < 4; ++ni) { u32x2 w; w.x = pk2(acc[ni][0], acc[ni][1]); w.y = pk2(acc[ni][2], acc[ni][3]);
                    *(LAS u32x2*)(Lo + (mi * 16 + fr) * 392 + h * 64 + ni * 16 + fq * 4) = w; }
            }
        }
#endif
        {
            bf16x8 Wf[4][4];
#pragma unroll
            for (int ni = 0; ni < 4; ++ni)
#pragma unroll
                for (int ks = 0; ks < 4; ++ks) Wf[ni][ks] = *(const bf16x8*)(WL + WL_GUP + (h * 64 + ni * 16 + fr) * 128 + ks * 32 + fq * 8);
#pragma unroll
            for (int mi = 0; mi < 2; ++mi) {
                f32x4 acc[4];
#pragma unroll
                for (int ni = 0; ni < 4; ++ni) acc[ni] = (f32x4){0.f, 0.f, 0.f, 0.f};
#pragma unroll
                for (int ks = 0; ks < 4; ++ks) { const bf16x8 Af = *(const LAS bf16x8*)(AL + (mi * 16 + fr) * 264 + 128 + ks * 32 + fq * 8);
#pragma unroll
                    for (int ni = 0; ni < 4; ++ni) acc[ni] = __builtin_amdgcn_mfma_f32_16x16x32_bf16(Wf[ni][ks], Af, acc[ni], 0, 0, 0); }
                const int row = row0 + mi * 16 + fr;
#pragma unroll
                for (int ni = 0; ni < 4; ++ni) { u32x2 w; w.x = pk2(acc[ni][0], acc[ni][1]); w.y = pk2(acc[ni][2], acc[ni][3]);
#ifndef NP_NO_G
                    *(u32x2*)(G + (size_t)row * 384 + h * 64 + ni * 16 + fq * 4) = w;
#endif
                }
            }
        }
    } else
#endif
#ifndef SK_PREP_L
    if (wave >= 6) {
#pragma unroll 1
        for (int nn = 0; nn < 2; ++nn) {
            const int n = (wave - 6) * 2 + nn;
            bf16x8 Wa[4][2], Wx[4][2];
#pragma unroll
            for (int ni = 0; ni < 4; ++ni)
#pragma unroll
                for (int ks = 0; ks < 2; ++ks) { Wa[ni][ks] = *(const bf16x8*)(WL + WL_WA + n * 4096 + (ni * 16 + fr) * 64 + ks * 32 + fq * 8);
                                                  Wx[ni][ks] = *(const bf16x8*)(WL + WL_WX + n * 4096 + (ni * 16 + fr) * 64 + ks * 32 + fq * 8); }
#pragma unroll
            for (int mi = 0; mi < 2; ++mi) {
                f32x4 ar[4], ax[4];
#pragma unroll
                for (int ni = 0; ni < 4; ++ni) { ar[ni] = (f32x4){0.f, 0.f, 0.f, 0.f}; ax[ni] = ar[ni]; }
#pragma unroll
                for (int ks = 0; ks < 2; ++ks) { const bf16x8 Af = *(const LAS bf16x8*)(XC + (mi * 16 + fr) * 264 + n * 64 + ks * 32 + fq * 8);
#pragma unroll
                    for (int ni = 0; ni < 4; ++ni) { ar[ni] = __builtin_amdgcn_mfma_f32_16x16x32_bf16(Wa[ni][ks], Af, ar[ni], 0, 0, 0); ax[ni] = __builtin_amdgcn_mfma_f32_16x16x32_bf16(Wx[ni][ks], Af, ax[ni], 0, 0, 0); } }
#pragma unroll
                for (int ni = 0; ni < 4; ++ni) { u32x2 w1, w2; w1.x = pk2(ar[ni][0], ar[ni][1]); w1.y = pk2(ar[ni][2], ar[ni][3]); w2.x = pk2(ax[ni][0], ax[ni][1]); w2.y = pk2(ax[ni][2], ax[ni][3]);
                    *(LAS u32x2*)(GR + (mi * 16 + fr) * 264 + n * 64 + ni * 16 + fq * 4) = w1; *(LAS u32x2*)(GI + (mi * 16 + fr) * 264 + n * 64 + ni * 16 + fq * 4) = w2; }
            }
        }
    }
#endif
    __syncthreads();
#ifndef NP_NO_RW
#pragma unroll 1
    for (int itx = 0; itx < 3; ++itx) {
        const int idx = itx * NT + tid, r = idx / 48, cg = idx % 48, c0 = cg * 8, h = cg >> 3, i0 = c0 & 63;
        const int row = row0 + r, t = row & (TT - 1);
        const bool valid = samp || t > 0; const int prow = samp ? row + 128 : row - 1;
        float cr[8], ck[8], cv[8], er[8], ek[8], ev[8], lw[8], la[8];
        const bf16* pr = P + (size_t)row * NP + c0; const bf16* pq = P + (size_t)prow * NP + c0;
        unpack8(*(const u32x4*)pr, cr); unpack8(*(const u32x4*)(pr + 384), ck); unpack8(*(const u32x4*)(pr + 768), cv);
        if (valid) { unpack8(*(const u32x4*)pq, er); unpack8(*(const u32x4*)(pq + 384), ek); unpack8(*(const u32x4*)(pq + 768), ev); }
        else { _Pragma("unroll") for (int e = 0; e < 8; ++e) { er[e] = 0.f; ek[e] = 0.f; ev[e] = 0.f; } }
        unpack8(*(const LAS u32x4*)(LW + r * 392 + c0), lw); unpack8(*(const LAS u32x4*)(LAo + r * 392 + c0), la);
        float wq[8], kq[8], av[8], rv[8], kv[8], vv[8]; float ssq = 0.f;
#pragma unroll
        for (int e = 0; e < 8; ++e) {
            const float mr = PRM[c0 + e], mk = PRM[384 + c0 + e], mv = PRM[768 + c0 + e], w0 = PRM[1152 + c0 + e], a0 = PRM[1536 + c0 + e], kk_ = PRM[1920 + c0 + e], ka_ = PRM[2304 + c0 + e];
            rv[e] = cr[e] + mr * (er[e] - cr[e]); const float kx = ck[e] + mk * (ek[e] - ck[e]); vv[e] = cv[e] + mv * (ev[e] - cv[e]);
            wq[e] = __expf(-0.6065306597f * sigm(w0 + lw[e]));
            av[e] = sigm(a0 + la[e]);
            kq[e] = kx * kk_; ssq += kq[e] * kq[e];
            kv[e] = kx * (1.f + (av[e] - 1.f) * ka_);
        }
        ssq = dpp_sum8<0>(ssq);
        const float inv = rsqrtf(fmaxf(ssq, 1e-24f));
        unsigned char* rec = samp ? ws + WS_SCANS + (size_t)((row - MP) * 6 + h) * REC
                                  : ws + WS_SCAN + ((size_t)((row >> 11) * 6 + h) * TT + t) * REC;
        f32x4 o0, o1;
        o0 = (f32x4){wq[0], wq[1], wq[2], wq[3]}; o1 = (f32x4){wq[4], wq[5], wq[6], wq[7]};
        *(f32x4*)(rec + 4 * i0) = o0; *(f32x4*)(rec + 4 * i0 + 16) = o1;
#pragma unroll
        for (int e = 0; e < 8; ++e) kq[e] *= inv;
        o0 = (f32x4){kq[0], kq[1], kq[2], kq[3]}; o1 = (f32x4){kq[4], kq[5], kq[6], kq[7]};
        *(f32x4*)(rec + 256 + 4 * i0) = o0; *(f32x4*)(rec + 256 + 4 * i0 + 16) = o1;
        o0 = (f32x4){kq[0] * av[0], kq[1] * av[1], kq[2] * av[2], kq[3] * av[3]}; o1 = (f32x4){kq[4] * av[4], kq[5] * av[5], kq[6] * av[6], kq[7] * av[7]};
        *(f32x4*)(rec + 512 + 4 * i0) = o0; *(f32x4*)(rec + 512 + 4 * i0 + 16) = o1;
        u32x4 rk; rk.x = pk2(rv[0], rv[1]); rk.y = pk2(rv[2], rv[3]); rk.z = pk2(kv[0], kv[1]); rk.w = pk2(kv[2], kv[3]);
        *(u32x4*)(rec + 768 + 4 * i0) = rk;
        rk.x = pk2(rv[4], rv[5]); rk.y = pk2(rv[6], rv[7]); rk.z = pk2(kv[4], kv[5]); rk.w = pk2(kv[6], kv[7]);
        *(u32x4*)(rec + 768 + 4 * i0 + 16) = rk;
        u32x4 vp; vp.x = pk2(vv[0], vv[1]); vp.y = pk2(vv[2], vv[3]); vp.z = pk2(vv[4], vv[5]); vp.w = pk2(vv[6], vv[7]);
        *(u32x4*)(rec + 1024 + 2 * i0) = vp;
    }
#endif
    {
        bf16* LA = (bf16*)(ws + WS_LA); bf16* LU = (bf16*)(ws + WS_LU);
#pragma unroll 1
        for (int itx = 0; itx < 2; ++itx) {
            const int idx = itx * NT + tid, r = idx >> 5, c0 = (idx & 31) * 8, row = row0 + r;
            float gr[8], gi[8], xc[8], la[8], uu[8];
            unpack8(*(const LAS u32x4*)(GR + r * 264 + c0), gr); unpack8(*(const LAS u32x4*)(GI + r * 264 + c0), gi); unpack8(*(const LAS u32x4*)(XC + r * 264 + c0), xc);
#pragma unroll
            for (int e = 0; e < 8; ++e) { const float rr = sigm(gr[e] + PRM[2688 + c0 + e]), ii = sigm(gi[e] + PRM[2944 + c0 + e]);
                la[e] = -8.f * rr * PRM[3200 + c0 + e];
                uu[e] = xc[e] * ii * sqrtf(fmaxf(-expm1f(2.f * la[e]), 1e-12f)); }
            u32x4 o1, o2; o1.x = pk2(la[0], la[1]); o1.y = pk2(la[2], la[3]); o1.z = pk2(la[4], la[5]); o1.w = pk2(la[6], la[7]);
            o2.x = pk2(uu[0], uu[1]); o2.y = pk2(uu[2], uu[3]); o2.z = pk2(uu[4], uu[5]); o2.w = pk2(uu[6], uu[7]);
#ifndef NP_NO_LRU
            *(u32x4*)(LA + (size_t)row * 256 + c0) = o1; *(u32x4*)(LU + (size_t)row * 256 + c0) = o2;
#endif
        }
    }
    __syncthreads();
}

DEV void phase_prep(const Args& a, int l, LAS unsigned char* lds, bool do_gelu = true) {
    const int tid = otid(), lane = tid & 63, wave = tid >> 6;
    const int gw = blockIdx.x * NWV + wave, NGW = gridDim.x * NWV;
    unsigned char* ws = a.ws;
    {
        LAS float* PRM = (LAS float*)(lds + PL_PRM);
        for (int i = tid; i < 384; i += NT) { PRM[i] = a.in[I_MU][l * 1408 + i]; PRM[384 + i] = a.in[I_MU][l * 1408 + 384 + i]; PRM[768 + i] = a.in[I_MU][l * 1408 + 768 + i];
            PRM[1152 + i] = a.in[I_W0][l * 384 + i]; PRM[1536 + i] = a.in[I_A0][l * 384 + i]; PRM[1920 + i] = a.in[I_KK][l * 384 + i]; PRM[2304 + i] = a.in[I_KA][l * 384 + i]; }
        for (int i = tid; i < 256; i += NT) { PRM[2688 + i] = a.in[I_BA][l * 256 + i]; PRM[2944 + i] = a.in[I_BX][l * 256 + i]; PRM[3200 + i] = log1pf(__expf(-a.in[I_LAM][l * 256 + i])); }
    }
    __syncthreads();
    for (int tt = blockIdx.x; tt < 516; tt += gridDim.x) prep_tile(a, l, tt, lds, do_gelu);
    const float* rss = (const float*)(ws + WS_RSE);
    for (int r = gw; r < 136; r += NGW) {
        const int row = r < 8 ? r * TT + TT - 1 : MP + (r - 8);
        const f32x4* src = (const f32x4*)(row < MP ? a.out + (size_t)row * DM : (const float*)(ws + WS_XS) + (size_t)(row - MP) * DM);
        f32x4* dst = (f32x4*)(r < 8 ? a.out + O_PSHIFT + (size_t)(l * 8 + r) * DM : a.out + O_SSHIFT + (size_t)(l * 128 + (r - 8)) * DM);
        const f32x4* g4 = (const f32x4*)(a.in[I_N1G] + l * DM);
        const float s = row_scale(rss, row);
#pragma unroll
        for (int j = 0; j < 4; ++j) { const f32x4 v = src[lane + 64 * j], g = g4[lane + 64 * j]; dst[lane + 64 * j] = (f32x4){v[0] * s * g[0], v[1] * s * g[1], v[2] * s * g[2], v[3] * s * g[3]}; }
    }
    if (l + 2 < 4) {
        bf16* U = (bf16*)(ws + ((l & 1) ? WS_U1 : WS_U0));
        for (int i = gw; i < 128; i += NGW) {
            const f32x4* src = (const f32x4*)(a.in[I_SSHIFT] + (size_t)((l + 2) * 128 + i) * DM);
            u32x2* ud = (u32x2*)(U + (size_t)(MREAL + i) * DM);
#pragma unroll
            for (int j = 0; j < 4; ++j) { const f32x4 v = src[lane + 64 * j]; u32x2 w; w.x = pk2(v[0], v[1]); w.y = pk2(v[2], v[3]); ud[lane + 64 * j] = w; }
        }
    }
    __syncthreads();
    LAS float* scr = (LAS float*)(lds + wave * 8448);
    int it = gw;
    transpose_job(a.in[I_WOUT] + (size_t)l * DM * DM, DM, DM, (bf16*)(ws + WS_WTOUT), it, NGW, scr, lane);
    transpose_job(a.in[I_W1] + (size_t)l * DM * FF, DM, FF, (bf16*)(ws + WS_WT1), it, NGW, scr, lane);
    transpose_job(a.in[I_W2] + (size_t)l * FF * DM, FF, DM, (bf16*)(ws + WS_WT2), it, NGW, scr, lane);
}

DEV void prep_tile_old(const Args& a, int l, int tt, LAS unsigned char* lds, bool do_gelu = true, int mi_lo = 0, int mi_hi = 4) {
    const int tid = otid(), lane = tid & 63, wave = __builtin_amdgcn_readfirstlane(tid >> 6);
    unsigned char* ws = a.ws;
    LAS bf16* AL = (LAS bf16*)lds;
    LAS bf16* XC = (LAS bf16*)(lds + 33792);
    bf16* P = (bf16*)(ws + WS_P);
    const bool samp = tt >= 256;
    const int row0 = tt * 64;
    const float* mu = a.in[I_MU] + l * 1408;
#ifndef SK_PREP_A
#pragma unroll 1
    for (int itx = mi_lo; itx < mi_hi; ++itx) {
        const int idx = itx * NT + tid, r = idx >> 5, col = (idx & 31) * 8, row = row0 + r, t = row & (TT - 1);
        float p[8], pp[8], x[8];
        {
            unpack8(*(const u32x4*)(P + (size_t)row * NP + 1152 + col), p);
            const bool valid = samp || t > 0; const int prow = samp ? row + 128 : row - 1;
            if (valid) unpack8(*(const u32x4*)(P + (size_t)prow * NP + 1152 + col), pp);
            else { _Pragma("unroll") for (int e = 0; e < 8; ++e) pp[e] = 0.f; }
            const f32x4 m0 = *(const f32x4*)(mu + 1152 + col), m1 = *(const f32x4*)(mu + 1152 + col + 4);
#pragma unroll
            for (int e = 0; e < 8; ++e) { const float m = e < 4 ? m0[e] : m1[e - 4]; x[e] = p[e] + m * (pp[e] - p[e]); }
            if (col < 64) { _Pragma("unroll") for (int e = 0; e < 8; ++e) x[e] = tanhf(x[e]); }
            else if (col >= 128) { _Pragma("unroll") for (int e = 0; e < 8; ++e) x[e] = sigm(x[e]); }
            u32x4 w; w.x = pk2(x[0], x[1]); w.y = pk2(x[2], x[3]); w.z = pk2(x[4], x[5]); w.w = pk2(x[6], x[7]);
            *(LAS u32x4*)(AL + r * 264 + col) = w;
        }
        {
            float xr[4][8];
            unpack8(*(const u32x4*)(P + (size_t)row * NP + 2944 + col), xr[0]);
            if (!samp) {
#pragma unroll
                for (int j = 1; j < 4; ++j) { if (t - j >= 0) unpack8(*(const u32x4*)(P + (size_t)(row - j) * NP + 2944 + col), xr[j]); else { _Pragma("unroll") for (int e = 0; e < 8; ++e) xr[j][e] = 0.f; } }
                if (t >= TT - 3) { float* pc = a.out + O_PCONV + ((size_t)((l * 8 + (row >> 11)) * 3 + (t - (TT - 3)))) * 256 + col;
                    *(f32x4*)pc = (f32x4){xr[0][0], xr[0][1], xr[0][2], xr[0][3]}; *(f32x4*)(pc + 4) = (f32x4){xr[0][4], xr[0][5], xr[0][6], xr[0][7]}; }
            } else {
                const int i = row - MP; const float* c0 = a.in[I_SCONV] + (size_t)((l * 128 + i) * 3) * 256 + col;
#pragma unroll
                for (int j = 1; j < 4; ++j) { const f32x4 q0 = *(const f32x4*)(c0 + (3 - j) * 256), q1 = *(const f32x4*)(c0 + (3 - j) * 256 + 4);
                    xr[j][0] = q0[0]; xr[j][1] = q0[1]; xr[j][2] = q0[2]; xr[j][3] = q0[3]; xr[j][4] = q1[0]; xr[j][5] = q1[1]; xr[j][6] = q1[2]; xr[j][7] = q1[3]; }
                float* sc = a.out + O_SCONV + (size_t)((l * 128 + i) * 3) * 256 + col;
                *(f32x4*)(sc) = (f32x4){xr[2][0], xr[2][1], xr[2][2], xr[2][3]}; *(f32x4*)(sc + 4) = (f32x4){xr[2][4], xr[2][5], xr[2][6], xr[2][7]};
                *(f32x4*)(sc + 256) = (f32x4){xr[1][0], xr[1][1], xr[1][2], xr[1][3]}; *(f32x4*)(sc + 260) = (f32x4){xr[1][4], xr[1][5], xr[1][6], xr[1][7]};
                *(f32x4*)(sc + 512) = (f32x4){xr[0][0], xr[0][1], xr[0][2], xr[0][3]}; *(f32x4*)(sc + 516) = (f32x4){xr[0][4], xr[0][5], xr[0][6], xr[0][7]};
            }
            const float* cw = a.in[I_CW] + (size_t)l * 4 * 256 + col; const float* cb = a.in[I_CB] + l * 256 + col;
            float xc[8];
#pragma unroll
            for (int e = 0; e < 8; ++e) xc[e] = cb[e] + cw[e] * xr[3][e] + cw[256 + e] * xr[2][e] + cw[512 + e] * xr[1][e] + cw[768 + e] * xr[0][e];
            u32x4 w; w.x = pk2(xc[0], xc[1]); w.y = pk2(xc[2], xc[3]); w.z = pk2(xc[4], xc[5]); w.w = pk2(xc[6], xc[7]);
            *(LAS u32x4*)(XC + r * 264 + col) = w;
            float gt8[8]; bf16* gp = P + (size_t)row * NP + 3200 + col;
            unpack8(*(const u32x4*)gp, gt8);
#pragma unroll
            for (int e = 0; e < 8; ++e) gt8[e] = gelu_t(gt8[e]);
            u32x4 gw; gw.x = pk2(gt8[0], gt8[1]); gw.y = pk2(gt8[2], gt8[3]); gw.z = pk2(gt8[4], gt8[5]); gw.w = pk2(gt8[6], gt8[7]);
        }
    }
#endif
    __syncthreads();
    const int fr = lane & 15, fq = lane >> 4;
    const bf16* WL = (const bf16*)(ws + WS_WLORA) + (size_t)l * WL_STRIDE;
#ifdef SK_PREP_R
    if (false) {
#else
    if (wave < 6) {
#endif
        const int h = wave;
        const float* w0 = a.in[I_W0] + l * 384; const float* a0 = a.in[I_A0] + l * 384; const float* kkp = a.in[I_KK] + l * 384; const float* kap = a.in[I_KA] + l * 384;
        bf16* G = (bf16*)(ws + WS_G);
#pragma unroll 1
        for (int mi = mi_lo; mi < mi_hi; ++mi) {
            f32x4 aw[4], aa[4], ag[4];
#pragma unroll
            for (int ni = 0; ni < 4; ++ni) { aw[ni] = (f32x4){0.f, 0.f, 0.f, 0.f}; aa[ni] = aw[ni]; ag[ni] = aw[ni]; }
            const LAS bf16* arow = AL + (mi * 16 + fr) * 264 + fq * 8;
#pragma unroll
            for (int ks = 0; ks < 2; ++ks) { const bf16x8 Af = *(const LAS bf16x8*)(arow + ks * 32), Bf = *(const LAS bf16x8*)(arow + 64 + ks * 32);
#pragma unroll
                for (int ni = 0; ni < 4; ++ni) { const int n = h * 64 + ni * 16 + fr;
                    aw[ni] = __builtin_amdgcn_mfma_f32_16x16x32_bf16(*(const bf16x8*)(WL + n * 64 + ks * 32 + fq * 8), Af, aw[ni], 0, 0, 0);
                    aa[ni] = __builtin_amdgcn_mfma_f32_16x16x32_bf16(*(const bf16x8*)(WL + WL_AUP + n * 64 + ks * 32 + fq * 8), Bf, aa[ni], 0, 0, 0); } }
#pragma unroll
            for (int ks = 0; ks < 4; ++ks) { const bf16x8 Af = *(const LAS bf16x8*)(arow + 128 + ks * 32);
#pragma unroll
                for (int ni = 0; ni < 4; ++ni) { const int n = h * 64 + ni * 16 + fr;
                    ag[ni] = __builtin_amdgcn_mfma_f32_16x16x32_bf16(*(const bf16x8*)(WL + WL_GUP + n * 128 + ks * 32 + fq * 8), Af, ag[ni], 0, 0, 0); } }
            const int r = mi * 16 + fr, row = row0 + r, t = row & (TT - 1);
            const bool valid = samp || t > 0; const int prow = samp ? row + 128 : row - 1;
            float ssq = 0.f;
#pragma unroll
            for (int ni = 0; ni < 4; ++ni) {
                const int c0 = h * 64 + ni * 16 + fq * 4;
                const u32x2 uk = *(const u32x2*)(P + (size_t)row * NP + 384 + c0);
                u32x2 qk = (u32x2){0u, 0u}; if (valid) qk = *(const u32x2*)(P + (size_t)prow * NP + 384 + c0);
                const f32x4 mk = *(const f32x4*)(mu + 384 + c0), kk4 = *(const f32x4*)(kkp + c0);
                const float ck[4] = {bflo(uk.x), bfhi(uk.x), bflo(uk.y), bfhi(uk.y)}, ek[4] = {bflo(qk.x), bfhi(qk.x), bflo(qk.y), bfhi(qk.y)};
#pragma unroll
                for (int j = 0; j < 4; ++j) { const float kr = (ck[j] + mk[j] * (ek[j] - ck[j])) * kk4[j]; ssq += kr * kr; }
            }
            ssq += __shfl_xor(ssq, 16); ssq += __shfl_xor(ssq, 32);
            const float inv = rsqrtf(fmaxf(ssq, 1e-24f));
            unsigned char* rec = samp ? ws + WS_SCANS + (size_t)((row - MP) * 6 + h) * REC
                                      : ws + WS_SCAN + ((size_t)((row >> 11) * 6 + h) * TT + t) * REC;
#pragma unroll
            for (int ni = 0; ni < 4; ++ni) {
                asm volatile("" ::: "memory");
                const int i0 = ni * 16 + fq * 4, c0 = h * 64 + i0;
                const bf16* pr = P + (size_t)row * NP + c0; const bf16* pq = P + (size_t)prow * NP + c0;
                const u32x2 ur = *(const u32x2*)pr, uk = *(const u32x2*)(pr + 384), uv = *(const u32x2*)(pr + 768);
                u32x2 qr = (u32x2){0u, 0u}, qk = qr, qv = qr;
                if (valid) { qr = *(const u32x2*)pq; qk = *(const u32x2*)(pq + 384); qv = *(const u32x2*)(pq + 768); }
                const f32x4 mr = *(const f32x4*)(mu + c0), mk = *(const f32x4*)(mu + 384 + c0), mv = *(const f32x4*)(mu + 768 + c0);
                const f32x4 w04 = *(const f32x4*)(w0 + c0), a04 = *(const f32x4*)(a0 + c0), kk4 = *(const f32x4*)(kkp + c0), ka4 = *(const f32x4*)(kap + c0);
                const float cr[4] = {bflo(ur.x), bfhi(ur.x), bflo(ur.y), bfhi(ur.y)}, ck[4] = {bflo(uk.x), bfhi(uk.x), bflo(uk.y), bfhi(uk.y)}, cv[4] = {bflo(uv.x), bfhi(uv.x), bflo(uv.y), bfhi(uv.y)};
                const float er[4] = {bflo(qr.x), bfhi(qr.x), bflo(qr.y), bfhi(qr.y)}, ek[4] = {bflo(qk.x), bfhi(qk.x), bflo(qk.y), bfhi(qk.y)}, ev[4] = {bflo(qv.x), bfhi(qv.x), bflo(qv.y), bfhi(qv.y)};
                f32x4 wq, kq, bq; float rv[4], kv[4], vv[4];
#pragma unroll
                for (int j = 0; j < 4; ++j) {
                    const float rr = cr[j] + mr[j] * (er[j] - cr[j]), kx = ck[j] + mk[j] * (ek[j] - ck[j]), vx = cv[j] + mv[j] * (ev[j] - cv[j]);
                    const float sg = sigm(w04[j] + aw[ni][j]);
                    wq[j] = __expf(-0.6065306597f * sg);
                    const float aj = sigm(a04[j] + aa[ni][j]);
                    kq[j] = kx * kk4[j] * inv; bq[j] = kq[j] * aj;
                    kv[j] = kx * (1.f + (aj - 1.f) * ka4[j]); rv[j] = rr; vv[j] = vx;
                }
                *(f32x4*)(rec + 4 * i0) = wq; *(f32x4*)(rec + 256 + 4 * i0) = kq; *(f32x4*)(rec + 512 + 4 * i0) = bq;
                u32x4 rk; rk.x = pk2(rv[0], rv[1]); rk.y = pk2(rv[2], rv[3]); rk.z = pk2(kv[0], kv[1]); rk.w = pk2(kv[2], kv[3]);
                *(u32x4*)(rec + 768 + 4 * i0) = rk;
                u32x2 vp; vp.x = pk2(vv[0], vv[1]); vp.y = pk2(vv[2], vv[3]);
                *(u32x2*)(rec + 1024 + 2 * i0) = vp;
                u32x2 gp; gp.x = pk2(ag[ni][0], ag[ni][1]); gp.y = pk2(ag[ni][2], ag[ni][3]);
                *(u32x2*)(G + (size_t)row * 384 + c0) = gp;
            }
        }
    } else
#ifdef SK_PREP_L
    if (false)
#endif
    {
        const float* ba = a.in[I_BA] + l * 256; const float* bx = a.in[I_BX] + l * 256; const float* lam = a.in[I_LAM] + l * 256;
        bf16* LA = (bf16*)(ws + WS_LA); bf16* LU = (bf16*)(ws + WS_LU);
#pragma unroll 1
        for (int mi = mi_lo; mi < mi_hi; ++mi)
#pragma unroll 1
            for (int nn = 0; nn < 2; ++nn) {
                const int n = (wave - 6) * 2 + nn;
                f32x4 ar[4], ax[4];
#pragma unroll
                for (int ni = 0; ni < 4; ++ni) { ar[ni] = (f32x4){0.f, 0.f, 0.f, 0.f}; ax[ni] = ar[ni]; }
#pragma unroll
                for (int ks = 0; ks < 2; ++ks) { const bf16x8 Af = *(const LAS bf16x8*)(XC + (mi * 16 + fr) * 264 + n * 64 + ks * 32 + fq * 8);
#pragma unroll
                    for (int ni = 0; ni < 4; ++ni) { const int d = ni * 16 + fr;
                        ar[ni] = __builtin_amdgcn_mfma_f32_16x16x32_bf16(*(const bf16x8*)(WL + WL_WA + n * 4096 + d * 64 + ks * 32 + fq * 8), Af, ar[ni], 0, 0, 0);
                        ax[ni] = __builtin_amdgcn_mfma_f32_16x16x32_bf16(*(const bf16x8*)(WL + WL_WX + n * 4096 + d * 64 + ks * 32 + fq * 8), Af, ax[ni], 0, 0, 0); } }
                const int r = mi * 16 + fr, row = row0 + r;
#pragma unroll
                for (int ni = 0; ni < 4; ++ni) {
                    const int c0 = n * 64 + ni * 16 + fq * 4;
                    const f32x4 ba4 = *(const f32x4*)(ba + c0), bx4 = *(const f32x4*)(bx + c0), lm4 = *(const f32x4*)(lam + c0);
                    const u32x2 xu = *(const LAS u32x2*)(XC + r * 264 + c0);
                    const float xcv[4] = {bflo(xu.x), bfhi(xu.x), bflo(xu.y), bfhi(xu.y)};
                    float la[4], uu[4];
#pragma unroll
                    for (int j = 0; j < 4; ++j) {
                        const float rr = sigm(ar[ni][j] + ba4[j]), ii = sigm(ax[ni][j] + bx4[j]);
                        la[j] = -8.f * rr * log1pf(__expf(-lm4[j]));
                        uu[j] = xcv[j] * ii * sqrtf(fmaxf(-expm1f(2.f * la[j]), 1e-12f));
                    }
                    u32x2 o1, o2; o1.x = pk2(la[0], la[1]); o1.y = pk2(la[2], la[3]); o2.x = pk2(uu[0], uu[1]); o2.y = pk2(uu[2], uu[3]);
                    *(u32x2*)(LA + (size_t)row * 256 + c0) = o1; *(u32x2*)(LU + (size_t)row * 256 + c0) = o2;
                }
            }
    }
    __syncthreads();
}

DEV void phase_prep_old(const Args& a, int l, LAS unsigned char* lds, bool do_gelu = true) {
    const int tid = otid(), lane = tid & 63, wave = tid >> 6;
    const int gw = blockIdx.x * NWV + wave, NGW = gridDim.x * NWV;
    unsigned char* ws = a.ws;
    prep_tile_old(a, l, blockIdx.x, lds, do_gelu);
    if (blockIdx.x >= 248) { const int q = blockIdx.x - 248; prep_tile_old(a, l, 256 + (q >> 2), lds, do_gelu, q & 3, (q & 3) + 1); }
    const float* rss = (const float*)(ws + WS_RSE);
    for (int r = gw; r < 136; r += NGW) {
        const int row = r < 8 ? r * TT + TT - 1 : MP + (r - 8);
        const f32x4* src = (const f32x4*)(row < MP ? a.out + (size_t)row * DM : (const float*)(ws + WS_XS) + (size_t)(row - MP) * DM);
        f32x4* dst = (f32x4*)(r < 8 ? a.out + O_PSHIFT + (size_t)(l * 8 + r) * DM : a.out + O_SSHIFT + (size_t)(l * 128 + (r - 8)) * DM);
        const f32x4* g4 = (const f32x4*)(a.in[I_N1G] + l * DM);
        const float s = row_scale(rss, row);
#pragma unroll
        for (int j = 0; j < 4; ++j) { const f32x4 v = src[lane + 64 * j], g = g4[lane + 64 * j]; dst[lane + 64 * j] = (f32x4){v[0] * s * g[0], v[1] * s * g[1], v[2] * s * g[2], v[3] * s * g[3]}; }
    }
    if (l + 2 < 4) {
        bf16* U = (bf16*)(ws + ((l & 1) ? WS_U1 : WS_U0));
        for (int i = gw; i < 128; i += NGW) {
            const f32x4* src = (const f32x4*)(a.in[I_SSHIFT] + (size_t)((l + 2) * 128 + i) * DM);
            u32x2* ud = (u32x2*)(U + (size_t)(MREAL + i) * DM);
#pragma unroll
            for (int j = 0; j < 4; ++j) { const f32x4 v = src[lane + 64 * j]; u32x2 w; w.x = pk2(v[0], v[1]); w.y = pk2(v[2], v[3]); ud[lane + 64 * j] = w; }
        }
    }
    __syncthreads();
    LAS float* scr = (LAS float*)(lds + wave * 8448);
    if (blockIdx.x < 248) {
    const int NGW2 = 248 * NWV; int it = gw;
    transpose_job(a.in[I_WOUT] + (size_t)l * DM * DM, DM, DM, (bf16*)(ws + WS_WTOUT), it, NGW2, scr, lane);
    transpose_job(a.in[I_W1] + (size_t)l * DM * FF, DM, FF, (bf16*)(ws + WS_WT1), it, NGW2, scr, lane);
    transpose_job(a.in[I_W2] + (size_t)l * FF * DM, FF, DM, (bf16*)(ws + WS_WT2), it, NGW2, scr, lane);
    }
}

DEV void rwkv_scan_block(const Args& a, int l, int blk, LAS unsigned char* lds) {
    const int tid = otid(), lane = tid & 63, wave = __builtin_amdgcn_readfirstlane(tid >> 6);
    unsigned char* ws = a.ws;
    const int bh = blk >> 2, rg = blk & 3;
    const unsigned char* recbase = ws + WS_SCAN + (size_t)bh * TT * REC;
    constexpr int CH = 32, CHB = CH * REC, NCH = TT / CH;
    const int lt = tid - 256;
    u32x4 ra[9], rb[9];
#define RW_LOAD(dst, chunk) do { const u32x4* src_ = (const u32x4*)(recbase + (size_t)(chunk) * CHB); _Pragma("unroll") for (int q = 0; q < 9; ++q) dst[q] = src_[lt + 256 * q]; } while (0)
#define RW_STORE(srcv, buf) do { LAS unsigned char* d_ = lds + (buf) * CHB; _Pragma("unroll") for (int q = 0; q < 9; ++q) *(LAS u32x4*)(d_ + (lt + 256 * q) * 16) = srcv[q]; } while (0)
    if (wave >= 4) { RW_LOAD(ra, 0); RW_LOAD(rb, 1); RW_STORE(ra, 0); RW_LOAD(ra, 2); }
    __syncthreads();
    const int g = lane >> 4, j = lane & 15, rowv = rg * 16 + (wave & 3) * 4 + g;
    float S0 = 0.f, S1 = 0.f, S2 = 0.f, S3 = 0.f, keep = 0.f;
    bf16* outr = (bf16*)(ws + WS_OUTR) + (size_t)(bh * 64 + rowv) * TT;
#define RW_LD(W, K, B, RK, V, tl) do { const LAS unsigned char* rec_ = buf + (tl) * REC; W = *(const LAS f32x4*)(rec_ + 16 * j); K = *(const LAS f32x4*)(rec_ + 256 + 16 * j); \
        B = *(const LAS f32x4*)(rec_ + 512 + 16 * j); RK = *(const LAS u32x4*)(rec_ + 768 + 16 * j); V = *(const LAS unsigned short*)(rec_ + 1024 + 2 * rowv); } while (0)
#define RW_SCAN(c) do { const LAS unsigned char* buf = lds + ((c) & 1) * CHB; \
        f32x4 w4, k4, b4, nw, nk, nb; u32x4 rk, nrk; unsigned short vs, nvs; \
        RW_LD(w4, k4, b4, rk, vs, 0); nw = w4; nk = k4; nb = b4; nrk = rk; nvs = vs; \
        _Pragma("unroll 16") for (int tl = 0; tl < CH; ++tl) { \
            if (tl + 1 < CH) RW_LD(nw, nk, nb, nrk, nvs, tl + 1); \
            const float vv = bf2f(vs); \
            float sa = (S0 * k4[0] + S1 * k4[1]) + (S2 * k4[2] + S3 * k4[3]); \
            sa = -red16(sa); \
            S0 = S0 * w4[0] + (sa * b4[0] + vv * bflo(rk.z)); S1 = S1 * w4[1] + (sa * b4[1] + vv * bfhi(rk.z)); \
            S2 = S2 * w4[2] + (sa * b4[2] + vv * bflo(rk.w)); S3 = S3 * w4[3] + (sa * b4[3] + vv * bfhi(rk.w)); \
            float o = (S0 * bflo(rk.x) + S1 * bfhi(rk.x)) + (S2 * bflo(rk.y) + S3 * bfhi(rk.y)); \
            o = red16(o); \
            if (j == (tl & 15)) keep = o; \
            if ((tl & 15) == 15) outr[(c) * CH + (tl - 15) + j] = f2bf(keep); \
            w4 = nw; k4 = nk; b4 = nb; rk = nrk; vs = nvs; } } while (0)
#pragma unroll 1
    for (int c = 0; c < NCH; c += 2) {
        if (wave >= 4) { RW_STORE(rb, 1); if (c + 3 < NCH) RW_LOAD(rb, c + 3); }
        else RW_SCAN(c);
        __syncthreads();
        if (wave >= 4) { if (c + 2 < NCH) { RW_STORE(ra, 0); if (c + 4 < NCH) RW_LOAD(ra, c + 4); } }
        else RW_SCAN(c + 1);
        __syncthreads();
    }
#undef RW_LOAD
#undef RW_STORE
#undef RW_SCAN
#undef RW_LD
    if (wave < 4) { float* so = a.out + O_PWKV + ((size_t)(l * 48 + bh) * 64 + rowv) * 64 + 4 * j; *(f32x4*)so = (f32x4){S0, S1, S2, S3}; }
}

DEV void hgrn_scan_block(const Args& a, int l, int bh, LAS unsigned char* lds) {
    const int tid = otid(), lane = tid & 63, wave = __builtin_amdgcn_readfirstlane(tid >> 6);
    unsigned char* ws = a.ws;
    const int b = bh / 6, h = bh % 6;
    const bf16* P = (const bf16*)(ws + WS_P);
    bf16* mix = (bf16*)(ws + (((l + 1) & 1) ? WS_U1 : WS_U0));
    constexpr int PT = 72, ARR = 64 * PT * 2;
    LAS bf16* Qm = (LAS bf16*)lds; LAS bf16* Km = Qm + 64 * PT; LAS bf16* Qb = Km + 64 * PT; LAS bf16* KbT = Qb + 64 * PT; LAS bf16* VT = KbT + 64 * PT;
    LAS bf16* AT = VT + 64 * PT; LAS bf16* ST0 = AT + 64 * PT;
    LAS float* O = (LAS float*)(lds + 8 * ARR);
    LAS float* GT = O + 4096;
    LAS float* EB = GT + 512;
    const int k = lane, tg = wave;
    const float lb = ((const float*)(ws + WS_LBT))[l * 384 + h * 64 + k];
    const float ng = a.in[I_HNG][l * 384 + h * 64 + lane];
    const int fr = lane & 15, fq = lane >> 4;
    f32x4 Sacc[2];
    Sacc[0] = (f32x4){0.f, 0.f, 0.f, 0.f}; Sacc[1] = Sacc[0];
    {
        for (int i = tid; i < 64 * PT / 2; i += NT) ((LAS unsigned*)ST0)[i] = 0u;
    }
    __syncthreads();
#define HG_BAR() asm volatile("s_waitcnt lgkmcnt(0)\n\ts_barrier" ::: "memory")
    unsigned short nq[8], nf[8], nv[8], ngt[8];
#define HG_PREF(chunk) do { _Pragma("unroll") for (int i = 0; i < 8; ++i) { const bf16* pr_ = P + (size_t)(b * TT + (chunk) * 64 + tg * 8 + i) * NP + 1408 + h * 64 + k; \
        nq[i] = pr_[0]; nf[i] = pr_[384]; nv[i] = pr_[768]; ngt[i] = pr_[1152]; } } while (0)
    HG_PREF(0);
#pragma unroll 1
    for (int c = 0; c < TT / 64; ++c) {
        const int rowc = b * TT + c * 64;
        LAS bf16* STr = ST0 + (c & 1) * 64 * PT; LAS bf16* STw = ST0 + ((c + 1) & 1) * 64 * PT;
        float q[8], kin[8], cs[8], iv[8], gcur[8];
#pragma unroll
        for (int i = 0; i < 8; ++i) {
            q[i] = bf2f(nq[i]); const float fp = bf2f(nf[i]); iv[i] = bf2f(nv[i]); gcur[i] = bf2f(ngt[i]);
            const float sg = sigm(fp); kin[i] = (1.f - lb) * sigm(-fp); const float f = lb + (1.f - lb) * sg;
            cs[i] = __logf(f) + (i ? cs[i - 1] : 0.f); }
        if (c + 1 < TT / 64) HG_PREF(c + 1);
        GT[tg * 64 + k] = cs[7];
        HG_BAR();
        float off = 0.f, m = 0.f, bl = 0.f;
#pragma unroll
        for (int g2 = 0; g2 < 8; ++g2) { const float gv = GT[g2 * 64 + k]; if (g2 < tg) off += gv; if (g2 < 4) m += gv; bl += gv; }
        if (tg == 0) EB[k] = __expf(bl);
        {
            unsigned kb8[8], vt8[8];
#pragma unroll
            for (int i = 0; i < 8; ++i) { const int t = tg * 8 + i; const float bb = off + cs[i];
                Qm[t * PT + k] = f2bf(q[i] * __expf(bb - m)); Km[t * PT + k] = f2bf(kin[i] * __expf(m - bb)); Qb[t * PT + k] = f2bf(q[i] * __expf(bb));
                kb8[i] = f2bf(kin[i] * __expf(bl - bb)); vt8[i] = f2bf(iv[i]); }
            u32x4 w1, w2; w1.x = kb8[0] | (kb8[1] << 16); w1.y = kb8[2] | (kb8[3] << 16); w1.z = kb8[4] | (kb8[5] << 16); w1.w = kb8[6] | (kb8[7] << 16);
            w2.x = vt8[0] | (vt8[1] << 16); w2.y = vt8[2] | (vt8[3] << 16); w2.z = vt8[4] | (vt8[5] << 16); w2.w = vt8[6] | (vt8[7] << 16);
            *(LAS u32x4*)(KbT + k * PT + tg * 8) = w1; *(LAS u32x4*)(VT + k * PT + tg * 8) = w2;
        }
        HG_BAR();
        {
            const int tr = wave >> 1;
#pragma unroll
            for (int i = 0; i < 2; ++i) { const int sc = (wave & 1) * 2 + i;
                f32x4 acc = (f32x4){0.f, 0.f, 0.f, 0.f};
                if (sc <= tr) {
#pragma unroll
                    for (int ks = 0; ks < 2; ++ks) { const bf16x8 af = *(const LAS bf16x8*)(Km + (sc * 16 + fr) * PT + ks * 32 + fq * 8), bfr = *(const LAS bf16x8*)(Qm + (tr * 16 + fr) * PT + ks * 32 + fq * 8);
                        acc = __builtin_amdgcn_mfma_f32_16x16x32_bf16(af, bfr, acc, 0, 0, 0); }
                }
                const int t = tr * 16 + fr, s0 = sc * 16 + fq * 4;
                u32x2 w; w.x = pk2(s0 <= t ? acc[0] : 0.f, s0 + 1 <= t ? acc[1] : 0.f); w.y = pk2(s0 + 2 <= t ? acc[2] : 0.f, s0 + 3 <= t ? acc[3] : 0.f);
                *(LAS u32x2*)(AT + t * PT + s0) = w; }
        }
        HG_BAR();
        {
            const int tr = wave >> 1, kb = wave >> 1;
#pragma unroll
            for (int i = 0; i < 2; ++i) { const int vb = (wave & 1) * 2 + i;
                f32x4 acc = (f32x4){0.f, 0.f, 0.f, 0.f};
#pragma unroll
                for (int ks = 0; ks < 2; ++ks) {
                    if (ks * 2 <= tr) { const bf16x8 af = *(const LAS bf16x8*)(VT + (vb * 16 + fr) * PT + ks * 32 + fq * 8), bfr = *(const LAS bf16x8*)(AT + (tr * 16 + fr) * PT + ks * 32 + fq * 8);
                        acc = __builtin_amdgcn_mfma_f32_16x16x32_bf16(af, bfr, acc, 0, 0, 0); }
                    const bf16x8 a2 = *(const LAS bf16x8*)(STr + (vb * 16 + fr) * PT + ks * 32 + fq * 8), b2 = *(const LAS bf16x8*)(Qb + (tr * 16 + fr) * PT + ks * 32 + fq * 8);
                    acc = __builtin_amdgcn_mfma_f32_16x16x32_bf16(a2, b2, acc, 0, 0, 0); }
                *(LAS f32x4*)(O + (tr * 16 + fr) * 64 + vb * 16 + fq * 4) = acc;
                f32x4 kv = (f32x4){0.f, 0.f, 0.f, 0.f};
#pragma unroll
                for (int ks = 0; ks < 2; ++ks) { const bf16x8 af = *(const LAS bf16x8*)(KbT + (kb * 16 + fr) * PT + ks * 32 + fq * 8), bfr = *(const LAS bf16x8*)(VT + (vb * 16 + fr) * PT + ks * 32 + fq * 8);
                    kv = __builtin_amdgcn_mfma_f32_16x16x32_bf16(af, bfr, kv, 0, 0, 0); }
                const f32x4 eb = *(const LAS f32x4*)(EB + kb * 16 + fq * 4);
                Sacc[i][0] = eb[0] * Sacc[i][0] + kv[0]; Sacc[i][1] = eb[1] * Sacc[i][1] + kv[1]; Sacc[i][2] = eb[2] * Sacc[i][2] + kv[2]; Sacc[i][3] = eb[3] * Sacc[i][3] + kv[3];
                u32x2 w; w.x = pk2(Sacc[i][0], Sacc[i][1]); w.y = pk2(Sacc[i][2], Sacc[i][3]);
                *(LAS u32x2*)(STw + (vb * 16 + fr) * PT + kb * 16 + fq * 4) = w; }
        }
        HG_BAR();
#pragma unroll
        for (int itx = 0; itx < 8; ++itx) { const int t = wave * 8 + itx, row = rowc + t;
            const float o = O[t * 64 + lane];
            const float ss = wave_sum(o * o);
            const float gte = gcur[itx];
            mix[(size_t)row * DM + 384 + h * 64 + lane] = f2bf(o * rsqrtf(ss * (1.f / 64.f) + EPS) * ng * (gte * sigm(gte))); }
    }
#undef HG_BAR
#undef HG_PREF
    {
        const int kb = wave >> 1;
#pragma unroll
        for (int i = 0; i < 2; ++i) { const int vb = (wave & 1) * 2 + i;
            float* so = a.out + O_PHGRN + ((size_t)(l * 48 + bh) * 64 + kb * 16 + fq * 4) * 64 + vb * 16 + fr;
            so[0] = Sacc[i][0]; so[64] = Sacc[i][1]; so[128] = Sacc[i][2]; so[192] = Sacc[i][3]; }
    }
}

DEV void lru_scan_block(const Args& a, int l, int i, LAS unsigned char* lds) {
    const int tid = otid();
    unsigned char* ws = a.ws;
    const int b = i >> 1, cb = (i & 1) * 128;
    const bf16* P = (const bf16*)(ws + WS_P); const bf16* LA = (const bf16*)(ws + WS_LA); const bf16* LU = (const bf16*)(ws + WS_LU);
    bf16* mix = (bf16*)(ws + (((l + 1) & 1) ? WS_U1 : WS_U0));
    constexpr int TILE = 64 * 128 * 2;
    u32x4 rg[6];
#define LRU_LOAD(tile) do { _Pragma("unroll") for (int q = 0; q < 2; ++q) { const int p = tid + 512 * q; const size_t row = (size_t)b * TT + (tile) * 64 + (p >> 4); const int cc = cb + (p & 15) * 8; \
        rg[q] = *(const u32x4*)(LA + row * 256 + cc); rg[2 + q] = *(const u32x4*)(LU + row * 256 + cc); rg[4 + q] = *(const u32x4*)(P + row * NP + 3200 + cc); } } while (0)
#define LRU_STORE(buf) do { _Pragma("unroll") for (int q = 0; q < 2; ++q) { const int p = tid + 512 * q; \
        *(LAS u32x4*)(lds + (buf) * 3 * TILE + p * 16) = rg[q]; *(LAS u32x4*)(lds + (buf) * 3 * TILE + TILE + p * 16) = rg[2 + q]; { float g8_[8]; unpack8(rg[4 + q], g8_); _Pragma("unroll") for (int e_ = 0; e_ < 8; ++e_) g8_[e_] = gelu_t(g8_[e_]); u32x4 gw_; gw_.x = pk2(g8_[0], g8_[1]); gw_.y = pk2(g8_[2], g8_[3]); gw_.z = pk2(g8_[4], g8_[5]); gw_.w = pk2(g8_[6], g8_[7]); \
          *(LAS u32x4*)(lds + (buf) * 3 * TILE + 2 * TILE + p * 16) = gw_; } } } while (0)
    LRU_LOAD(0); LRU_STORE(0);
    __syncthreads();
    float h = 0.f;
#pragma unroll 1
    for (int tile = 0; tile < TT / 64; ++tile) {
        if (tile + 1 < TT / 64) LRU_LOAD(tile + 1);
        if (tid < 128) {
            const LAS unsigned short* la = (const LAS unsigned short*)(lds + (tile & 1) * 3 * TILE) + tid; const LAS unsigned short* lu = la + TILE / 2; const LAS unsigned short* gg = lu + TILE / 2;
            bf16* mo = mix + ((size_t)b * TT + tile * 64) * DM + 768 + cb + tid;
#pragma unroll 8
            for (int t = 0; t < 64; ++t) { h = __expf(bf2f(la[t * 128])) * h + bf2f(lu[t * 128]); mo[(size_t)t * DM] = f2bf(h * bf2f(gg[t * 128])); }
        }
        if (tile + 1 < TT / 64) LRU_STORE((tile + 1) & 1);
        __syncthreads();
    }
#undef LRU_LOAD
#undef LRU_STORE
    if (tid < 128) a.out[O_PLRU + (size_t)(l * 8 + b) * 256 + cb + tid] = h;
}

DEV void phase_post(const Args& a, int l, LAS unsigned char* lds) {
    const int tid = otid(), lane = tid & 63, wave = __builtin_amdgcn_readfirstlane(tid >> 6);
    unsigned char* ws = a.ws;
    const bf16* P = (const bf16*)(ws + WS_P); const bf16* G = (const bf16*)(ws + WS_G);
    bf16* mix = (bf16*)(ws + (((l + 1) & 1) ? WS_U1 : WS_U0));
    LAS unsigned short* OT = (LAS unsigned short*)lds;
    const float* lnw = a.in[I_LNW] + l * 384; const float* lnb = a.in[I_LNB] + l * 384; const float* rkp = a.in[I_RK] + l * 384;
#pragma unroll 1
    for (int item = blockIdx.x; item < 1536; item += gridDim.x) {
        const int b = item / 192, rem = item % 192, h = rem >> 5, t0 = (rem & 31) * 64, bh = b * 6 + h;
        { const int v = tid >> 3, seg = tid & 7; const u32x4 u = *(const u32x4*)((const bf16*)(ws + WS_OUTR) + (size_t)(bh * 64 + v) * TT + t0 + seg * 8);
          LAS unsigned* d = (LAS unsigned*)(OT + v * 66 + seg * 8); d[0] = u.x; d[1] = u.y; d[2] = u.z; d[3] = u.w; }
        __syncthreads();
        const float w_ = lnw[h * 64 + lane], b_ = lnb[h * 64 + lane], rk_ = rkp[h * 64 + lane];
#pragma unroll 2
        for (int q = 0; q < 8; ++q) {
            const int tt = wave * 8 + q, row = b * TT + t0 + tt;
            const float o = bf2f(OT[lane * 66 + tt]);
            const float mean = wave_sum(o) * (1.f / 64.f), d = o - mean, var = wave_sum(d * d) * (1.f / 64.f);
            const float gn = d * rsqrtf(var + 64e-5f) * w_ + b_;
            const unsigned char* rec = ws + WS_SCAN + ((size_t)bh * TT + t0 + tt) * REC;
            const float rr = bf2f(*(const unsigned short*)(rec + 768 + 16 * (lane >> 2) + 2 * (lane & 3))), kk = bf2f(*(const unsigned short*)(rec + 776 + 16 * (lane >> 2) + 2 * (lane & 3)));
            const float cb = wave_sum(rr * kk * rk_), vv = bf2f(*(const unsigned short*)(rec + 1024 + 2 * lane));
            const float gg = bf2f(G[(size_t)row * 384 + h * 64 + lane]);
            mix[(size_t)row * DM + h * 64 + lane] = f2bf((gn + cb * vv) * gg);
        }
        __syncthreads();
    }
    const int gw = __builtin_amdgcn_readfirstlane(blockIdx.x * NWV + wave), NGW = gridDim.x * NWV;
#pragma unroll 1
    for (int it = gw; it < 1664; it += NGW) {
        if (it < 768) {
            const int i = it / 6, h = it % 6, row = MP + i;
            const unsigned char* rec = ws + WS_SCANS + (size_t)(i * 6 + h) * REC;
            const float* s0 = a.in[I_SWKV] + ((size_t)((l * 128 + i) * 6 + h) * 64 + lane) * 64;
            float* s1 = a.out + O_SWKV + ((size_t)((l * 128 + i) * 6 + h) * 64 + lane) * 64;
            float sa = 0.f;
#pragma unroll 4
            for (int k4 = 0; k4 < 16; ++k4) { const f32x4 v = *(const f32x4*)(s0 + 4 * k4), kq = *(const f32x4*)(rec + 256 + 16 * k4);
                sa -= (v[0] * kq[0] + v[1] * kq[1]) + (v[2] * kq[2] + v[3] * kq[3]); }
            const float vv = bf2f(*(const unsigned short*)(rec + 1024 + 2 * lane));
            float o = 0.f, cb = 0.f;
#pragma unroll 4
            for (int k4 = 0; k4 < 16; ++k4) {
                f32x4 v = *(const f32x4*)(s0 + 4 * k4); const f32x4 w = *(const f32x4*)(rec + 16 * k4), bb = *(const f32x4*)(rec + 512 + 16 * k4), rk4 = *(const f32x4*)(rkp + h * 64 + 4 * k4);
                const u32x4 rk = *(const u32x4*)(rec + 768 + 16 * k4);
                const float rr[4] = {bflo(rk.x), bfhi(rk.x), bflo(rk.y), bfhi(rk.y)}, kx[4] = {bflo(rk.z), bfhi(rk.z), bflo(rk.w), bfhi(rk.w)};
#pragma unroll
                for (int e = 0; e < 4; ++e) { v[e] = v[e] * w[e] + (sa * bb[e] + vv * kx[e]); o += v[e] * rr[e]; cb += rr[e] * kx[e] * rk4[e]; }
                *(f32x4*)(s1 + 4 * k4) = v; }
            const float mean = wave_sum(o) * (1.f / 64.f), d = o - mean, var = wave_sum(d * d) * (1.f / 64.f);
            const float gn = d * rsqrtf(var + 64e-5f) * lnw[h * 64 + lane] + lnb[h * 64 + lane];
            const float gg = bf2f(G[(size_t)row * 384 + h * 64 + lane]);
            mix[(size_t)row * DM + h * 64 + lane] = f2bf((gn + cb * vv) * gg);
        } else if (it < 1536) {
            const int i = (it - 768) / 6, h = (it - 768) % 6, row = MP + i;
            const bf16* pr = P + (size_t)row * NP + 1408 + h * 64;
            const float* s0 = a.in[I_SHGRN] + (size_t)((l * 128 + i) * 6 + h) * 4096 + lane;
            float* s1 = a.out + O_SHGRN + (size_t)((l * 128 + i) * 6 + h) * 4096 + lane;
            const float* lbt = (const float*)(ws + WS_LBT) + l * 384 + h * 64;
            const float iv = bf2f(pr[768 + lane]); float o = 0.f;
#pragma unroll 8
            for (int k = 0; k < 64; ++k) { const float q = bf2f(pr[k]), fp = bf2f(pr[384 + k]), lb = lbt[k];
                const float f = lb + (1.f - lb) * sigm(fp), ki = (1.f - lb) * sigm(-fp);
                const float s = f * s0[k * 64] + ki * iv; s1[k * 64] = s; o += q * s; }
            const float ss = wave_sum(o * o), gte = bf2f(pr[1152 + lane]);
            mix[(size_t)row * DM + 384 + h * 64 + lane] = f2bf(o * rsqrtf(ss * (1.f / 64.f) + EPS) * a.in[I_HNG][l * 384 + h * 64 + lane] * (gte * sigm(gte)));
        } else {
            const int i = it - 1536, row = MP + i;
#pragma unroll
            for (int q = 0; q < 4; ++q) { const int c = lane + 64 * q;
                const float la = bf2f(((const bf16*)(ws + WS_LA))[(size_t)row * 256 + c]), u = bf2f(((const bf16*)(ws + WS_LU))[(size_t)row * 256 + c]);
                const float hh = __expf(la) * a.in[I_SLRU][(size_t)(l * 128 + i) * 256 + c] + u;
                a.out[O_SLRU + (size_t)(l * 128 + i) * 256 + c] = hh;
                mix[(size_t)row * DM + 768 + c] = f2bf(hh * gelu_t(bf2f(P[(size_t)row * NP + 3200 + c]))); }
        }
    }
    if (l + 1 < 4) {
        __syncthreads();
        LAS float* scr = (LAS float*)(lds + wave * 8448);
        int it = gw;
        transpose_job(a.in[I_WIN] + (size_t)(l + 1) * DM * 3456, DM, 3456, (bf16*)(ws + WS_WTIN), it, NGW, scr, lane);
    }
}

DEV void phase_final(const Args& a) {
    const int tid = otid(), lane = tid & 63, wave = tid >> 6;
    const int gw = blockIdx.x * NWV + wave, NGW = gridDim.x * NWV;
    const float* rss = (const float*)(a.ws + WS_RSE);
    const f32x4* g4 = (const f32x4*)a.in[I_FG];
    for (int row = gw; row < MREAL; row += NGW) {
        const f32x4* src = (const f32x4*)(row < MP ? a.out + (size_t)row * DM : (const float*)(a.ws + WS_XS) + (size_t)(row - MP) * DM);
        f32x4* dst = (f32x4*)(a.out + (size_t)row * DM);
        const float s = row_scale(rss, row);
#pragma unroll
        for (int j = 0; j < 4; ++j) { const f32x4 v = src[lane + 64 * j], g = g4[lane + 64 * j]; dst[lane + 64 * j] = (f32x4){v[0] * s * g[0], v[1] * s * g[1], v[2] * s * g[2], v[3] * s * g[3]}; }
    }
}

constexpr size_t WS_PART = 232 * MiB;
struct EpiPart {
    static constexpr bool PERM = false, AFTER_DRAIN = false;
    float* O;
    DEV void operator()(const pg8::f32x4 (&acc)[2][2][4][2], const pg8::Unit& u, int wr, int wc, int fr, int fq) const {
        const int col0 = u.pn * 256 + wc * 32 + 4 * fq;
#pragma unroll
        for (int m = 0; m < 4; ++m) { const int row = wr * 64 + fr + m * 16;
            float* rp_ = O + (size_t)row * DM + col0;
#pragma unroll
            for (int bj = 0; bj < 2; ++bj)
#pragma unroll
                for (int n = 0; n < 2; ++n) { const pg8::f32x4 v = acc[0][bj][m][n]; *(f32x4*)(rp_ + bj * 128 + n * 16) = (f32x4){v[0], v[1], v[2], v[3]}; } }
    }
};
struct OneUnit {
    int pn;
    DEV bool next(int i, pg8::Unit& u) const { if (i) return false; u.pm = 0; u.pn = pn; return true; }
    DEV void a_ready(const pg8::Unit&) const {}
    DEV void done(const pg8::Unit&) const {}
};
DEV void phase_sample_reduce(const Args& a, bf16* U, const float* g, float* rs) {
    const int tid = otid(), lane = tid & 63, wave = tid >> 6;
    const int gw = blockIdx.x * NWV + wave;
    if (gw >= 128) return;
    const float* part = (const float*)(a.ws + WS_PART);
    f32x4* xr = (f32x4*)((float*)(a.ws + WS_XS) + (size_t)gw * DM);
    u32x2* ud = (u32x2*)(U + (size_t)(MP + gw) * DM);
    const f32x4* g4 = (const f32x4*)g;
    float ss = 0.f;
#pragma unroll
    for (int j = 0; j < 4; ++j) { const int o = lane + 64 * j;
        f32x4 x = xr[o];
        const f32x4 p0 = ((const f32x4*)(part + (size_t)(0 * 128 + gw) * DM))[o], p1 = ((const f32x4*)(part + (size_t)(1 * 128 + gw) * DM))[o],
                    p2 = ((const f32x4*)(part + (size_t)(2 * 128 + gw) * DM))[o], p3 = ((const f32x4*)(part + (size_t)(3 * 128 + gw) * DM))[o];
#pragma unroll
        for (int e = 0; e < 4; ++e) x[e] += (p0[e] + p1[e]) + (p2[e] + p3[e]);
        xr[o] = x; ss += (x[0] * x[0] + x[1] * x[1]) + (x[2] * x[2] + x[3] * x[3]);
        const f32x4 gv = g4[o]; u32x2 w; w.x = pk2(x[0] * gv[0], x[1] * gv[1]); w.y = pk2(x[2] * gv[2], x[3] * gv[3]); ud[o] = w; }
    ss = wave_sum(ss);
    if (lane < 16) rs[(size_t)(MP + gw) * 16 + lane] = lane == 0 ? ss : 0.f;
}

#define XB_TMO      128
#define XB_XCNT(j)  (256  + 64 * (j))
#define XB_XSUB(j)  (1280 + 64 * (j))
#define XB_XGEN(j)  (2304 + 64 * (j))
#define XB_TOP      3328
#define XB_TOPGEN   3392
#define XCD_BAR_WORDS 3456
#define XB_SPIN_CAP (1u << 22)

__device__ __forceinline__ unsigned xb_ld(unsigned* p)              { return __hip_atomic_load(p, __ATOMIC_RELAXED, __HIP_MEMORY_SCOPE_AGENT); }
__device__ __forceinline__ unsigned xb_add(unsigned* p, unsigned v) { return __hip_atomic_fetch_add(p, v, __ATOMIC_RELAXED, __HIP_MEMORY_SCOPE_AGENT); }
__device__ __forceinline__ unsigned xb_xcc_id() { return (unsigned)__builtin_amdgcn_s_getreg((3 << 11) | 20) & 0xFu; }
#define XB_SPIN(cond, bar) do { unsigned _sp = 0; while (cond) { __builtin_amdgcn_s_sleep(1); \
    if ((++_sp & 255u) == 0u) { if (xb_ld(&(bar)[XB_TMO])) break; if (_sp > XB_SPIN_CAP) { atomicAdd(&(bar)[XB_TMO], 1u); break; } } } } while (0)

struct XcdBarrier {
    unsigned* bar; unsigned x;
    volatile LAS unsigned* st;
};

__device__ __forceinline__ XcdBarrier xcd_barrier_post(unsigned* bar, volatile LAS unsigned* st) {
    XcdBarrier b; b.bar = bar; b.x = xb_xcc_id(); b.st = st;
    if (threadIdx.x == 0) (void)xb_add(&bar[XB_XCNT(b.x)], 1u);
    return b;
}
__device__ __forceinline__ void xcd_barrier_complete(unsigned* bar, unsigned x, unsigned& nloc, unsigned& nx) {
    const unsigned G = gridDim.x * gridDim.y * gridDim.z;
    unsigned sum, cnt, mine, sp = 0u;
    for (;;) {
        sum = 0u; cnt = 0u; mine = 0u;
#pragma unroll
        for (unsigned j = 0; j < 16; ++j) { const unsigned c = xb_ld(&bar[XB_XCNT(j)]); sum += c; cnt += (c > 0u) ? 1u : 0u; mine = (j == x) ? c : mine; }
        if (sum == G) break;
        __builtin_amdgcn_s_sleep(1);
        if ((++sp & 255u) == 0u) { if (xb_ld(&bar[XB_TMO])) break; if (sp > XB_SPIN_CAP) { atomicAdd(&bar[XB_TMO], 1u); break; } }
    }
    nloc = mine > 0u ? mine : 1u; nx = cnt > 0u ? cnt : 1u;
}

__device__ __forceinline__ void xcd_barrier(const XcdBarrier& b) {
    asm volatile("s_waitcnt vmcnt(0)" ::: "memory");
    __syncthreads();
    if (otid() == 0) {
        unsigned* bar = b.bar;
        __builtin_amdgcn_s_waitcnt(0);
        unsigned nloc = b.st[0], nx = b.st[1];
        if (nloc == 0u) { xcd_barrier_complete(bar, b.x, nloc, nx); b.st[0] = nloc; b.st[1] = nx; }
        const unsigned old = xb_add(&bar[XB_XSUB(b.x)], 1u);
        const unsigned gen = old / nloc;
        if (old + 1u == (gen + 1u) * nloc) {
            __builtin_amdgcn_fence(__ATOMIC_RELEASE, "agent");
            asm volatile("s_waitcnt vmcnt(0)" ::: "memory");
            const unsigned og = xb_add(&bar[XB_TOP], 1u);
            const unsigned tg = og / nx;
            if (og + 1u == (tg + 1u) * nx) xb_add(&bar[XB_TOPGEN], 1u);
            else XB_SPIN(xb_ld(&bar[XB_TOPGEN]) == tg, bar);
            __builtin_amdgcn_fence(__ATOMIC_ACQUIRE, "agent");
            xb_add(&bar[XB_XGEN(b.x)], 1u);
            asm volatile("s_waitcnt vmcnt(0)" ::: "memory");
        } else {
            XB_SPIN(xb_ld(&bar[XB_XGEN(b.x)]) == gen, bar);
            __builtin_amdgcn_fence(__ATOMIC_ACQUIRE, "agent");
            asm volatile("s_waitcnt vmcnt(0)" ::: "memory");
        }
    }
    __syncthreads();
}

__global__ void __launch_bounds__(NT, 2) mega_fwd(Args a) {
    extern __shared__ __attribute__((aligned(16))) unsigned char lds_raw[];
    LAS unsigned char* lds = (LAS unsigned char*)lds_raw;
    cg::grid_group grid = cg::this_grid();
    volatile LAS unsigned* st = (volatile LAS unsigned*)(lds + LDS_BYTES - 16);
    if (threadIdx.x < 4) st[threadIdx.x] = 0u;
    __syncthreads();
    { const XcdBarrier b0 = xcd_barrier_post((unsigned*)(a.ws + WS_BAR), st); if (threadIdx.x == 0) st[2] = b0.x; }
#define GRID_BAR() do { XcdBarrier b_; b_.bar = (unsigned*)(a.ws + WS_BAR); b_.st = (volatile LAS unsigned*)(lds + LDS_BYTES - 16); b_.x = otid() == 0 ? b_.st[2] : 0u; xcd_barrier(b_); } while (0)
    grid.sync();
#ifndef SK_P0
    phase0(a, lds);
#endif
    GRID_BAR();
#pragma unroll 1
    for (int l = 0; l < 4; ++l) {
#define Ua ((bf16*)(a.ws + ((l & 1) ? WS_U1 : WS_U0)))
#define Ub ((bf16*)(a.ws + ((l & 1) ? WS_U0 : WS_U1)))
#define rse ((float*)(a.ws + WS_RSE))
#define rso ((float*)(a.ws + WS_RSO))
        {
            pg8::Gemm g{Ua, (const bf16*)(a.ws + WS_WTIN), MT, NP, DM}; pg8::StaticOrder S; S.init(MT, NP, gridDim.x, oblk());
            EpiP E{(bf16*)(a.ws + WS_P), rse};
#ifndef SK_G1
            pg8::gemm_phase<EpiP, pg8::StaticOrder, true, true>(lds, g, S, E);
#ifdef DUP_G1
            GRID_BAR(); pg8::gemm_phase<EpiP, pg8::StaticOrder, true, true>(lds, g, S, E);
#endif
#endif
        }
        GRID_BAR();
#ifndef SK_PREP
#ifdef OLD_FIRST
        phase_prep_old(a, l, lds); GRID_BAR();
#endif
#ifdef ONLY_OLD
        phase_prep_old(a, l, lds);
#else
        phase_prep(a, l, lds);
#endif
#ifdef OLD_AFTER
        GRID_BAR(); phase_prep_old(a, l, lds);
#endif
#ifdef DUP_PREP
        GRID_BAR(); phase_prep(a, l, lds, false);
#endif
#endif
        GRID_BAR();
#ifndef SK_RWKV
        if (oblk() < 192) rwkv_scan_block(a, l, oblk(), lds);
#endif
#ifndef SK_HGRN
        if (oblk() >= 192 && oblk() < 240) hgrn_scan_block(a, l, oblk() - 192, lds);
#endif
#ifndef SK_LRU
        if (oblk() >= 240) lru_scan_block(a, l, oblk() - 240, lds);
#endif
#ifdef DUP_RWKV
        GRID_BAR(); if (oblk() < 192) rwkv_scan_block(a, l, oblk(), lds);
#endif
#ifdef DUP_HGRN
        GRID_BAR(); if (oblk() >= 192 && oblk() < 240) hgrn_scan_block(a, l, oblk() - 192, lds);
#endif
#ifdef DUP_LRU
        GRID_BAR(); if (oblk() >= 240) lru_scan_block(a, l, oblk() - 240, lds);
#endif
        GRID_BAR();
#ifndef SK_POST
        phase_post(a, l, lds);
#ifdef DUP_POST
        GRID_BAR(); phase_post(a, l, lds);
#endif
#endif
        GRID_BAR();
        {
            pg8::Gemm g{Ub, (const bf16*)(a.ws + WS_WTOUT), MT, DM, DM}; pg8::StaticOrder S; S.init(MT, DM, gridDim.x, oblk());
            EpiX E{a.out, (float*)(a.ws + WS_XS), Ua, a.in[I_N2G] + l * DM, rso};
#ifndef SK_GX
            pg8::gemm_phase<EpiX, pg8::StaticOrder, true, true, 64>(lds, g, S, E);
#endif
        }
        GRID_BAR();
        {
            pg8::Gemm g{Ua, (const bf16*)(a.ws + WS_WT1), MT, FF, DM}; pg8::StaticOrder S; S.init(MT, FF, gridDim.x, oblk());
            EpiH E{(bf16*)(a.ws + WS_H), rso};
#ifndef SK_G6
            pg8::gemm_phase<EpiH, pg8::StaticOrder, true, true, 64>(lds, g, S, E);
#ifdef DUP_G6
            GRID_BAR(); pg8::gemm_phase<EpiH, pg8::StaticOrder, true, true, 64>(lds, g, S, E);
#endif
#endif
        }
        GRID_BAR();
        {
            pg8::Gemm g{(const bf16*)(a.ws + WS_H), (const bf16*)(a.ws + WS_WT2), MP, DM, FF}; pg8::StaticOrder S; S.init(MP, DM, gridDim.x, oblk());
            EpiX E{a.out, (float*)(a.ws + WS_XS), Ub, l < 3 ? a.in[I_N1G] + (l + 1) * DM : a.in[I_FG], rse};
#ifndef SK_GX
            pg8::gemm_phase<EpiX, pg8::StaticOrder, true, true, 64>(lds, g, S, E);
#endif
            if (oblk() < 16) {
                const int ks = oblk() >> 2;
                pg8::Gemm g2{(const bf16*)(a.ws + WS_H) + (size_t)MP * FF + ks * 1024, (const bf16*)(a.ws + WS_WT2) + ks * 1024, 256, DM, 1024, FF};
                OneUnit S2{oblk() & 3}; EpiPart E2{(float*)(a.ws + WS_PART) + (size_t)ks * 128 * DM};
                pg8::gemm_phase<EpiPart, OneUnit, true, true, 0>(lds, g2, S2, E2);
            }
        }
        GRID_BAR();
        phase_sample_reduce(a, Ub, l < 3 ? a.in[I_N1G] + (l + 1) * DM : a.in[I_FG], rse);
        GRID_BAR();
    }
    phase_final(a);
}

extern "C" void kernel_launch(void* const* d_in, const int* in_sizes, int n_in, void* d_out, int out_size, void* d_ws, size_t ws_size, hipStream_t stream) {
    static int grid = 0;
    if (grid == 0) {
        int dev = 0, cus = 0;
        if (n_in != N_IN || ws_size < WS_END || out_size != 44761088) { fprintf(stderr, "kernel_launch: unexpected problem: n_in %d ws %zu (need %zu) out %d\n", n_in, ws_size, (size_t)WS_END, out_size); grid = -1; return; }
        if (hipGetDevice(&dev) != hipSuccess || hipDeviceGetAttribute(&cus, hipDeviceAttributeMultiprocessorCount, dev) != hipSuccess) { grid = -1; return; }
        if (hipFuncSetAttribute((const void*)mega_fwd, hipFuncAttributeMaxDynamicSharedMemorySize, LDS_BYTES) != hipSuccess) { fprintf(stderr, "kernel_launch: hipFuncSetAttribute failed\n"); grid = -1; return; }
        if (cus != 256) fprintf(stderr, "kernel_launch: %d CUs (built for 256)\n", cus);
        grid = 256;
    }
    if (grid < 0) return;
#ifdef DBG_POISON
    (void)hipMemsetAsync(d_ws, 0xAA, WS_END, stream); (void)hipMemsetAsync(d_out, 0xAA, (size_t)out_size * 4, stream);
#endif
    if (hipMemsetAsync((char*)d_ws + WS_BAR, 0, BAR_BYTES, stream) != hipSuccess) { fprintf(stderr, "kernel_launch: memset failed\n"); return; }
    Args a{};
    for (int i = 0; i < N_IN; ++i) a.in[i] = (const float*)d_in[i];
    a.out = (float*)d_out; a.ws = (unsigned char*)d_ws;
    void* args[] = {&a};
    hipError_t e = hipLaunchCooperativeKernel((const void*)mega_fwd, dim3(grid), dim3(NT), args, LDS_BYTES, stream);
    if (e != hipSuccess) fprintf(stderr, "kernel_launch: cooperative launch failed: %s\n", hipGetErrorString(e));
}
```

```cpp
#define ONLY_OLD 1
#include <hip/hip_runtime.h>
#include <hip/hip_cooperative_groups.h>
#include <cstdio>
#include <cstdint>
namespace cg = cooperative_groups;
namespace pg8 {
#define PG8_LAS __attribute__((address_space(3)))
typedef unsigned short bf16_t;
typedef short bf16x8 __attribute__((ext_vector_type(8)));
typedef float f32x4 __attribute__((ext_vector_type(4)));
typedef unsigned u32x4 __attribute__((ext_vector_type(4)));
constexpr int BM = 256, BK = 64, HALF = 128, HTB = HALF * BK * 2  , STAGE_BYTES = 8 * HTB, NXCD = 8, WGM = 8;

__host__ __device__ __forceinline__ int lds_byte(int r, int c) { const int st = (r >> 4) * 2 + (c >> 5), rr = r & 15, cc = c & 31, ob = rr * 64 + cc * 2; return st * 1024 + (ob ^ (((ob >> 9) & 1) << 5)); }
__host__ __device__ __forceinline__ void stage_rc(int b, int& R, int& C) { const int st = b / 1024, sb = b % 1024, swz = sb ^ (((sb >> 9) & 1) << 5); R = (st >> 1) * 16 + swz / 64; C = (st & 1) * 32 + (swz % 64) / 2; }
__host__ __device__ __forceinline__ int perm32(int rho) { const int n = rho >> 4, i = rho & 15; return 8 * (i >> 2) + 4 * n + (i & 3); }

struct Unit { int pm, pn; };
struct Gemm { const bf16_t* A; const bf16_t* Bt; int M, N, K; int ld = 0; };

struct StaticOrder {
    int nM, nN, nwg, G, c;
    __host__ __device__ void init(int M, int N, int G_, int c_) { nM = M / BM; nN = N / BM; nwg = nM * nN; G = G_; c = c_; }
    __host__ __device__ bool next(int i, Unit& u) const {
        const long L = (long)i * G + c; if (L >= nwg) return false;
        int wgid = (int)L; { const int q = nwg / NXCD, r = nwg % NXCD, xcd = wgid % NXCD, off = wgid / NXCD; wgid = (xcd < r ? xcd * (q + 1) : r * (q + 1) + (xcd - r) * q) + off; }
        const int nig = WGM * nN, gid = wgid / nig, fm = gid * WGM, gsz = (nM - fm) < WGM ? (nM - fm) : WGM;
        u.pm = fm + ((wgid % nig) % gsz); u.pn = (wgid % nig) / gsz; return true;
    }
    __device__ __forceinline__ void a_ready(const Unit&) const {}
    __device__ __forceinline__ void done(const Unit&) const {}
};

__device__ __forceinline__ unsigned cvt_pk_bf16(float lo, float hi) { unsigned r; asm volatile("v_cvt_pk_bf16_f32 %0, %1, %2" : "=v"(r) : "v"(lo), "v"(hi)); return r; }
typedef float f32x2 __attribute__((ext_vector_type(2)));
template <class Epi, class Sched, bool ALIGN_EPI = false, bool SP2 = false, int HALF_PM = -1>
__device__ __forceinline__ void gemm_phase(PG8_LAS unsigned char* lds, const Gemm g, const Sched& S, const Epi& E) {
    int tid_ = threadIdx.x; asm volatile("" : "+v"(tid_)); const int tid = tid_, wid = __builtin_amdgcn_readfirstlane(tid >> 6), lane = tid & 63, wr = wid >> 2, wc = wid & 3, fr = lane & 15, fq = lane >> 4;
    const int K = g.K, nt = K / BK, LD = g.ld ? g.ld : g.K;
    unsigned voffA[2], voffB[2];
#pragma unroll
    for (int i = 0; i < 2; ++i) { int R, C; stage_rc(tid * 16 + i * 8192, R, C); const int Rb = Epi::PERM ? ((R & ~31) + perm32(R & 31)) : R;
        voffA[i] = (unsigned)(R * LD + C) * 2u; voffB[i] = (unsigned)(Rb * LD + C) * 2u; }
    const size_t kstep = (size_t)(BK * 2);
    const size_t hstep = (size_t)HALF * LD * 2;
    const size_t tstep = 2 * hstep;
    const unsigned ldsw = (unsigned)wid * 1024u;
    const int aoff = lds_byte(wr * 64 + fr, fq * 8), boff = lds_byte(wc * 32 + fr, fq * 8);
#define PG8_SA(b, h) (((b) * 2 + (h)) * HTB)
#define PG8_SB(b, h) ((4 + (b) * 2 + (h)) * HTB)
#define PG8_STAGE(bufoff, gbase, voff) do { _Pragma("unroll") for (int _i = 0; _i < 2; ++_i) \
        __builtin_amdgcn_global_load_lds((const unsigned*)((const char*)(gbase) + (voff)[_i]), (PG8_LAS unsigned*)(lds + (bufoff) + ldsw + _i * 8192), 16, 0, 0); } while (0)
#define PG8_LDA(dst, b, h) do { _Pragma("unroll") for (int m = 0; m < 4; ++m) _Pragma("unroll") for (int k = 0; k < 2; ++k) dst[m][k] = *(const PG8_LAS bf16x8*)(lds + PG8_SA(b, h) + aoff + m * 2048 + k * 1024); } while (0)
#define PG8_LDB(dst, b, h) do { _Pragma("unroll") for (int n = 0; n < 2; ++n) _Pragma("unroll") for (int k = 0; k < 2; ++k) dst[n][k] = *(const PG8_LAS bf16x8*)(lds + PG8_SB(b, h) + boff + n * 2048 + k * 1024); } while (0)
#define PG8_MMA(ai, bj, At, Bt) do { __builtin_amdgcn_s_setprio(1); _Pragma("unroll") for (int m = 0; m < 4; ++m) _Pragma("unroll") for (int n = 0; n < 2; ++n) _Pragma("unroll") for (int k = 0; k < 2; ++k) \
        acc[ai][bj][m][n] = __builtin_amdgcn_mfma_f32_16x16x32_bf16(Bt[n][k], At[m][k], acc[ai][bj][m][n], 0, 0, 0); __builtin_amdgcn_s_setprio(0); } while (0)
#define PG8_WAIT_V(n) asm volatile("s_waitcnt vmcnt(" #n ")" ::: "memory")
#define PG8_WAIT_L(n) asm volatile("s_waitcnt lgkmcnt(" #n ")" ::: "memory")
#define PG8_BAR __builtin_amdgcn_s_barrier()
#define PG8_SCHED __builtin_amdgcn_sched_barrier(0)
    Unit cur, nxt; int ui = 0;
    if (!S.next(0, cur)) return;
    f32x4 acc[2][2][4][2];
#pragma unroll
    for (int a = 0; a < 2; ++a)
#pragma unroll
        for (int b = 0; b < 2; ++b)
#pragma unroll
            for (int m = 0; m < 4; ++m)
#pragma unroll
                for (int n = 0; n < 2; ++n) acc[a][b][m][n] = (f32x4){0.f, 0.f, 0.f, 0.f};
    bf16x8 At[4][2], B0[2][2], B1[2][2];
    const char* cA = (const char*)g.A + (size_t)cur.pm * tstep; const char* cB = (const char*)g.Bt + (size_t)cur.pn * tstep;
    S.a_ready(cur);
    if constexpr (SP2) {
        PG8_STAGE(PG8_SB(0, 0), cB, voffB); PG8_STAGE(PG8_SB(0, 1), cB + hstep, voffB); PG8_STAGE(PG8_SA(0, 0), cA, voffA); PG8_STAGE(PG8_SA(0, 1), cA + hstep, voffA);
        if (wr == 1) PG8_BAR;
        PG8_WAIT_V(2); PG8_BAR;
        PG8_STAGE(PG8_SB(1, 0), cB + kstep, voffB); PG8_STAGE(PG8_SA(1, 0), cA + kstep, voffA); PG8_STAGE(PG8_SB(1, 1), cB + hstep + kstep, voffB);
        PG8_WAIT_V(6); PG8_BAR;
    } else {
        PG8_STAGE(PG8_SB(0, 0), cB, voffB); PG8_STAGE(PG8_SA(0, 0), cA, voffA); PG8_STAGE(PG8_SB(0, 1), cB + hstep, voffB); PG8_STAGE(PG8_SA(0, 1), cA + hstep, voffA);
        if (wr == 1) PG8_BAR;
        PG8_WAIT_V(4); PG8_BAR;
        PG8_STAGE(PG8_SB(1, 0), cB + kstep, voffB); PG8_STAGE(PG8_SA(1, 0), cA + kstep, voffA); PG8_STAGE(PG8_SB(1, 1), cB + hstep + kstep, voffB);
        PG8_WAIT_V(6); PG8_BAR;
    }
    for (;;) {
        const bool has_next = S.next(ui + 1, nxt);
        const char* nA = has_next ? (const char*)g.A + (size_t)nxt.pm * tstep : cA; const char* nB = has_next ? (const char*)g.Bt + (size_t)nxt.pn * tstep : cB;
        for (int t = 0; t < nt; t += 2) {
            const bool last = (t == nt - 2);
            const char* a1 = cA + (size_t)(t + 1) * kstep;
            const char* a2 = last ? nA : cA + (size_t)(t + 2) * kstep; const char* b2 = last ? nB : cB + (size_t)(t + 2) * kstep;
            const char* a3 = a2 + kstep; const char* b3 = b2 + kstep;
            if (last && has_next) S.a_ready(nxt);
            if constexpr (SP2) {
            PG8_LDB(B0, 0, 0); PG8_LDB(B1, 0, 1); PG8_SCHED; PG8_LDA(At, 0, 0); PG8_STAGE(PG8_SA(1, 1), a1 + hstep, voffA);
            PG8_WAIT_V(8); PG8_WAIT_L(0); PG8_BAR; PG8_MMA(0, 0, At, B0); PG8_MMA(0, 1, At, B1); PG8_BAR; PG8_SCHED;
            PG8_LDA(At, 0, 1); PG8_STAGE(PG8_SB(0, 0), b2, voffB); PG8_STAGE(PG8_SB(0, 1), b2 + hstep, voffB); PG8_STAGE(PG8_SA(0, 0), a2, voffA);
            PG8_WAIT_V(8); PG8_WAIT_L(0); PG8_BAR; if (cur.pm != HALF_PM) { PG8_MMA(1, 0, At, B0); PG8_MMA(1, 1, At, B1); } PG8_BAR; PG8_SCHED;
            PG8_LDB(B0, 1, 0); PG8_LDB(B1, 1, 1); PG8_SCHED; PG8_LDA(At, 1, 0); PG8_STAGE(PG8_SA(0, 1), a2 + hstep, voffA);
            PG8_WAIT_V(8); PG8_WAIT_L(0); PG8_BAR; PG8_MMA(0, 0, At, B0); PG8_MMA(0, 1, At, B1); PG8_BAR; PG8_SCHED;
            PG8_LDA(At, 1, 1); PG8_STAGE(PG8_SB(1, 0), b3, voffB); PG8_STAGE(PG8_SB(1, 1), b3 + hstep, voffB); PG8_STAGE(PG8_SA(1, 0), a3, voffA);
            PG8_WAIT_V(8); PG8_WAIT_L(0); PG8_BAR; if (cur.pm != HALF_PM) { PG8_MMA(1, 0, At, B0); PG8_MMA(1, 1, At, B1); } PG8_BAR; PG8_SCHED;
            } else {
            PG8_LDB(B0, 0, 0); PG8_SCHED; PG8_LDA(At, 0, 0); PG8_STAGE(PG8_SA(1, 1), a1 + hstep, voffA);
            PG8_WAIT_L(8); PG8_BAR; PG8_WAIT_L(0); PG8_MMA(0, 0, At, B0); PG8_BAR; PG8_SCHED;
            PG8_LDB(B1, 0, 1); PG8_STAGE(PG8_SB(0, 0), b2, voffB);
            PG8_BAR; PG8_WAIT_L(0); PG8_MMA(0, 1, At, B1); PG8_BAR;
            PG8_LDA(At, 0, 1); PG8_STAGE(PG8_SA(0, 0), a2, voffA);
            PG8_BAR; PG8_WAIT_L(0); PG8_MMA(1, 0, At, B0); PG8_BAR; PG8_SCHED;
            PG8_STAGE(PG8_SB(0, 1), b2 + hstep, voffB);
            PG8_WAIT_V(6); PG8_BAR; PG8_MMA(1, 1, At, B1); PG8_BAR;
            PG8_LDB(B0, 1, 0); PG8_SCHED; PG8_LDA(At, 1, 0); PG8_STAGE(PG8_SA(0, 1), a2 + hstep, voffA);
            PG8_WAIT_L(8); PG8_BAR; PG8_WAIT_L(0); PG8_MMA(0, 0, At, B0); PG8_BAR; PG8_SCHED;
            PG8_LDB(B1, 1, 1); PG8_STAGE(PG8_SB(1, 0), b3, voffB);
            PG8_BAR; PG8_WAIT_L(0); PG8_MMA(0, 1, At, B1); PG8_BAR;
            PG8_LDA(At, 1, 1); PG8_STAGE(PG8_SA(1, 0), a3, voffA);
            PG8_BAR; PG8_WAIT_L(0); PG8_MMA(1, 0, At, B0); PG8_BAR; PG8_SCHED;
            PG8_STAGE(PG8_SB(1, 1), b3 + hstep, voffB);
            PG8_WAIT_V(6); PG8_BAR; PG8_MMA(1, 1, At, B1); PG8_BAR;
            }
        }
        if constexpr (ALIGN_EPI) { if (wr == 0) PG8_BAR; }
        if constexpr (!Epi::AFTER_DRAIN) { E(acc, cur, wr, wc, fr, fq); S.done(cur); }
        if (!has_next) break;
#pragma unroll
        for (int a = 0; a < 2; ++a)
#pragma unroll
            for (int b = 0; b < 2; ++b)
#pragma unroll
                for (int m = 0; m < 4; ++m)
#pragma unroll
                    for (int n = 0; n < 2; ++n) acc[a][b][m][n] = (f32x4){0.f, 0.f, 0.f, 0.f};
        cur = nxt; cA = nA; cB = nB; ++ui;
        if constexpr (ALIGN_EPI) { if (wr == 1) PG8_BAR; }
    }
    PG8_WAIT_V(0);
    if constexpr (!ALIGN_EPI) { if (wr == 0) PG8_BAR; }
    PG8_BAR;
    if constexpr (Epi::AFTER_DRAIN) { E.fused(acc, cur, wr, wc, fr, fq, lds, wid, lane); S.done(cur); }
#undef PG8_SA
#undef PG8_SB
#undef PG8_STAGE
#undef PG8_LDA
#undef PG8_LDB
#undef PG8_MMA
#undef PG8_WAIT_V
#undef PG8_WAIT_L
#undef PG8_BAR
#undef PG8_SCHED
}
}
#define DEV __device__ __forceinline__
#define LAS __attribute__((address_space(3)))
typedef unsigned short bf16;
typedef float f32x4 __attribute__((ext_vector_type(4)));
typedef unsigned u32x4 __attribute__((ext_vector_type(4)));
typedef unsigned u32x2 __attribute__((ext_vector_type(2)));
typedef short bf16x8 __attribute__((ext_vector_type(8)));

constexpr int NT = 512, NWV = 8;
constexpr int DM = 1024, NP = 3584, FF = 4096;
constexpr int MP = 16384, MREAL = 16512, MT = 16640, TT = 2048;
constexpr int REC = 1152;
constexpr float EPS = 1e-6f;
constexpr size_t MiB = 1u << 20;
constexpr size_t WS_RSS = 0;
constexpr size_t WS_LBT = 640 * 1024, WS_BAR = 704 * 1024, BAR_BYTES = 16384;
constexpr size_t WS_WTIN = 1 * MiB, WS_WTOUT = 8 * MiB, WS_WT1 = 10 * MiB, WS_WT2 = 18 * MiB, WS_WLORA = 26 * MiB;
constexpr size_t WS_XS = 27 * MiB, WS_U0 = 28 * MiB, WS_U1 = 61 * MiB, WS_P = 94 * MiB, WS_SCAN = 208 * MiB, WS_SCANS = 316 * MiB;
constexpr size_t WS_H = 94 * MiB;
constexpr size_t WS_OUTR = 317 * MiB, WS_G = 329 * MiB, WS_LA = 342 * MiB, WS_LU = 351 * MiB, WS_RSE = 360 * MiB, WS_RSO = 360 * MiB + 1280 * 1024, WS_END = 360 * MiB + 2560 * 1024;
DEV float row_scale(const float* rs, int row) { const f32x4* p = (const f32x4*)(rs + (size_t)row * 16); const f32x4 a = p[0], b = p[1], c = p[2], d = p[3];
    const float t = ((a[0] + a[1]) + (a[2] + a[3])) + ((b[0] + b[1]) + (b[2] + b[3])) + (((c[0] + c[1]) + (c[2] + c[3])) + ((d[0] + d[1]) + (d[2] + d[3])));
    return rsqrtf(t * (1.f / 1024.f) + 1e-6f); }
static_assert(WS_P + (size_t)MT * NP * 2 <= WS_SCAN && WS_SCAN + (size_t)MP * 6 * REC <= WS_SCANS && WS_H + (size_t)MT * FF * 2 <= WS_SCANS, "ws map");
static_assert(WS_U0 + (size_t)MT * DM * 2 <= WS_U1 && WS_U1 + (size_t)MT * DM * 2 <= WS_P, "ws map 2");
constexpr int WL_STRIDE = 131072, WL_AUP = 24576, WL_GUP = 49152, WL_WA = 98304, WL_WX = 114688;
constexpr size_t O_YP = 0, O_YS = 16777216, O_PWKV = 16908288, O_PSHIFT = 17694720, O_PHGRN = 17727488, O_PLRU = 18513920, O_PCONV = 18522112,
                 O_SWKV = 18546688, O_SSHIFT = 31129600, O_SHGRN = 31653888, O_SLRU = 44236800, O_SCONV = 44367872;
constexpr int LDS_BYTES = 147456;
enum { I_XP = 0, I_XS, I_SWKV, I_SSHIFT, I_SHGRN, I_SLRU, I_SCONV, I_N1G, I_WIN, I_MU, I_W0, I_WUP, I_A0, I_AUP, I_GUP, I_KK, I_KA, I_RK, I_LNW, I_LNB,
       I_HLB, I_HNG, I_CW, I_CB, I_WA, I_BA, I_WX, I_BX, I_LAM, I_WOUT, I_N2G, I_W1, I_W2, I_FG, N_IN };
struct Args { const float* in[N_IN]; float* out; unsigned char* ws; };

DEV int otid() { int t = threadIdx.x; asm volatile("" : "+v"(t)); return t; }
DEV int oblk() { int b = blockIdx.x; asm volatile("" : "+s"(b)); return b; }
DEV float bflo(unsigned u) { return __uint_as_float(u << 16); }
DEV float bfhi(unsigned u) { return __uint_as_float(u & 0xffff0000u); }
DEV float bf2f(unsigned short h) { return __uint_as_float((unsigned)h << 16); }
DEV unsigned pk2(float lo, float hi) { unsigned r; asm("v_cvt_pk_bf16_f32 %0, %1, %2" : "=v"(r) : "v"(lo), "v"(hi)); return r; }
DEV unsigned short f2bf(float f) { return (unsigned short)(pk2(f, 0.f) & 0xffffu); }
DEV float sigm(float x) { return 1.f / (1.f + __expf(-x)); }
template <int CTRL> DEV float dppf(float x) { return __builtin_bit_cast(float, __builtin_amdgcn_update_dpp(0, __builtin_bit_cast(int, x), CTRL, 0xF, 0xF, true)); }
DEV float red16(float x) { x += dppf<0xB1>(x); x += dppf<0x4E>(x); x += dppf<0x141>(x); x += dppf<0x140>(x); return x; }
DEV float rl(float x, int l) { return __builtin_bit_cast(float, __builtin_amdgcn_readlane(__builtin_bit_cast(int, x), l)); }
#ifdef WS_SHFL
DEV float wave_sum(float v) {
#pragma unroll
    for (int o = 1; o < 64; o <<= 1) v += __shfl_xor(v, o);
    return v;
}
#else
DEV float wave_sum(float v) { v = red16(v); return (rl(v, 0) + rl(v, 16)) + (rl(v, 32) + rl(v, 48)); }
#endif
DEV void unpack8(u32x4 u, float* f) { f[0] = bflo(u.x); f[1] = bfhi(u.x); f[2] = bflo(u.y); f[3] = bfhi(u.y); f[4] = bflo(u.z); f[5] = bfhi(u.z); f[6] = bflo(u.w); f[7] = bfhi(u.w); }
DEV float gelu_t(float x) { return 0.5f * x * (1.f + tanhf(0.7978845608f * (x + 0.044715f * x * x * x))); }

struct EpiP {
    static constexpr bool PERM = true, AFTER_DRAIN = false;
    bf16* O; const float* rss;
    DEV void operator()(const pg8::f32x4 (&acc)[2][2][4][2], const pg8::Unit& u, int wr, int wc, int fr, int fq) const {
        const int row0 = u.pm * 256 + wr * 64 + fr, col0 = u.pn * 256 + wc * 32 + 8 * fq;
#pragma unroll
        for (int ai = 0; ai < 2; ++ai)
#pragma unroll
            for (int m = 0; m < 4; ++m) {
                const int row = row0 + ai * 128 + m * 16;
                const float s = row < MREAL ? row_scale(rss, row) : 1.f;
                bf16* rowp = O + (size_t)row * NP + col0;
#pragma unroll
                for (int bj = 0; bj < 2; ++bj) { const pg8::f32x4 v0 = acc[ai][bj][m][0] * s, v1 = acc[ai][bj][m][1] * s;
                    u32x4 w; w.x = pk2(v0[0], v0[1]); w.y = pk2(v0[2], v0[3]); w.z = pk2(v1[0], v1[1]); w.w = pk2(v1[2], v1[3]);
                    *(u32x4*)(rowp + bj * 128) = w; }
            }
    }
};
struct EpiH {
    static constexpr bool PERM = true, AFTER_DRAIN = false;
    bf16* O; const float* rss;
    DEV void operator()(const pg8::f32x4 (&acc)[2][2][4][2], const pg8::Unit& u, int wr, int wc, int fr, int fq) const {
        const int row0 = u.pm * 256 + wr * 64 + fr, col0 = u.pn * 256 + wc * 32 + 8 * fq;
#pragma unroll
        for (int ai = 0; ai < 2; ++ai)
#pragma unroll
            for (int m = 0; m < 4; ++m) {
                const int row = row0 + ai * 128 + m * 16;
                const float s = row < MREAL ? row_scale(rss, row) : 1.f;
                bf16* rowp = O + (size_t)row * FF + col0;
#pragma unroll
                for (int bj = 0; bj < 2; ++bj) { pg8::f32x4 v0 = acc[ai][bj][m][0] * s, v1 = acc[ai][bj][m][1] * s;
#pragma unroll
                    for (int e = 0; e < 4; ++e) { const float a0 = fmaxf(v0[e], 0.f), a1 = fmaxf(v1[e], 0.f); v0[e] = a0 * a0; v1[e] = a1 * a1; }
                    u32x4 w; w.x = pk2(v0[0], v0[1]); w.y = pk2(v0[2], v0[3]); w.z = pk2(v1[0], v1[1]); w.w = pk2(v1[2], v1[3]);
                    *(u32x4*)(rowp + bj * 128) = w; }
            }
    }
};
struct EpiX {
    static constexpr bool PERM = false, AFTER_DRAIN = false;
    float* xp; float* xs; bf16* U; const float* g; float* rss;
    DEV void operator()(const pg8::f32x4 (&acc)[2][2][4][2], const pg8::Unit& u, int wr, int wc, int fr, int fq) const {
        const int row0 = u.pm * 256 + wr * 64 + fr, col0 = u.pn * 256 + wc * 32 + 4 * fq;
#pragma unroll
        for (int ai = 0; ai < 2; ++ai) {
            if (u.pm * 256 + ai * 128 >= MREAL) continue;
#pragma unroll
            for (int m = 0; m < 4; ++m) {
                const int row = row0 + ai * 128 + m * 16;
                float* xr = (row < MP ? xp + (size_t)row * DM : xs + (size_t)(row - MP) * DM) + col0;
                bf16* ur = U + (size_t)row * DM + col0;
                float ss = 0.f;
#pragma unroll
                for (int bj = 0; bj < 2; ++bj)
#pragma unroll
                    for (int n = 0; n < 2; ++n) { const int co = bj * 128 + n * 16;
                        f32x4 x = *(const f32x4*)(xr + co); const pg8::f32x4 a = acc[ai][bj][m][n];
                        x[0] += a[0]; x[1] += a[1]; x[2] += a[2]; x[3] += a[3];
                        *(f32x4*)(xr + co) = x; ss += (x[0] * x[0] + x[1] * x[1]) + (x[2] * x[2] + x[3] * x[3]);
                        const f32x4 gv = *(const f32x4*)(g + col0 + co);
                        u32x2 w; w.x = pk2(x[0] * gv[0], x[1] * gv[1]); w.y = pk2(x[2] * gv[2], x[3] * gv[3]);
                        *(u32x2*)(ur + co) = w; }
                ss += __shfl_xor(ss, 16); ss += __shfl_xor(ss, 32);
                if (fq == 0) rss[(size_t)row * 16 + u.pn * 4 + wc] = ss;
            }
        }
    }
};

DEV void transpose_item(const float* W, int K, int N, bf16* WT, int row_off, LAS float* scr, int item, int lane) {
    const int nblk = N / 32, kb = item / nblk, nb = item % nblk, k0 = 64 * kb, n0 = 32 * nb;
#pragma unroll 8
    for (int i = 0; i < 32; ++i) { const int kk = 2 * i + (lane >> 5); scr[kk * 33 + (lane & 31)] = W[(size_t)(k0 + kk) * N + n0 + (lane & 31)]; }
    asm volatile("s_waitcnt lgkmcnt(0)" ::: "memory");
    const int c = lane & 7;
#pragma unroll
    for (int j = 0; j < 4; ++j) { const int n = (lane >> 3) + 8 * j; const LAS float* s = scr + (8 * c) * 33 + n;
        u32x4 o; o.x = pk2(s[0 * 33], s[1 * 33]); o.y = pk2(s[2 * 33], s[3 * 33]); o.z = pk2(s[4 * 33], s[5 * 33]); o.w = pk2(s[6 * 33], s[7 * 33]);
        *(u32x4*)(WT + (size_t)(row_off + n0 + n) * K + k0 + 8 * c) = o; }
    asm volatile("s_waitcnt lgkmcnt(0)" ::: "memory");
}
DEV void transpose_job(const float* W, int K, int N, bf16* WT, int& it, int NGW, LAS float* scr, int lane) {
    const int n_items = (K / 64) * (N / 32);
    while (it < n_items) { transpose_item(W, K, N, WT, 0, scr, it, lane); it += NGW; }
    it -= n_items;
}

DEV void phase0(const Args& a, LAS unsigned char* lds) {
    const int tid = otid(), lane = tid & 63, wave = tid >> 6;
    const int gw = blockIdx.x * NWV + wave, NGW = gridDim.x * NWV, gt = blockIdx.x * NT + tid, NGT = gridDim.x * NT;
    unsigned char* ws = a.ws;
    float* rss = (float*)(ws + WS_RSE);
    {
        u32x4* z = (u32x4*)(ws + WS_WTIN + (size_t)3456 * DM * 2);
        for (int i = gt; i < 128 * DM * 2 / 16; i += NGT) z[i] = (u32x4){0u, 0u, 0u, 0u};
    }
    if (gt < 384) {
        const float* hl = a.in[I_HLB]; float e[4], mx = -1e30f, sm = 0.f;
        _Pragma("unroll") for (int d = 0; d < 4; ++d) { e[d] = hl[d * 384 + gt]; mx = fmaxf(mx, e[d]); }
        _Pragma("unroll") for (int d = 0; d < 4; ++d) { e[d] = __expf(e[d] - mx); sm += e[d]; }
        float* lbt = (float*)(ws + WS_LBT); float acc = 0.f; lbt[gt] = 0.f;
        _Pragma("unroll") for (int d = 1; d < 4; ++d) { acc += e[d] / sm; lbt[d * 384 + gt] = acc; }
    }
    bf16* U0 = (bf16*)(ws + WS_U0); bf16* U1 = (bf16*)(ws + WS_U1); float* xs = (float*)(ws + WS_XS);
    const f32x4* g4 = (const f32x4*)a.in[I_N1G];
    for (int row = gw; row < MREAL; row += NGW) {
        const f32x4* src = (const f32x4*)(row < MP ? a.in[I_XP] + (size_t)row * DM : a.in[I_XS] + (size_t)(row - MP) * DM);
        f32x4* dst = (f32x4*)(row < MP ? a.out + (size_t)row * DM : xs + (size_t)(row - MP) * DM);
        u32x2* ud = (u32x2*)(U0 + (size_t)row * DM);
        float ss = 0.f;
#pragma unroll
        for (int j = 0; j < 4; ++j) { const f32x4 v = src[lane + 64 * j], g = g4[lane + 64 * j]; dst[lane + 64 * j] = v;
            ss += (v[0] * v[0] + v[1] * v[1]) + (v[2] * v[2] + v[3] * v[3]);
            u32x2 w; w.x = pk2(v[0] * g[0], v[1] * g[1]); w.y = pk2(v[2] * g[2], v[3] * g[3]); ud[lane + 64 * j] = w; }
        ss = wave_sum(ss); if (lane < 16) rss[(size_t)row * 16 + lane] = lane == 0 ? ss : 0.f;
    }
    for (int r = gw; r < 256; r += NGW) { const int lay = r >> 7, i = r & 127;
        const f32x4* src = (const f32x4*)(a.in[I_SSHIFT] + (size_t)(lay * 128 + i) * DM);
        u32x2* ud = (u32x2*)((lay ? U1 : U0) + (size_t)(MREAL + i) * DM);
#pragma unroll
        for (int j = 0; j < 4; ++j) { const f32x4 v = src[lane + 64 * j]; u32x2 w; w.x = pk2(v[0], v[1]); w.y = pk2(v[2], v[3]); ud[lane + 64 * j] = w; }
    }
    LAS float* scr = (LAS float*)(lds + wave * 8448);
    int it = gw;
    transpose_job(a.in[I_WIN], DM, 3456, (bf16*)(ws + WS_WTIN), it, NGW, scr, lane);
    for (int l = 0; l < 4; ++l) {
        bf16* WL = (bf16*)(ws + WS_WLORA) + (size_t)l * WL_STRIDE;
        transpose_job(a.in[I_WUP] + (size_t)l * 64 * 384, 64, 384, WL, it, NGW, scr, lane);
        transpose_job(a.in[I_AUP] + (size_t)l * 64 * 384, 64, 384, WL + WL_AUP, it, NGW, scr, lane);
        transpose_job(a.in[I_GUP] + (size_t)l * 128 * 384, 128, 384, WL + WL_GUP, it, NGW, scr, lane);
        for (int n = 0; n < 4; ++n) {
            transpose_job(a.in[I_WA] + (size_t)(l * 4 + n) * 4096, 64, 64, WL + WL_WA + n * 4096, it, NGW, scr, lane);
            transpose_job(a.in[I_WX] + (size_t)(l * 4 + n) * 4096, 64, 64, WL + WL_WX + n * 4096, it, NGW, scr, lane);
        }
    }
}

constexpr int PL_PRM = 0, PL_AL = 14336, PL_XC = 31232, PL_LW = 48128, PL_LA = 73216, PL_GR = 98304, PL_GI = 115200;
template <int C> DEV float dpp_sum8(float x) { x += __shfl_xor(x, 1); x += __shfl_xor(x, 2); x += __shfl_xor(x, 4); return x; }
DEV void prep_tile(const Args& a, int l, int tt, LAS unsigned char* lds, bool do_gelu = true) {
    const int tid = otid(), lane = tid & 63, wave = __builtin_amdgcn_readfirstlane(tid >> 6);
    unsigned char* ws = a.ws;
    LAS float* PRM = (LAS float*)(lds + PL_PRM);
    LAS bf16* AL = (LAS bf16*)(lds + PL_AL);
    LAS bf16* XC = (LAS bf16*)(lds + PL_XC);
    LAS bf16* LW = (LAS bf16*)(lds + PL_LW);
    LAS bf16* LAo = (LAS bf16*)(lds + PL_LA);
    LAS bf16* GR = (LAS bf16*)(lds + PL_GR);
    LAS bf16* GI = (LAS bf16*)(lds + PL_GI);
    bf16* P = (bf16*)(ws + WS_P);
    const bool samp = tt >= 512;
    const int row0 = tt * 32;
    const float* mu = a.in[I_MU] + l * 1408;
#ifndef SK_PREP_A
#pragma unroll 1
    for (int itx = 0; itx < 2; ++itx) {
        const int idx = itx * NT + tid, r = idx >> 5, col = (idx & 31) * 8, row = row0 + r, t = row & (TT - 1);
        float p[8], pp[8], x[8];
        {
            unpack8(*(const u32x4*)(P + (size_t)row * NP + 1152 + col), p);
            const bool valid = samp || t > 0; const int prow = samp ? row + 128 : row - 1;
            if (valid) unpack8(*(const u32x4*)(P + (size_t)prow * NP + 1152 + col), pp);
            else { _Pragma("unroll") for (int e = 0; e < 8; ++e) pp[e] = 0.f; }
            const f32x4 m0 = *(const f32x4*)(mu + 1152 + col), m1 = *(const f32x4*)(mu + 1152 + col + 4);
#pragma unroll
            for (int e = 0; e < 8; ++e) { const float m = e < 4 ? m0[e] : m1[e - 4]; x[e] = p[e] + m * (pp[e] - p[e]); }
            if (col < 64) { _Pragma("unroll") for (int e = 0; e < 8; ++e) x[e] = tanhf(x[e]); }
            else if (col >= 128) { _Pragma("unroll") for (int e = 0; e < 8; ++e) x[e] = sigm(x[e]); }
            u32x4 w; w.x = pk2(x[0], x[1]); w.y = pk2(x[2], x[3]); w.z = pk2(x[4], x[5]); w.w = pk2(x[6], x[7]);
            *(LAS u32x4*)(AL + r * 264 + col) = w;
        }
        {
            float xr[4][8];
            unpack8(*(const u32x4*)(P + (size_t)row * NP + 2944 + col), xr[0]);
            if (!samp) {
#pragma unroll
                for (int j = 1; j < 4; ++j) { if (t - j >= 0) unpack8(*(const u32x4*)(P + (size_t)(row - j) * NP + 2944 + col), xr[j]); else { _Pragma("unroll") for (int e = 0; e < 8; ++e) xr[j][e] = 0.f; } }
                if (t >= TT - 3) { float* pc = a.out + O_PCONV + ((size_t)((l * 8 + (row >> 11)) * 3 + (t - (TT - 3)))) * 256 + col;
                    *(f32x4*)pc = (f32x4){xr[0][0], xr[0][1], xr[0][2], xr[0][3]}; *(f32x4*)(pc + 4) = (f32x4){xr[0][4], xr[0][5], xr[0][6], xr[0][7]}; }
            } else {
                const int i = row - MP; const float* c0 = a.in[I_SCONV] + (size_t)((l * 128 + i) * 3) * 256 + col;
#pragma unroll
                for (int j = 1; j < 4; ++j) { const f32x4 q0 = *(const f32x4*)(c0 + (3 - j) * 256), q1 = *(const f32x4*)(c0 + (3 - j) * 256 + 4);
                    xr[j][0] = q0[0]; xr[j][1] = q0[1]; xr[j][2] = q0[2]; xr[j][3] = q0[3]; xr[j][4] = q1[0]; xr[j][5] = q1[1]; xr[j][6] = q1[2]; xr[j][7] = q1[3]; }
                float* sc = a.out + O_SCONV + (size_t)((l * 128 + i) * 3) * 256 + col;
                *(f32x4*)(sc) = (f32x4){xr[2][0], xr[2][1], xr[2][2], xr[2][3]}; *(f32x4*)(sc + 4) = (f32x4){xr[2][4], xr[2][5], xr[2][6], xr[2][7]};
                *(f32x4*)(sc + 256) = (f32x4){xr[1][0], xr[1][1], xr[1][2], xr[1][3]}; *(f32x4*)(sc + 260) = (f32x4){xr[1][4], xr[1][5], xr[1][6], xr[1][7]};
                *(f32x4*)(sc + 512) = (f32x4){xr[0][0], xr[0][1], xr[0][2], xr[0][3]}; *(f32x4*)(sc + 516) = (f32x4){xr[0][4], xr[0][5], xr[0][6], xr[0][7]};
            }
            const float* cw = a.in[I_CW] + (size_t)l * 4 * 256 + col; const float* cb = a.in[I_CB] + l * 256 + col;
            float xc[8];
#pragma unroll
            for (int e = 0; e < 8; ++e) xc[e] = cb[e] + cw[e] * xr[3][e] + cw[256 + e] * xr[2][e] + cw[512 + e] * xr[1][e] + cw[768 + e] * xr[0][e];
            u32x4 w; w.x = pk2(xc[0], xc[1]); w.y = pk2(xc[2], xc[3]); w.z = pk2(xc[4], xc[5]); w.w = pk2(xc[6], xc[7]);
            *(LAS u32x4*)(XC + r * 264 + col) = w;
        }
    }
#endif
    __syncthreads();
    const int fr = lane & 15, fq = lane >> 4;
    const bf16* WL = (const bf16*)(ws + WS_WLORA) + (size_t)l * WL_STRIDE;
#ifndef SK_PREP_R
    if (wave < 6) {
        const int h = wave;
        bf16* G = (bf16*)(ws + WS_G);
#ifndef NP_NO_WA
#pragma unroll
        for (int which = 0; which < 2; ++which) {
            const bf16* Wm = WL + (which ? WL_AUP : 0); LAS bf16* Lo = which ? LAo : LW;
            bf16x8 Wf[4][2];
#pragma unroll
            for (int ni = 0; ni < 4; ++ni)
#pragma unroll
                for (int ks = 0; ks < 2; ++ks) Wf[ni][ks] = *(const bf16x8*)(Wm + (h * 64 + ni * 16 + fr) * 64 + ks * 32 + fq * 8);
#pragma unroll
            for (int mi = 0; mi < 2; ++mi) {
                f32x4 acc[4];
#pragma unroll
                for (int ni = 0; ni < 4; ++ni) acc[ni] = (f32x4){0.f, 0.f, 0.f, 0.f};
#pragma unroll
                for (int ks = 0; ks < 2; ++ks) { const bf16x8 Af = *(const LAS bf16x8*)(AL + (mi * 16 + fr) * 264 + which * 64 + ks * 32 + fq * 8);
#pragma unroll
                    for (int ni = 0; ni < 4; ++ni) acc[ni] = __builtin_amdgcn_mfma_f32_16x16x32_bf16(Wf[ni][ks], Af, acc[ni], 0, 0, 0); }
#pragma unroll
                for (int ni = 0; ni < 4; ++ni) { u32x2 w; w.x = pk2(acc[ni][0], acc[ni][1]); w.y = pk2(acc[ni][2], acc[ni][3]);
                    *(LAS u32x2*)(Lo + (mi * 16 + fr) * 392 + h * 64 + ni * 16 + fq * 4) = w; }
            }
        }
#endif
        {
            bf16x8 Wf[4][4];
#pragma unroll
            for (int ni = 0; ni < 4; ++ni)
#pragma unroll
                for (int ks = 0; ks < 4; ++ks) Wf[ni][ks] = *(const bf16x8*)(WL + WL_GUP + (h * 64 + ni * 16 + fr) * 128 + ks * 32 + fq * 8);
#pragma unroll
            for (int mi = 0; mi < 2; ++mi) {
                f32x4 acc[4];
#pragma unroll
                for (int ni = 0; ni < 4; ++ni) acc[ni] = (f32x4){0.f, 0.f, 0.f, 0.f};
#pragma unroll
                for (int ks = 0; ks < 4; ++ks) { const bf16x8 Af = *(const LAS bf16x8*)(AL + (mi * 16 + fr) * 264 + 128 + ks * 32 + fq * 8);
#pragma unroll
                    for (int ni = 0; ni < 4; ++ni) acc[ni] = __builtin_amdgcn_mfma_f32_16x16x32_bf16(Wf[ni][ks], Af, acc[ni], 0, 0, 0); }
                const int row = row0 + mi * 16 + fr;
#pragma unroll
                for (int ni = 0; ni < 4; ++ni) { u32x2 w; w.x = pk2(acc[ni][0], acc[ni][1]); w.y = pk2(acc[ni][2], acc[ni][3]);
#ifndef NP_NO_G
                    *(u32x2*)(G + (size_t)row * 384 + h * 64 + ni * 16 + fq * 4) = w;
#endif
                }
            }
        }
    } else
#endif
#ifndef SK_PREP_L
    if (wave >= 6) {
#pragma unroll 1
        for (int nn = 0; nn < 2; ++nn) {
            const int n = (wave - 6) * 2 + nn;
            bf16x8 Wa[4][2], Wx[4][2];
#pragma unroll
            for (int ni = 0; ni < 4; ++ni)
#pragma unroll
                for (int ks = 0; ks < 2; ++ks) { Wa[ni][ks] = *(const bf16x8*)(WL + WL_WA + n * 4096 + (ni * 16 + fr) * 64 + ks * 32 + fq * 8);
                                                  Wx[ni][ks] = *(const bf16x8*)(WL + WL_WX + n * 4096 + (ni * 16 + fr) * 64 + ks * 32 + fq * 8); }
#pragma unroll
            for (int mi = 0; mi < 2; ++mi) {
                f32x4 ar[4], ax[4];
#pragma unroll
                for (int ni = 0; ni < 4; ++ni) { ar[ni] = (f32x4){0.f, 0.f, 0.f, 0.f}; ax[ni] = ar[ni]; }
#pragma unroll
                for (int ks = 0; ks < 2; ++ks) { const bf16x8 Af = *(const LAS bf16x8*)(XC + (mi * 16 + fr) * 264 + n * 64 + ks * 32 + fq * 8);
#pragma unroll
                    for (int ni = 0; ni < 4; ++ni) { ar[ni] = __builtin_amdgcn_mfma_f32_16x16x32_bf16(Wa[ni][ks], Af, ar[ni], 0, 0, 0); ax[ni] = __builtin_amdgcn_mfma_f32_16x16x32_bf16(Wx[ni][ks], Af, ax[ni], 0, 0, 0); } }
#pragma unroll
                for (int ni = 0; ni < 4; ++ni) { u32x2 w1, w2; w1.x = pk2(ar[ni][0], ar[ni][1]); w1.y = pk2(ar[ni][2], ar[ni][3]); w2.x = pk2(ax[ni][0], ax[ni][1]); w2.y = pk2(ax[ni][2], ax[ni][3]);
                    *(LAS u32x2*)(GR + (mi * 16 + fr) * 264 + n * 64 + ni * 16 + fq * 4) = w1; *(LAS u32x2*)(GI + (mi * 16 + fr) * 264 + n * 64 + ni * 16 + fq * 4) = w2; }
            }
        }
    }
#endif
    __syncthreads();
#ifndef NP_NO_RW
#pragma unroll 1
    for (int itx = 0; itx < 3; ++itx) {
        const int idx = itx * NT + tid, r = idx / 48, cg = idx % 48, c0 = cg * 8, h = cg >> 3, i0 = c0 & 63;
        const int row = row0 + r, t = row & (TT - 1);
        const bool valid = samp || t > 0; const int prow = samp ? row + 128 : row - 1;
        float cr[8], ck[8], cv[8], er[8], ek[8], ev[8], lw[8], la[8];
        const bf16* pr = P + (size_t)row * NP + c0; const bf16* pq = P + (size_t)prow * NP + c0;
        unpack8(*(const u32x4*)pr, cr); unpack8(*(const u32x4*)(pr + 384), ck); unpack8(*(const u32x4*)(pr + 768), cv);
        if (valid) { unpack8(*(const u32x4*)pq, er); unpack8(*(const u32x4*)(pq + 384), ek); unpack8(*(const u32x4*)(pq + 768), ev); }
        else { _Pragma("unroll") for (int e = 0; e < 8; ++e) { er[e] = 0.f; ek[e] = 0.f; ev[e] = 0.f; } }
        unpack8(*(const LAS u32x4*)(LW + r * 392 + c0), lw); unpack8(*(const LAS u32x4*)(LAo + r * 392 + c0), la);
        float wq[8], kq[8], av[8], rv[8], kv[8], vv[8]; float ssq = 0.f;
#pragma unroll
        for (int e = 0; e < 8; ++e) {
            const float mr = PRM[c0 + e], mk = PRM[384 + c0 + e], mv = PRM[768 + c0 + e], w0 = PRM[1152 + c0 + e], a0 = PRM[1536 + c0 + e], kk_ = PRM[1920 + c0 + e], ka_ = PRM[2304 + c0 + e];
            rv[e] = cr[e] + mr * (er[e] - cr[e]); const float kx = ck[e] + mk * (ek[e] - ck[e]); vv[e] = cv[e] + mv * (ev[e] - cv[e]);
            wq[e] = __expf(-0.6065306597f * sigm(w0 + lw[e]));
            av[e] = sigm(a0 + la[e]);
            kq[e] = kx * kk_; ssq += kq[e] * kq[e];
            kv[e] = kx * (1.f + (av[e] - 1.f) * ka_);
        }
        ssq = dpp_sum8<0>(ssq);
        const float inv = rsqrtf(fmaxf(ssq, 1e-24f));
        unsigned char* rec = samp ? ws + WS_SCANS + (size_t)((row - MP) * 6 + h) * REC
                                  : ws + WS_SCAN + ((size_t)((row >> 11) * 6 + h) * TT + t) * REC;
        f32x4 o0, o1;
        o0 = (f32x4){wq[0], wq[1], wq[2], wq[3]}; o1 = (f32x4){wq[4], wq[5], wq[6], wq[7]};
        *(f32x4*)(rec + 4 * i0) = o0; *(f32x4*)(rec + 4 * i0 + 16) = o1;
#pragma unroll
        for (int e = 0; e < 8; ++e) kq[e] *= inv;
        o0 = (f32x4){kq[0], kq[1], kq[2], kq[3]}; o1 = (f32x4){kq[4], kq[5], kq[6], kq[7]};
        *(f32x4*)(rec + 256 + 4 * i0) = o0; *(f32x4*)(rec + 256 + 4 * i0 + 16) = o1;
        o0 = (f32x4){kq[0] * av[0], kq[1] * av[1], kq[2] * av[2], kq[3] * av[3]}; o1 = (f32x4){kq[4] * av[4], kq[5] * av[5], kq[6] * av[6], kq[7] * av[7]};
        *(f32x4*)(rec + 512 + 4 * i0) = o0; *(f32x4*)(rec + 512 + 4 * i0 + 16) = o1;
        u32x4 rk; rk.x = pk2(rv[0], rv[1]); rk.y = pk2(rv[2], rv[3]); rk.z = pk2(kv[0], kv[1]); rk.w = pk2(kv[2], kv[3]);
        *(u32x4*)(rec + 768 + 4 * i0) = rk;
        rk.x = pk2(rv[4], rv[5]); rk.y = pk2(rv[6], rv[7]); rk.z = pk2(kv[4], kv[5]); rk.w = pk2(kv[6], kv[7]);
        *(u32x4*)(rec + 768 + 4 * i0 + 16) = rk;
        u32x4 vp; vp.x = pk2(vv[0], vv[1]); vp.y = pk2(vv[2], vv[3]); vp.z = pk2(vv[4], vv[5]); vp.w = pk2(vv[6], vv[7]);
        *(u32x4*)(rec + 1024 + 2 * i0) = vp;
    }
#endif
    {
        bf16* LA = (bf16*)(ws + WS_LA); bf16* LU = (bf16*)(ws + WS_LU);
#pragma unroll 1
        for (int itx = 0; itx < 2; ++itx) {
            const int idx = itx * NT + tid, r = idx >> 5, c0 = (idx & 31) * 8, row = row0 + r;
            float gr[8], gi[8], xc[8], la[8], uu[8];
            unpack8(*(const LAS u32x4*)(GR + r * 264 + c0), gr); unpack8(*(const LAS u32x4*)(GI + r * 264 + c0), gi); unpack8(*(const LAS u32x4*)(XC + r * 264 + c0), xc);
#pragma unroll
            for (int e = 0; e < 8; ++e) { const float rr = sigm(gr[e] + PRM[2688 + c0 + e]), ii = sigm(gi[e] + PRM[2944 + c0 + e]);
                la[e] = -8.f * rr * PRM[3200 + c0 + e];
                uu[e] = xc[e] * ii * sqrtf(fmaxf(-expm1f(2.f * la[e]), 1e-12f)); }
            u32x4 o1, o2; o1.x = pk2(la[0], la[1]); o1.y = pk2(la[2], la[3]); o1.z = pk2(la[4], la[5]); o1.w = pk2(la[6], la[7]);
            o2.x = pk2(uu[0], uu[1]); o2.y = pk2(uu[2], uu[3]); o2.z = pk2(uu[4], uu[5]); o2.w = pk2(uu[6], uu[7]);
#ifndef NP_NO_LRU
            *(u32x4*)(LA + (size_t)row * 256 + c0) = o1; *(u32x4*)(LU + (size_t)row * 256 + c0) = o2;
#endif
        }
    }
    __syncthreads();
}

DEV void phase_prep(const Args& a, int l, LAS unsigned char* lds, bool do_gelu = true) {
    const int tid = otid(), lane = tid & 63, wave = tid >> 6;
    const int gw = blockIdx.x * NWV + wave, NGW = gridDim.x * NWV;
    unsigned char* ws = a.ws;
    {
        LAS float* PRM = (LAS float*)(lds + PL_PRM);
        for (int i = tid; i < 384; i += NT) { PRM[i] = a.in[I_MU][l * 1408 + i]; PRM[384 + i] = a.in[I_MU][l * 1408 + 384 + i]; PRM[768 + i] = a.in[I_MU][l * 1408 + 768 + i];
            PRM[1152 + i] = a.in[I_W0][l * 384 + i]; PRM[1536 + i] = a.in[I_A0][l * 384 + i]; PRM[1920 + i] = a.in[I_KK][l * 384 + i]; PRM[2304 + i] = a.in[I_KA][l * 384 + i]; }
        for (int i = tid; i < 256; i += NT) { PRM[2688 + i] = a.in[I_BA][l * 256 + i]; PRM[2944 + i] = a.in[I_BX][l * 256 + i]; PRM[3200 + i] = log1pf(__expf(-a.in[I_LAM][l * 256 + i])); }
    }
    __syncthreads();
    for (int tt = blockIdx.x; tt < 516; tt += gridDim.x) prep_tile(a, l, tt, lds, do_gelu);
    const float* rss = (const float*)(ws + WS_RSE);
    for (int r = gw; r < 136; r += NGW) {
        const int row = r < 8 ? r * TT + TT - 1 : MP + (r - 8);
        const f32x4* src = (const f32x4*)(row < MP ? a.out + (size_t)row * DM : (const float*)(ws + WS_XS) + (size_t)(row - MP) * DM);
        f32x4* dst = (f32x4*)(r < 8 ? a.out + O_PSHIFT + (size_t)(l * 8 + r) * DM : a.out + O_SSHIFT + (size_t)(l * 128 + (r - 8)) * DM);
        const f32x4* g4 = (const f32x4*)(a.in[I_N1G] + l * DM);
        const float s = row_scale(rss, row);
#pragma unroll
        for (int j = 0; j < 4; ++j) { const f32x4 v = src[lane + 64 * j], g = g4[lane + 64 * j]; dst[lane + 64 * j] = (f32x4){v[0] * s * g[0], v[1] * s * g[1], v[2] * s * g[2], v[3] * s * g[3]}; }
    }
    if (l + 2 < 4) {
        bf16* U = (bf16*)(ws + ((l & 1) ? WS_U1 : WS_U0));
        for (int i = gw; i < 128; i += NGW) {
            const f32x4* src = (const f32x4*)(a.in[I_SSHIFT] + (size_t)((l + 2) * 128 + i) * DM);
            u32x2* ud = (u32x2*)(U + (size_t)(MREAL + i) * DM);
#pragma unroll
            for (int j = 0; j < 4; ++j) { const f32x4 v = src[lane + 64 * j]; u32x2 w; w.x = pk2(v[0], v[1]); w.y = pk2(v[2], v[3]); ud[lane + 64 * j] = w; }
        }
    }
    __syncthreads();
    LAS float* scr = (LAS float*)(lds + wave * 8448);
    int it = gw;
    transpose_job(a.in[I_WOUT] + (size_t)l * DM * DM, DM, DM, (bf16*)(ws + WS_WTOUT), it, NGW, scr, lane);
    transpose_job(a.in[I_W1] + (size_t)l * DM * FF, DM, FF, (bf16*)(ws + WS_WT1), it, NGW, scr, lane);
    transpose_job(a.in[I_W2] + (size_t)l * FF * DM, FF, DM, (bf16*)(ws + WS_WT2), it, NGW, scr, lane);
}

DEV void prep_tile_old(const Args& a, int l, int tt, LAS unsigned char* lds, bool do_gelu = true, int mi_lo = 0, int mi_hi = 4) {
    const int tid = otid(), lane = tid & 63, wave = __builtin_amdgcn_readfirstlane(tid >> 6);
    unsigned char* ws = a.ws;
    LAS bf16* AL = (LAS bf16*)lds;
    LAS bf16* XC = (LAS bf16*)(lds + 33792);
    bf16* P = (bf16*)(ws + WS_P);
    const bool samp = tt >= 256;
    const int row0 = tt * 64;
    const float* mu = a.in[I_MU] + l * 1408;
    LAS float* SPT = (LAS float*)(lds + 67584);
    if (tid < 256) SPT[tid] = log1pf(__expf(-a.in[I_LAM][l * 256 + tid]));
#ifndef SK_PREP_A
#pragma unroll 1
    for (int itx = mi_lo; itx < mi_hi; ++itx) {
        const int idx = itx * NT + tid, r = idx >> 5, col = (idx & 31) * 8, row = row0 + r, t = row & (TT - 1);
        float p[8], pp[8], x[8];
        {
            unpack8(*(const u32x4*)(P + (size_t)row * NP + 1152 + col), p);
            const bool valid = samp || t > 0; const int prow = samp ? row + 128 : row - 1;
            if (valid) unpack8(*(const u32x4*)(P + (size_t)prow * NP + 1152 + col), pp);
            else { _Pragma("unroll") for (int e = 0; e < 8; ++e) pp[e] = 0.f; }
            const f32x4 m0 = *(const f32x4*)(mu + 1152 + col), m1 = *(const f32x4*)(mu + 1152 + col + 4);
#pragma unroll
            for (int e = 0; e < 8; ++e) { const float m = e < 4 ? m0[e] : m1[e - 4]; x[e] = p[e] + m * (pp[e] - p[e]); }
            if (col < 64) { _Pragma("unroll") for (int e = 0; e < 8; ++e) x[e] = tanhf(x[e]); }
            else if (col >= 128) { _Pragma("unroll") for (int e = 0; e < 8; ++e) x[e] = sigm(x[e]); }
            u32x4 w; w.x = pk2(x[0], x[1]); w.y = pk2(x[2], x[3]); w.z = pk2(x[4], x[5]); w.w = pk2(x[6], x[7]);
            *(LAS u32x4*)(AL + r * 264 + col) = w;
        }
        {
            float xr[4][8];
            unpack8(*(const u32x4*)(P + (size_t)row * NP + 2944 + col), xr[0]);
            if (!samp) {
#pragma unroll
                for (int j = 1; j < 4; ++j) { if (t - j >= 0) unpack8(*(const u32x4*)(P + (size_t)(row - j) * NP + 2944 + col), xr[j]); else { _Pragma("unroll") for (int e = 0; e < 8; ++e) xr[j][e] = 0.f; } }
                if (t >= TT - 3) { float* pc = a.out + O_PCONV + ((size_t)((l * 8 + (row >> 11)) * 3 + (t - (TT - 3)))) * 256 + col;
                    *(f32x4*)pc = (f32x4){xr[0][0], xr[0][1], xr[0][2], xr[0][3]}; *(f32x4*)(pc + 4) = (f32x4){xr[0][4], xr[0][5], xr[0][6], xr[0][7]}; }
            } else {
                const int i = row - MP; const float* c0 = a.in[I_SCONV] + (size_t)((l * 128 + i) * 3) * 256 + col;
#pragma unroll
                for (int j = 1; j < 4; ++j) { const f32x4 q0 = *(const f32x4*)(c0 + (3 - j) * 256), q1 = *(const f32x4*)(c0 + (3 - j) * 256 + 4);
                    xr[j][0] = q0[0]; xr[j][1] = q0[1]; xr[j][2] = q0[2]; xr[j][3] = q0[3]; xr[j][4] = q1[0]; xr[j][5] = q1[1]; xr[j][6] = q1[2]; xr[j][7] = q1[3]; }
                float* sc = a.out + O_SCONV + (size_t)((l * 128 + i) * 3) * 256 + col;
                *(f32x4*)(sc) = (f32x4){xr[2][0], xr[2][1], xr[2][2], xr[2][3]}; *(f32x4*)(sc + 4) = (f32x4){xr[2][4], xr[2][5], xr[2][6], xr[2][7]};
                *(f32x4*)(sc + 256) = (f32x4){xr[1][0], xr[1][1], xr[1][2], xr[1][3]}; *(f32x4*)(sc + 260) = (f32x4){xr[1][4], xr[1][5], xr[1][6], xr[1][7]};
                *(f32x4*)(sc + 512) = (f32x4){xr[0][0], xr[0][1], xr[0][2], xr[0][3]}; *(f32x4*)(sc + 516) = (f32x4){xr[0][4], xr[0][5], xr[0][6], xr[0][7]};
            }
            const float* cw = a.in[I_CW] + (size_t)l * 4 * 256 + col; const float* cb = a.in[I_CB] + l * 256 + col;
            float xc[8];
#pragma unroll
            for (int e = 0; e < 8; ++e) xc[e] = cb[e] + cw[e] * xr[3][e] + cw[256 + e] * xr[2][e] + cw[512 + e] * xr[1][e] + cw[768 + e] * xr[0][e];
            u32x4 w; w.x = pk2(xc[0], xc[1]); w.y = pk2(xc[2], xc[3]); w.z = pk2(xc[4], xc[5]); w.w = pk2(xc[6], xc[7]);
            *(LAS u32x4*)(XC + r * 264 + col) = w;
            float gt8[8]; bf16* gp = P + (size_t)row * NP + 3200 + col;
            unpack8(*(const u32x4*)gp, gt8);
#pragma unroll
            for (int e = 0; e < 8; ++e) gt8[e] = gelu_t(gt8[e]);
            u32x4 gw; gw.x = pk2(gt8[0], gt8[1]); gw.y = pk2(gt8[2], gt8[3]); gw.z = pk2(gt8[4], gt8[5]); gw.w = pk2(gt8[6], gt8[7]);
        }
    }
#endif
    __syncthreads();
    const int fr = lane & 15, fq = lane >> 4;
    const bf16* WL = (const bf16*)(ws + WS_WLORA) + (size_t)l * WL_STRIDE;
#ifdef SK_PREP_R
    if (false) {
#else
    if (wave < 6) {
#endif
        const int h = wave;
        const float* w0 = a.in[I_W0] + l * 384; const float* a0 = a.in[I_A0] + l * 384; const float* kkp = a.in[I_KK] + l * 384; const float* kap = a.in[I_KA] + l * 384;
        bf16* G = (bf16*)(ws + WS_G);
#pragma unroll 1
        for (int mi = mi_lo; mi < mi_hi; ++mi) {
            f32x4 aw[4], aa[4], ag[4];
#pragma unroll
            for (int ni = 0; ni < 4; ++ni) { aw[ni] = (f32x4){0.f, 0.f, 0.f, 0.f}; aa[ni] = aw[ni]; ag[ni] = aw[ni]; }
            const LAS bf16* arow = AL + (mi * 16 + fr) * 264 + fq * 8;
#pragma unroll
            for (int ks = 0; ks < 2; ++ks) { const bf16x8 Af = *(const LAS bf16x8*)(arow + ks * 32), Bf = *(const LAS bf16x8*)(arow + 64 + ks * 32);
#pragma unroll
                for (int ni = 0; ni < 4; ++ni) { const int n = h * 64 + ni * 16 + fr;
                    aw[ni] = __builtin_amdgcn_mfma_f32_16x16x32_bf16(*(const bf16x8*)(WL + n * 64 + ks * 32 + fq * 8), Af, aw[ni], 0, 0, 0);
                    aa[ni] = __builtin_amdgcn_mfma_f32_16x16x32_bf16(*(const bf16x8*)(WL + WL_AUP + n * 64 + ks * 32 + fq * 8), Bf, aa[ni], 0, 0, 0); } }
#pragma unroll
            for (int ks = 0; ks < 4; ++ks) { const bf16x8 Af = *(const LAS bf16x8*)(arow + 128 + ks * 32);
#pragma unroll
                for (int ni = 0; ni < 4; ++ni) { const int n = h * 64 + ni * 16 + fr;
                    ag[ni] = __builtin_amdgcn_mfma_f32_16x16x32_bf16(*(const bf16x8*)(WL + WL_GUP + n * 128 + ks * 32 + fq * 8), Af, ag[ni], 0, 0, 0); } }
            const int r = mi * 16 + fr, row = row0 + r, t = row & (TT - 1);
            const bool valid = samp || t > 0; const int prow = samp ? row + 128 : row - 1;
            float ssq = 0.f;
#pragma unroll
            for (int ni = 0; ni < 4; ++ni) {
                const int c0 = h * 64 + ni * 16 + fq * 4;
                const u32x2 uk = *(const u32x2*)(P + (size_t)row * NP + 384 + c0);
                u32x2 qk = (u32x2){0u, 0u}; if (valid) qk = *(const u32x2*)(P + (size_t)prow * NP + 384 + c0);
                const f32x4 mk = *(const f32x4*)(mu + 384 + c0), kk4 = *(const f32x4*)(kkp + c0);
                const float ck[4] = {bflo(uk.x), bfhi(uk.x), bflo(uk.y), bfhi(uk.y)}, ek[4] = {bflo(qk.x), bfhi(qk.x), bflo(qk.y), bfhi(qk.y)};
#pragma unroll
                for (int j = 0; j < 4; ++j) { const float kr = (ck[j] + mk[j] * (ek[j] - ck[j])) * kk4[j]; ssq += kr * kr; }
            }
            ssq += __shfl_xor(ssq, 16); ssq += __shfl_xor(ssq, 32);
            const float inv = rsqrtf(fmaxf(ssq, 1e-24f));
            unsigned char* rec = samp ? ws + WS_SCANS + (size_t)((row - MP) * 6 + h) * REC
                                      : ws + WS_SCAN + ((size_t)((row >> 11) * 6 + h) * TT + t) * REC;
#pragma unroll
            for (int ni = 0; ni < 4; ++ni) {
                asm volatile("" ::: "memory");
                const int i0 = ni * 16 + fq * 4, c0 = h * 64 + i0;
                const bf16* pr = P + (size_t)row * NP + c0; const bf16* pq = P + (size_t)prow * NP + c0;
                const u32x2 ur = *(const u32x2*)pr, uk = *(const u32x2*)(pr + 384), uv = *(const u32x2*)(pr + 768);
                u32x2 qr = (u32x2){0u, 0u}, qk = qr, qv = qr;
                if (valid) { qr = *(const u32x2*)pq; qk = *(const u32x2*)(pq + 384); qv = *(const u32x2*)(pq + 768); }
                const f32x4 mr = *(const f32x4*)(mu + c0), mk = *(const f32x4*)(mu + 384 + c0), mv = *(const f32x4*)(mu + 768 + c0);
                const f32x4 w04 = *(const f32x4*)(w0 + c0), a04 = *(const f32x4*)(a0 + c0), kk4 = *(const f32x4*)(kkp + c0), ka4 = *(const f32x4*)(kap + c0);
                const float cr[4] = {bflo(ur.x), bfhi(ur.x), bflo(ur.y), bfhi(ur.y)}, ck[4] = {bflo(uk.x), bfhi(uk.x), bflo(uk.y), bfhi(uk.y)}, cv[4] = {bflo(uv.x), bfhi(uv.x), bflo(uv.y), bfhi(uv.y)};
                const float er[4] = {bflo(qr.x), bfhi(qr.x), bflo(qr.y), bfhi(qr.y)}, ek[4] = {bflo(qk.x), bfhi(qk.x), bflo(qk.y), bfhi(qk.y)}, ev[4] = {bflo(qv.x), bfhi(qv.x), bflo(qv.y), bfhi(qv.y)};
                f32x4 wq, kq, bq; float rv[4], kv[4], vv[4];
#pragma unroll
                for (int j = 0; j < 4; ++j) {
                    const float rr = cr[j] + mr[j] * (er[j] - cr[j]), kx = ck[j] + mk[j] * (ek[j] - ck[j]), vx = cv[j] + mv[j] * (ev[j] - cv[j]);
                    const float sg = sigm(w04[j] + aw[ni][j]);
                    wq[j] = __expf(-0.6065306597f * sg);
                    const float aj = sigm(a04[j] + aa[ni][j]);
                    kq[j] = kx * kk4[j] * inv; bq[j] = kq[j] * aj;
                    kv[j] = kx * (1.f + (aj - 1.f) * ka4[j]); rv[j] = rr; vv[j] = vx;
                }
                *(f32x4*)(rec + 4 * i0) = wq; *(f32x4*)(rec + 256 + 4 * i0) = kq; *(f32x4*)(rec + 512 + 4 * i0) = bq;
                u32x4 rk; rk.x = pk2(rv[0], rv[1]); rk.y = pk2(rv[2], rv[3]); rk.z = pk2(kv[0], kv[1]); rk.w = pk2(kv[2], kv[3]);
                *(u32x4*)(rec + 768 + 4 * i0) = rk;
                u32x2 vp; vp.x = pk2(vv[0], vv[1]); vp.y = pk2(vv[2], vv[3]);
                *(u32x2*)(rec + 1024 + 2 * i0) = vp;
                u32x2 gp; gp.x = pk2(ag[ni][0], ag[ni][1]); gp.y = pk2(ag[ni][2], ag[ni][3]);
                *(u32x2*)(G + (size_t)row * 384 + c0) = gp;
            }
        }
    } else
#ifdef SK_PREP_L
    if (false)
#endif
    {
        const float* ba = a.in[I_BA] + l * 256; const float* bx = a.in[I_BX] + l * 256; const float* lam = a.in[I_LAM] + l * 256;
        bf16* LA = (bf16*)(ws + WS_LA); bf16* LU = (bf16*)(ws + WS_LU);
#pragma unroll 1
        for (int nn = 0; nn < 2; ++nn) {
            const int n = (wave - 6) * 2 + nn;
            bf16x8 Wa[4][2], Wx[4][2];
#pragma unroll
            for (int ni = 0; ni < 4; ++ni) { const int d = ni * 16 + fr;
#pragma unroll
                for (int ks = 0; ks < 2; ++ks) { Wa[ni][ks] = *(const bf16x8*)(WL + WL_WA + n * 4096 + d * 64 + ks * 32 + fq * 8); Wx[ni][ks] = *(const bf16x8*)(WL + WL_WX + n * 4096 + d * 64 + ks * 32 + fq * 8); }
            }
#pragma unroll 1
            for (int mi = mi_lo; mi < mi_hi; ++mi) {
                f32x4 ar[4], ax[4];
#pragma unroll
                for (int ni = 0; ni < 4; ++ni) { ar[ni] = (f32x4){0.f, 0.f, 0.f, 0.f}; ax[ni] = ar[ni]; }
#pragma unroll
                for (int ks = 0; ks < 2; ++ks) { const bf16x8 Af = *(const LAS bf16x8*)(XC + (mi * 16 + fr) * 264 + n * 64 + ks * 32 + fq * 8);
#pragma unroll
                    for (int ni = 0; ni < 4; ++ni) { ar[ni] = __builtin_amdgcn_mfma_f32_16x16x32_bf16(Wa[ni][ks], Af, ar[ni], 0, 0, 0); ax[ni] = __builtin_amdgcn_mfma_f32_16x16x32_bf16(Wx[ni][ks], Af, ax[ni], 0, 0, 0); } }
                const int r = mi * 16 + fr, row = row0 + r;
#pragma unroll
                for (int ni = 0; ni < 4; ++ni) {
                    const int c0 = n * 64 + ni * 16 + fq * 4;
                    const f32x4 ba4 = *(const f32x4*)(ba + c0), bx4 = *(const f32x4*)(bx + c0), sp4 = *(const LAS f32x4*)(SPT + c0);
                    const u32x2 xu = *(const LAS u32x2*)(XC + r * 264 + c0);
                    const float xcv[4] = {bflo(xu.x), bfhi(xu.x), bflo(xu.y), bfhi(xu.y)};
                    float la[4], uu[4];
#pragma unroll
                    for (int j = 0; j < 4; ++j) {
                        const float rr = sigm(ar[ni][j] + ba4[j]), ii = sigm(ax[ni][j] + bx4[j]);
                        la[j] = -8.f * rr * sp4[j];
                        uu[j] = xcv[j] * ii * sqrtf(fmaxf(-expm1f(2.f * la[j]), 1e-12f));
                    }
                    u32x2 o1, o2; o1.x = pk2(la[0], la[1]); o1.y = pk2(la[2], la[3]); o2.x = pk2(uu[0], uu[1]); o2.y = pk2(uu[2], uu[3]);
                    *(u32x2*)(LA + (size_t)row * 256 + c0) = o1; *(u32x2*)(LU + (size_t)row * 256 + c0) = o2;
                }
            }
        }
    }
    __syncthreads();
}

DEV void phase_prep_old(const Args& a, int l, LAS unsigned char* lds, bool do_gelu = true) {
    const int tid = otid(), lane = tid & 63, wave = tid >> 6;
    const int gw = blockIdx.x * NWV + wave, NGW = gridDim.x * NWV;
    unsigned char* ws = a.ws;
    prep_tile_old(a, l, blockIdx.x, lds, do_gelu);
    if (blockIdx.x >= 248) { const int q = blockIdx.x - 248; prep_tile_old(a, l, 256 + (q >> 2), lds, do_gelu, q & 3, (q & 3) + 1); }
    const float* rss = (const float*)(ws + WS_RSE);
    for (int r = gw; r < 136; r += NGW) {
        const int row = r < 8 ? r * TT + TT - 1 : MP + (r - 8);
        const f32x4* src = (const f32x4*)(row < MP ? a.out + (size_t)row * DM : (const float*)(ws + WS_XS) + (size_t)(row - MP) * DM);
        f32x4* dst = (f32x4*)(r < 8 ? a.out + O_PSHIFT + (size_t)(l * 8 + r) * DM : a.out + O_SSHIFT + (size_t)(l * 128 + (r - 8)) * DM);
        const f32x4* g4 = (const f32x4*)(a.in[I_N1G] + l * DM);
        const float s = row_scale(rss, row);
#pragma unroll
        for (int j = 0; j < 4; ++j) { const f32x4 v = src[lane + 64 * j], g = g4[lane + 64 * j]; dst[lane + 64 * j] = (f32x4){v[0] * s * g[0], v[1] * s * g[1], v[2] * s * g[2], v[3] * s * g[3]}; }
    }
    if (l + 2 < 4) {
        bf16* U = (bf16*)(ws + ((l & 1) ? WS_U1 : WS_U0));
        for (int i = gw; i < 128; i += NGW) {
            const f32x4* src = (const f32x4*)(a.in[I_SSHIFT] + (size_t)((l + 2) * 128 + i) * DM);
            u32x2* ud = (u32x2*)(U + (size_t)(MREAL + i) * DM);
#pragma unroll
            for (int j = 0; j < 4; ++j) { const f32x4 v = src[lane + 64 * j]; u32x2 w; w.x = pk2(v[0], v[1]); w.y = pk2(v[2], v[3]); ud[lane + 64 * j] = w; }
        }
    }
    __syncthreads();
    LAS float* scr = (LAS float*)(lds + wave * 8448);
    if (blockIdx.x < 248) {
    const int NGW2 = 248 * NWV; int it = gw;
    transpose_job(a.in[I_WOUT] + (size_t)l * DM * DM, DM, DM, (bf16*)(ws + WS_WTOUT), it, NGW2, scr, lane);
    transpose_job(a.in[I_W1] + (size_t)l * DM * FF, DM, FF, (bf16*)(ws + WS_WT1), it, NGW2, scr, lane);
    transpose_job(a.in[I_W2] + (size_t)l * FF * DM, FF, DM, (bf16*)(ws + WS_WT2), it, NGW2, scr, lane);
    }
#ifdef DUP_TR
    if (blockIdx.x < 248) { const int NGW2 = 248 * NWV; int it = gw;
    transpose_job(a.in[I_WOUT] + (size_t)l * DM * DM, DM, DM, (bf16*)(ws + WS_WTOUT), it, NGW2, scr, lane);
    transpose_job(a.in[I_W1] + (size_t)l * DM * FF, DM, FF, (bf16*)(ws + WS_WT1), it, NGW2, scr, lane);
    transpose_job(a.in[I_W2] + (size_t)l * FF * DM, FF, DM, (bf16*)(ws + WS_WT2), it, NGW2, scr, lane);
    }
#endif
}

DEV void rwkv_scan_block(const Args& a, int l, int blk, LAS unsigned char* lds) {
    const int tid = otid(), lane = tid & 63, wave = __builtin_amdgcn_readfirstlane(tid >> 6);
    unsigned char* ws = a.ws;
    const int bh = blk >> 2, rg = blk & 3;
    const unsigned char* recbase = ws + WS_SCAN + (size_t)bh * TT * REC;
    constexpr int CH = 32, CHB = CH * REC, NCH = TT / CH;
    const int lt = tid - 256;
    u32x4 ra[9], rb[9];
#define RW_LOAD(dst, chunk) do { const u32x4* src_ = (const u32x4*)(recbase + (size_t)(chunk) * CHB); _Pragma("unroll") for (int q = 0; q < 9; ++q) dst[q] = src_[lt + 256 * q]; } while (0)
#define RW_STORE(srcv, buf) do { LAS unsigned char* d_ = lds + (buf) * CHB; _Pragma("unroll") for (int q = 0; q < 9; ++q) *(LAS u32x4*)(d_ + (lt + 256 * q) * 16) = srcv[q]; } while (0)
    if (wave >= 4) { RW_LOAD(ra, 0); RW_LOAD(rb, 1); RW_STORE(ra, 0); RW_LOAD(ra, 2); }
    __syncthreads();
    const int g = lane >> 4, j = lane & 15, rowv = rg * 16 + (wave & 3) * 4 + g;
    float S0 = 0.f, S1 = 0.f, S2 = 0.f, S3 = 0.f, keep = 0.f;
    bf16* outr = (bf16*)(ws + WS_OUTR) + (size_t)(bh * 64 + rowv) * TT;
#define RW_LD(W, K, B, RK, V, tl) do { const LAS unsigned char* rec_ = buf + (tl) * REC; W = *(const LAS f32x4*)(rec_ + 16 * j); K = *(const LAS f32x4*)(rec_ + 256 + 16 * j); \
        B = *(const LAS f32x4*)(rec_ + 512 + 16 * j); RK = *(const LAS u32x4*)(rec_ + 768 + 16 * j); V = *(const LAS unsigned short*)(rec_ + 1024 + 2 * rowv); } while (0)
#define RW_SCAN(c) do { const LAS unsigned char* buf = lds + ((c) & 1) * CHB; \
        f32x4 w4, k4, b4, nw, nk, nb; u32x4 rk, nrk; unsigned short vs, nvs; \
        RW_LD(w4, k4, b4, rk, vs, 0); nw = w4; nk = k4; nb = b4; nrk = rk; nvs = vs; \
        _Pragma("unroll 16") for (int tl = 0; tl < CH; ++tl) { \
            if (tl + 1 < CH) RW_LD(nw, nk, nb, nrk, nvs, tl + 1); \
            const float vv = bf2f(vs); \
            float sa = (S0 * k4[0] + S1 * k4[1]) + (S2 * k4[2] + S3 * k4[3]); \
            sa = -red16(sa); \
            S0 = S0 * w4[0] + (sa * b4[0] + vv * bflo(rk.z)); S1 = S1 * w4[1] + (sa * b4[1] + vv * bfhi(rk.z)); \
            S2 = S2 * w4[2] + (sa * b4[2] + vv * bflo(rk.w)); S3 = S3 * w4[3] + (sa * b4[3] + vv * bfhi(rk.w)); \
            float o = (S0 * bflo(rk.x) + S1 * bfhi(rk.x)) + (S2 * bflo(rk.y) + S3 * bfhi(rk.y)); \
            o = red16(o); \
            if (j == (tl & 15)) keep = o; \
            if ((tl & 15) == 15) outr[(c) * CH + (tl - 15) + j] = f2bf(keep); \
            w4 = nw; k4 = nk; b4 = nb; rk = nrk; vs = nvs; } } while (0)
#pragma unroll 1
    for (int c = 0; c < NCH; c += 2) {
        if (wave >= 4) { RW_STORE(rb, 1); if (c + 3 < NCH) RW_LOAD(rb, c + 3); }
        else RW_SCAN(c);
        __syncthreads();
        if (wave >= 4) { if (c + 2 < NCH) { RW_STORE(ra, 0); if (c + 4 < NCH) RW_LOAD(ra, c + 4); } }
        else RW_SCAN(c + 1);
        __syncthreads();
    }
#undef RW_LOAD
#undef RW_STORE
#undef RW_SCAN
#undef RW_LD
    if (wave < 4) { float* so = a.out + O_PWKV + ((size_t)(l * 48 + bh) * 64 + rowv) * 64 + 4 * j; *(f32x4*)so = (f32x4){S0, S1, S2, S3}; }
}

DEV void hgrn_scan_block(const Args& a, int l, int bh, LAS unsigned char* lds) {
    const int tid = otid(), lane = tid & 63, wave = __builtin_amdgcn_readfirstlane(tid >> 6);
    unsigned char* ws = a.ws;
    const int b = bh / 6, h = bh % 6;
    const bf16* P = (const bf16*)(ws + WS_P);
    bf16* mix = (bf16*)(ws + (((l + 1) & 1) ? WS_U1 : WS_U0));
    constexpr int PT = 72, ARR = 64 * PT * 2;
    LAS bf16* Qm = (LAS bf16*)lds; LAS bf16* Km = Qm + 64 * PT; LAS bf16* Qb = Km + 64 * PT; LAS bf16* KbT = Qb + 64 * PT; LAS bf16* VT = KbT + 64 * PT;
    LAS bf16* AT = VT + 64 * PT; LAS bf16* ST0 = AT + 64 * PT;
    LAS float* O = (LAS float*)(lds + 8 * ARR);
    LAS float* GT = O + 4096;
    LAS float* EB = GT + 512;
    const int k = lane, tg = wave;
    const float lb = ((const float*)(ws + WS_LBT))[l * 384 + h * 64 + k];
    const float ng = a.in[I_HNG][l * 384 + h * 64 + lane];
    const int fr = lane & 15, fq = lane >> 4;
    f32x4 Sacc[2];
    Sacc[0] = (f32x4){0.f, 0.f, 0.f, 0.f}; Sacc[1] = Sacc[0];
    {
        for (int i = tid; i < 64 * PT / 2; i += NT) ((LAS unsigned*)ST0)[i] = 0u;
    }
    __syncthreads();
#define HG_BAR() asm volatile("s_waitcnt lgkmcnt(0)\n\ts_barrier" ::: "memory")
    unsigned short nq[8], nf[8], nv[8], ngt[8];
#define HG_PREF(chunk) do { _Pragma("unroll") for (int i = 0; i < 8; ++i) { const bf16* pr_ = P + (size_t)(b * TT + (chunk) * 64 + tg * 8 + i) * NP + 1408 + h * 64 + k; \
        nq[i] = pr_[0]; nf[i] = pr_[384]; nv[i] = pr_[768]; ngt[i] = pr_[1152]; } } while (0)
    HG_PREF(0);
#pragma unroll 1
    for (int c = 0; c < TT / 64; ++c) {
        const int rowc = b * TT + c * 64;
        LAS bf16* STr = ST0 + (c & 1) * 64 * PT; LAS bf16* STw = ST0 + ((c + 1) & 1) * 64 * PT;
        float q[8], kin[8], cs[8], iv[8], gcur[8];
#pragma unroll
        for (int i = 0; i < 8; ++i) {
            q[i] = bf2f(nq[i]); const float fp = bf2f(nf[i]); iv[i] = bf2f(nv[i]); gcur[i] = bf2f(ngt[i]);
            const float sg = sigm(fp); kin[i] = (1.f - lb) * sigm(-fp); const float f = lb + (1.f - lb) * sg;
            cs[i] = __logf(f) + (i ? cs[i - 1] : 0.f); }
        if (c + 1 < TT / 64) HG_PREF(c + 1);
        GT[tg * 64 + k] = cs[7];
        HG_BAR();
        float off = 0.f, m = 0.f, bl = 0.f;
#pragma unroll
        for (int g2 = 0; g2 < 8; ++g2) { const float gv = GT[g2 * 64 + k]; if (g2 < tg) off += gv; if (g2 < 4) m += gv; bl += gv; }
        if (tg == 0) EB[k] = __expf(bl);
        {
            unsigned kb8[8], vt8[8];
#pragma unroll
            for (int i = 0; i < 8; ++i) { const int t = tg * 8 + i; const float bb = off + cs[i];
                Qm[t * PT + k] = f2bf(q[i] * __expf(bb - m)); Km[t * PT + k] = f2bf(kin[i] * __expf(m - bb)); Qb[t * PT + k] = f2bf(q[i] * __expf(bb));
                kb8[i] = f2bf(kin[i] * __expf(bl - bb)); vt8[i] = f2bf(iv[i]); }
            u32x4 w1, w2; w1.x = kb8[0] | (kb8[1] << 16); w1.y = kb8[2] | (kb8[3] << 16); w1.z = kb8[4] | (kb8[5] << 16); w1.w = kb8[6] | (kb8[7] << 16);
            w2.x = vt8[0] | (vt8[1] << 16); w2.y = vt8[2] | (vt8[3] << 16); w2.z = vt8[4] | (vt8[5] << 16); w2.w = vt8[6] | (vt8[7] << 16);
            *(LAS u32x4*)(KbT + k * PT + tg * 8) = w1; *(LAS u32x4*)(VT + k * PT + tg * 8) = w2;
        }
        HG_BAR();
        {
            const int tr = wave >> 1;
#pragma unroll
            for (int i = 0; i < 2; ++i) { const int sc = (wave & 1) * 2 + i;
                f32x4 acc = (f32x4){0.f, 0.f, 0.f, 0.f};
                if (sc <= tr) {
#pragma unroll
                    for (int ks = 0; ks < 2; ++ks) { const bf16x8 af = *(const LAS bf16x8*)(Km + (sc * 16 + fr) * PT + ks * 32 + fq * 8), bfr = *(const LAS bf16x8*)(Qm + (tr * 16 + fr) * PT + ks * 32 + fq * 8);
                        acc = __builtin_amdgcn_mfma_f32_16x16x32_bf16(af, bfr, acc, 0, 0, 0); }
                }
                const int t = tr * 16 + fr, s0 = sc * 16 + fq * 4;
                u32x2 w; w.x = pk2(s0 <= t ? acc[0] : 0.f, s0 + 1 <= t ? acc[1] : 0.f); w.y = pk2(s0 + 2 <= t ? acc[2] : 0.f, s0 + 3 <= t ? acc[3] : 0.f);
                *(LAS u32x2*)(AT + t * PT + s0) = w; }
        }
        HG_BAR();
        {
            const int tr = wave >> 1, kb = wave >> 1;
#pragma unroll
            for (int i = 0; i < 2; ++i) { const int vb = (wave & 1) * 2 + i;
                f32x4 acc = (f32x4){0.f, 0.f, 0.f, 0.f};
#pragma unroll
                for (int ks = 0; ks < 2; ++ks) {
                    if (ks * 2 <= tr) { const bf16x8 af = *(const LAS bf16x8*)(VT + (vb * 16 + fr) * PT + ks * 32 + fq * 8), bfr = *(const LAS bf16x8*)(AT + (tr * 16 + fr) * PT + ks * 32 + fq * 8);
                        acc = __builtin_amdgcn_mfma_f32_16x16x32_bf16(af, bfr, acc, 0, 0, 0); }
                    const bf16x8 a2 = *(const LAS bf16x8*)(STr + (vb * 16 + fr) * PT + ks * 32 + fq * 8), b2 = *(const LAS bf16x8*)(Qb + (tr * 16 + fr) * PT + ks * 32 + fq * 8);
                    acc = __builtin_amdgcn_mfma_f32_16x16x32_bf16(a2, b2, acc, 0, 0, 0); }
                *(LAS f32x4*)(O + (tr * 16 + fr) * 64 + vb * 16 + fq * 4) = acc;
                f32x4 kv = (f32x4){0.f, 0.f, 0.f, 0.f};
#pragma unroll
                for (int ks = 0; ks < 2; ++ks) { const bf16x8 af = *(const LAS bf16x8*)(KbT + (kb * 16 + fr) * PT + ks * 32 + fq * 8), bfr = *(const LAS bf16x8*)(VT + (vb * 16 + fr) * PT + ks * 32 + fq * 8);
                    kv = __builtin_amdgcn_mfma_f32_16x16x32_bf16(af, bfr, kv, 0, 0, 0); }
                const f32x4 eb = *(const LAS f32x4*)(EB + kb * 16 + fq * 4);
                Sacc[i][0] = eb[0] * Sacc[i][0] + kv[0]; Sacc[i][1] = eb[1] * Sacc[i][1] + kv[1]; Sacc[i][2] = eb[2] * Sacc[i][2] + kv[2]; Sacc[i][3] = eb[3] * Sacc[i][3] + kv[3];
                u32x2 w; w.x = pk2(Sacc[i][0], Sacc[i][1]); w.y = pk2(Sacc[i][2], Sacc[i][3]);
                *(LAS u32x2*)(STw + (vb * 16 + fr) * PT + kb * 16 + fq * 4) = w; }
        }
        HG_BAR();
#pragma unroll
        for (int itx = 0; itx < 8; ++itx) { const int t = wave * 8 + itx, row = rowc + t;
            const float o = O[t * 64 + lane];
            const float ss = wave_sum(o * o);
            const float gte = gcur[itx];
            mix[(size_t)row * DM + 384 + h * 64 + lane] = f2bf(o * rsqrtf(ss * (1.f / 64.f) + EPS) * ng * (gte * sigm(gte))); }
    }
#undef HG_BAR
#undef HG_PREF
    {
        const int kb = wave >> 1;
#pragma unroll
        for (int i = 0; i < 2; ++i) { const int vb = (wave & 1) * 2 + i;
            float* so = a.out + O_PHGRN + ((size_t)(l * 48 + bh) * 64 + kb * 16 + fq * 4) * 64 + vb * 16 + fr;
            so[0] = Sacc[i][0]; so[64] = Sacc[i][1]; so[128] = Sacc[i][2]; so[192] = Sacc[i][3]; }
    }
}

DEV void lru_scan_block(const Args& a, int l, int i, LAS unsigned char* lds) {
    const int tid = otid();
    unsigned char* ws = a.ws;
    const int b = i >> 1, cb = (i & 1) * 128;
    const bf16* P = (const bf16*)(ws + WS_P); const bf16* LA = (const bf16*)(ws + WS_LA); const bf16* LU = (const bf16*)(ws + WS_LU);
    bf16* mix = (bf16*)(ws + (((l + 1) & 1) ? WS_U1 : WS_U0));
    constexpr int TILE = 64 * 128 * 2;
    u32x4 rg[6];
#define LRU_LOAD(tile) do { _Pragma("unroll") for (int q = 0; q < 2; ++q) { const int p = tid + 512 * q; const size_t row = (size_t)b * TT + (tile) * 64 + (p >> 4); const int cc = cb + (p & 15) * 8; \
        rg[q] = *(const u32x4*)(LA + row * 256 + cc); rg[2 + q] = *(const u32x4*)(LU + row * 256 + cc); rg[4 + q] = *(const u32x4*)(P + row * NP + 3200 + cc); } } while (0)
#define LRU_STORE(buf) do { _Pragma("unroll") for (int q = 0; q < 2; ++q) { const int p = tid + 512 * q; \
        *(LAS u32x4*)(lds + (buf) * 3 * TILE + p * 16) = rg[q]; *(LAS u32x4*)(lds + (buf) * 3 * TILE + TILE + p * 16) = rg[2 + q]; { float g8_[8]; unpack8(rg[4 + q], g8_); _Pragma("unroll") for (int e_ = 0; e_ < 8; ++e_) g8_[e_] = gelu_t(g8_[e_]); u32x4 gw_; gw_.x = pk2(g8_[0], g8_[1]); gw_.y = pk2(g8_[2], g8_[3]); gw_.z = pk2(g8_[4], g8_[5]); gw_.w = pk2(g8_[6], g8_[7]); \
          *(LAS u32x4*)(lds + (buf) * 3 * TILE + 2 * TILE + p * 16) = gw_; } } } while (0)
    LRU_LOAD(0); LRU_STORE(0);
    __syncthreads();
    float h = 0.f;
#pragma unroll 1
    for (int tile = 0; tile < TT / 64; ++tile) {
        if (tile + 1 < TT / 64) LRU_LOAD(tile + 1);
        if (tid < 128) {
            const LAS unsigned short* la = (const LAS unsigned short*)(lds + (tile & 1) * 3 * TILE) + tid; const LAS unsigned short* lu = la + TILE / 2; const LAS unsigned short* gg = lu + TILE / 2;
            bf16* mo = mix + ((size_t)b * TT + tile * 64) * DM + 768 + cb + tid;
#pragma unroll 8
            for (int t = 0; t < 64; ++t) { h = __expf(bf2f(la[t * 128])) * h + bf2f(lu[t * 128]); mo[(size_t)t * DM] = f2bf(h * bf2f(gg[t * 128])); }
        }
        if (tile + 1 < TT / 64) LRU_STORE((tile + 1) & 1);
        __syncthreads();
    }
#undef LRU_LOAD
#undef LRU_STORE
    if (tid < 128) a.out[O_PLRU + (size_t)(l * 8 + b) * 256 + cb + tid] = h;
}

DEV void phase_post(const Args& a, int l, LAS unsigned char* lds) {
    const int tid = otid(), lane = tid & 63, wave = __builtin_amdgcn_readfirstlane(tid >> 6);
    unsigned char* ws = a.ws;
    const bf16* P = (const bf16*)(ws + WS_P); const bf16* G = (const bf16*)(ws + WS_G);
    bf16* mix = (bf16*)(ws + (((l + 1) & 1) ? WS_U1 : WS_U0));
    LAS unsigned short* OT = (LAS unsigned short*)lds;
    const float* lnw = a.in[I_LNW] + l * 384; const float* lnb = a.in[I_LNB] + l * 384; const float* rkp = a.in[I_RK] + l * 384;
#pragma unroll 1
    for (int item = blockIdx.x; item < 1536; item += gridDim.x) {
        const int b = item / 192, rem = item % 192, h = rem >> 5, t0 = (rem & 31) * 64, bh = b * 6 + h;
        { const int v = tid >> 3, seg = tid & 7; const u32x4 u = *(const u32x4*)((const bf16*)(ws + WS_OUTR) + (size_t)(bh * 64 + v) * TT + t0 + seg * 8);
          LAS unsigned* d = (LAS unsigned*)(OT + v * 66 + seg * 8); d[0] = u.x; d[1] = u.y; d[2] = u.z; d[3] = u.w; }
        __syncthreads();
        const float w_ = lnw[h * 64 + lane], b_ = lnb[h * 64 + lane], rk_ = rkp[h * 64 + lane];
#pragma unroll 2
        for (int q = 0; q < 8; ++q) {
            const int tt = wave * 8 + q, row = b * TT + t0 + tt;
            const float o = bf2f(OT[lane * 66 + tt]);
            const float mean = wave_sum(o) * (1.f / 64.f), d = o - mean, var = wave_sum(d * d) * (1.f / 64.f);
            const float gn = d * rsqrtf(var + 64e-5f) * w_ + b_;
            const unsigned char* rec = ws + WS_SCAN + ((size_t)bh * TT + t0 + tt) * REC;
            const float rr = bf2f(*(const unsigned short*)(rec + 768 + 16 * (lane >> 2) + 2 * (lane & 3))), kk = bf2f(*(const unsigned short*)(rec + 776 + 16 * (lane >> 2) + 2 * (lane & 3)));
            const float cb = wave_sum(rr * kk * rk_), vv = bf2f(*(const unsigned short*)(rec + 1024 + 2 * lane));
            const float gg = bf2f(G[(size_t)row * 384 + h * 64 + lane]);
            mix[(size_t)row * DM + h * 64 + lane] = f2bf((gn + cb * vv) * gg);
        }
        __syncthreads();
    }
    const int gw = __builtin_amdgcn_readfirstlane(blockIdx.x * NWV + wave), NGW = gridDim.x * NWV;
#pragma unroll 1
    for (int it = gw; it < 1664; it += NGW) {
        if (it < 768) {
            const int i = it / 6, h = it % 6, row = MP + i;
            const unsigned char* rec = ws + WS_SCANS + (size_t)(i * 6 + h) * REC;
            const float* s0 = a.in[I_SWKV] + ((size_t)((l * 128 + i) * 6 + h) * 64 + lane) * 64;
            float* s1 = a.out + O_SWKV + ((size_t)((l * 128 + i) * 6 + h) * 64 + lane) * 64;
            float sa = 0.f;
#pragma unroll 4
            for (int k4 = 0; k4 < 16; ++k4) { const f32x4 v = *(const f32x4*)(s0 + 4 * k4), kq = *(const f32x4*)(rec + 256 + 16 * k4);
                sa -= (v[0] * kq[0] + v[1] * kq[1]) + (v[2] * kq[2] + v[3] * kq[3]); }
            const float vv = bf2f(*(const unsigned short*)(rec + 1024 + 2 * lane));
            float o = 0.f, cb = 0.f;
#pragma unroll 4
            for (int k4 = 0; k4 < 16; ++k4) {
                f32x4 v = *(const f32x4*)(s0 + 4 * k4); const f32x4 w = *(const f32x4*)(rec + 16 * k4), bb = *(const f32x4*)(rec + 512 + 16 * k4), rk4 = *(const f32x4*)(rkp + h * 64 + 4 * k4);
                const u32x4 rk = *(const u32x4*)(rec + 768 + 16 * k4);
                const float rr[4] = {bflo(rk.x), bfhi(rk.x), bflo(rk.y), bfhi(rk.y)}, kx[4] = {bflo(rk.z), bfhi(rk.z), bflo(rk.w), bfhi(rk.w)};
#pragma unroll
                for (int e = 0; e < 4; ++e) { v[e] = v[e] * w[e] + (sa * bb[e] + vv * kx[e]); o += v[e] * rr[e]; cb += rr[e] * kx[e] * rk4[e]; }
                *(f32x4*)(s1 + 4 * k4) = v; }
            const float mean = wave_sum(o) * (1.f / 64.f), d = o - mean, var = wave_sum(d * d) * (1.f / 64.f);
            const float gn = d * rsqrtf(var + 64e-5f) * lnw[h * 64 + lane] + lnb[h * 64 + lane];
            const float gg = bf2f(G[(size_t)row * 384 + h * 64 + lane]);
            mix[(size_t)row * DM + h * 64 + lane] = f2bf((gn + cb * vv) * gg);
        } else if (it < 1536) {
            const int i = (it - 768) / 6, h = (it - 768) % 6, row = MP + i;
            const bf16* pr = P + (size_t)row * NP + 1408 + h * 64;
            const float* s0 = a.in[I_SHGRN] + (size_t)((l * 128 + i) * 6 + h) * 4096 + lane;
            float* s1 = a.out + O_SHGRN + (size_t)((l * 128 + i) * 6 + h) * 4096 + lane;
            const float* lbt = (const float*)(ws + WS_LBT) + l * 384 + h * 64;
            const float iv = bf2f(pr[768 + lane]); float o = 0.f;
#pragma unroll 8
            for (int k = 0; k < 64; ++k) { const float q = bf2f(pr[k]), fp = bf2f(pr[384 + k]), lb = lbt[k];
                const float f = lb + (1.f - lb) * sigm(fp), ki = (1.f - lb) * sigm(-fp);
                const float s = f * s0[k * 64] + ki * iv; s1[k * 64] = s; o += q * s; }
            const float ss = wave_sum(o * o), gte = bf2f(pr[1152 + lane]);
            mix[(size_t)row * DM + 384 + h * 64 + lane] = f2bf(o * rsqrtf(ss * (1.f / 64.f) + EPS) * a.in[I_HNG][l * 384 + h * 64 + lane] * (gte * sigm(gte)));
        } else {
            const int i = it - 1536, row = MP + i;
#pragma unroll
            for (int q = 0; q < 4; ++q) { const int c = lane + 64 * q;
                const float la = bf2f(((const bf16*)(ws + WS_LA))[(size_t)row * 256 + c]), u = bf2f(((const bf16*)(ws + WS_LU))[(size_t)row * 256 + c]);
                const float hh = __expf(la) * a.in[I_SLRU][(size_t)(l * 128 + i) * 256 + c] + u;
                a.out[O_SLRU + (size_t)(l * 128 + i) * 256 + c] = hh;
                mix[(size_t)row * DM + 768 + c] = f2bf(hh * gelu_t(bf2f(P[(size_t)row * NP + 3200 + c]))); }
        }
    }
    if (l + 1 < 4) {
        __syncthreads();
        LAS float* scr = (LAS float*)(lds + wave * 8448);
        int it = gw;
        transpose_job(a.in[I_WIN] + (size_t)(l + 1) * DM * 3456, DM, 3456, (bf16*)(ws + WS_WTIN), it, NGW, scr, lane);
    }
}

DEV void phase_final(const Args& a) {
    const int tid = otid(), lane = tid & 63, wave = tid >> 6;
    const int gw = blockIdx.x * NWV + wave, NGW = gridDim.x * NWV;
    const float* rss = (const float*)(a.ws + WS_RSE);
    const f32x4* g4 = (const f32x4*)a.in[I_FG];
    for (int row = gw; row < MREAL; row += NGW) {
        const f32x4* src = (const f32x4*)(row < MP ? a.out + (size_t)row * DM : (const float*)(a.ws + WS_XS) + (size_t)(row - MP) * DM);
        f32x4* dst = (f32x4*)(a.out + (size_t)row * DM);
        const float s = row_scale(rss, row);
#pragma unroll
        for (int j = 0; j < 4; ++j) { const f32x4 v = src[lane + 64 * j], g = g4[lane + 64 * j]; dst[lane + 64 * j] = (f32x4){v[0] * s * g[0], v[1] * s * g[1], v[2] * s * g[2], v[3] * s * g[3]}; }
    }
}

constexpr size_t WS_PART = 232 * MiB;
struct EpiPart {
    static constexpr bool PERM = false, AFTER_DRAIN = false;
    float* O;
    DEV void operator()(const pg8::f32x4 (&acc)[2][2][4][2], const pg8::Unit& u, int wr, int wc, int fr, int fq) const {
        const int col0 = u.pn * 256 + wc * 32 + 4 * fq;
#pragma unroll
        for (int m = 0; m < 4; ++m) { const int row = wr * 64 + fr + m * 16;
            float* rp_ = O + (size_t)row * DM + col0;
#pragma unroll
            for (int bj = 0; bj < 2; ++bj)
#pragma unroll
                for (int n = 0; n < 2; ++n) { const pg8::f32x4 v = acc[0][bj][m][n]; *(f32x4*)(rp_ + bj * 128 + n * 16) = (f32x4){v[0], v[1], v[2], v[3]}; } }
    }
};
struct OneUnit {
    int pn;
    DEV bool next(int i, pg8::Unit& u) const { if (i) return false; u.pm = 0; u.pn = pn; return true; }
    DEV void a_ready(const pg8::Unit&) const {}
    DEV void done(const pg8::Unit&) const {}
};
DEV void phase_sample_reduce(const Args& a, bf16* U, const float* g, float* rs) {
    const int tid = otid(), lane = tid & 63, wave = tid >> 6;
    const int gw = blockIdx.x * NWV + wave;
    if (gw >= 128) return;
    const float* part = (const float*)(a.ws + WS_PART);
    f32x4* xr = (f32x4*)((float*)(a.ws + WS_XS) + (size_t)gw * DM);
    u32x2* ud = (u32x2*)(U + (size_t)(MP + gw) * DM);
    const f32x4* g4 = (const f32x4*)g;
    float ss = 0.f;
#pragma unroll
    for (int j = 0; j < 4; ++j) { const int o = lane + 64 * j;
        f32x4 x = xr[o];
        const f32x4 p0 = ((const f32x4*)(part + (size_t)(0 * 128 + gw) * DM))[o], p1 = ((const f32x4*)(part + (size_t)(1 * 128 + gw) * DM))[o],
                    p2 = ((const f32x4*)(part + (size_t)(2 * 128 + gw) * DM))[o], p3 = ((const f32x4*)(part + (size_t)(3 * 128 + gw) * DM))[o];
#pragma unroll
        for (int e = 0; e < 4; ++e) x[e] += (p0[e] + p1[e]) + (p2[e] + p3[e]);
        xr[o] = x; ss += (x[0] * x[0] + x[1] * x[1]) + (x[2] * x[2] + x[3] * x[3]);
        const f32x4 gv = g4[o]; u32x2 w; w.x = pk2(x[0] * gv[0], x[1] * gv[1]); w.y = pk2(x[2] * gv[2], x[3] * gv[3]); ud[o] = w; }
    ss = wave_sum(ss);
    if (lane < 16) rs[(size_t)(MP + gw) * 16 + lane] = lane == 0 ? ss : 0.f;
}

#define XB_TMO      128
#define XB_XCNT(j)  (256  + 64 * (j))
#define XB_XSUB(j)  (1280 + 64 * (j))
#define XB_XGEN(j)  (2304 + 64 * (j))
#define XB_TOP      3328
#define XB_TOPGEN   3392
#define XCD_BAR_WORDS 3456
#define XB_SPIN_CAP (1u << 22)

__device__ __forceinline__ unsigned xb_ld(unsigned* p)              { return __hip_atomic_load(p, __ATOMIC_RELAXED, __HIP_MEMORY_SCOPE_AGENT); }
__device__ __forceinline__ unsigned xb_add(unsigned* p, unsigned v) { return __hip_atomic_fetch_add(p, v, __ATOMIC_RELAXED, __HIP_MEMORY_SCOPE_AGENT); }
__device__ __forceinline__ unsigned xb_xcc_id() { return (unsigned)__builtin_amdgcn_s_getreg((3 << 11) | 20) & 0xFu; }
#define XB_SPIN(cond, bar) do { unsigned _sp = 0; while (cond) { __builtin_amdgcn_s_sleep(1); \
    if ((++_sp & 255u) == 0u) { if (xb_ld(&(bar)[XB_TMO])) break; if (_sp > XB_SPIN_CAP) { atomicAdd(&(bar)[XB_TMO], 1u); break; } } } } while (0)

struct XcdBarrier {
    unsigned* bar; unsigned x;
    volatile LAS unsigned* st;
};

__device__ __forceinline__ XcdBarrier xcd_barrier_post(unsigned* bar, volatile LAS unsigned* st) {
    XcdBarrier b; b.bar = bar; b.x = xb_xcc_id(); b.st = st;
    if (threadIdx.x == 0) (void)xb_add(&bar[XB_XCNT(b.x)], 1u);
    return b;
}
__device__ __forceinline__ void xcd_barrier_complete(unsigned* bar, unsigned x, unsigned& nloc, unsigned& nx) {
    const unsigned G = gridDim.x * gridDim.y * gridDim.z;
    unsigned sum, cnt, mine, sp = 0u;
    for (;;) {
        sum = 0u; cnt = 0u; mine = 0u;
#pragma unroll
        for (unsigned j = 0; j < 16; ++j) { const unsigned c = xb_ld(&bar[XB_XCNT(j)]); sum += c; cnt += (c > 0u) ? 1u : 0u; mine = (j == x) ? c : mine; }
        if (sum == G) break;
        __builtin_amdgcn_s_sleep(1);
        if ((++sp & 255u) == 0u) { if (xb_ld(&bar[XB_TMO])) break; if (sp > XB_SPIN_CAP) { atomicAdd(&bar[XB_TMO], 1u); break; } }
    }
    nloc = mine > 0u ? mine : 1u; nx = cnt > 0u ? cnt : 1u;
}

__device__ __forceinline__ void xcd_barrier(const XcdBarrier& b) {
    asm volatile("s_waitcnt vmcnt(0)" ::: "memory");
    __syncthreads();
    if (otid() == 0) {
        unsigned* bar = b.bar;
        __builtin_amdgcn_s_waitcnt(0);
        unsigned nloc = b.st[0], nx = b.st[1];
        if (nloc == 0u) { xcd_barrier_complete(bar, b.x, nloc, nx); b.st[0] = nloc; b.st[1] = nx; }
        const unsigned old = xb_add(&bar[XB_XSUB(b.x)], 1u);
        const unsigned gen = old / nloc;
        if (old + 1u == (gen + 1u) * nloc) {
            __builtin_amdgcn_fence(__ATOMIC_RELEASE, "agent");
            asm volatile("s_waitcnt vmcnt(0)" ::: "memory");
            const unsigned og = xb_add(&bar[XB_TOP], 1u);
            const unsigned tg = og / nx;
            if (og + 1u == (tg + 1u) * nx) xb_add(&bar[XB_TOPGEN], 1u);
            else XB_SPIN(xb_ld(&bar[XB_TOPGEN]) == tg, bar);
            __builtin_amdgcn_fence(__ATOMIC_ACQUIRE, "agent");
            xb_add(&bar[XB_XGEN(b.x)], 1u);
            asm volatile("s_waitcnt vmcnt(0)" ::: "memory");
        } else {
            XB_SPIN(xb_ld(&bar[XB_XGEN(b.x)]) == gen, bar);
            __builtin_amdgcn_fence(__ATOMIC_ACQUIRE, "agent");
            asm volatile("s_waitcnt vmcnt(0)" ::: "memory");
        }
    }
    __syncthreads();
}

__global__ void __launch_bounds__(NT, 2) mega_fwd(Args a) {
    extern __shared__ __attribute__((aligned(16))) unsigned char lds_raw[];
    LAS unsigned char* lds = (LAS unsigned char*)lds_raw;
    cg::grid_group grid = cg::this_grid();
    volatile LAS unsigned* st = (volatile LAS unsigned*)(lds + LDS_BYTES - 16);
    if (threadIdx.x < 4) st[threadIdx.x] = 0u;
    __syncthreads();
    { const XcdBarrier b0 = xcd_barrier_post((unsigned*)(a.ws + WS_BAR), st); if (threadIdx.x == 0) st[2] = b0.x; }
#define GRID_BAR() do { XcdBarrier b_; b_.bar = (unsigned*)(a.ws + WS_BAR); b_.st = (volatile LAS unsigned*)(lds + LDS_BYTES - 16); b_.x = otid() == 0 ? b_.st[2] : 0u; xcd_barrier(b_); } while (0)
    grid.sync();
#ifndef SK_P0
    phase0(a, lds);
#endif
    GRID_BAR();
#pragma unroll 1
    for (int l = 0; l < 4; ++l) {
#define Ua ((bf16*)(a.ws + ((l & 1) ? WS_U1 : WS_U0)))
#define Ub ((bf16*)(a.ws + ((l & 1) ? WS_U0 : WS_U1)))
#define rse ((float*)(a.ws + WS_RSE))
#define rso ((float*)(a.ws + WS_RSO))
        {
            pg8::Gemm g{Ua, (const bf16*)(a.ws + WS_WTIN), MT, NP, DM}; pg8::StaticOrder S; S.init(MT, NP, gridDim.x, oblk());
            EpiP E{(bf16*)(a.ws + WS_P), rse};
#ifndef SK_G1
            pg8::gemm_phase<EpiP, pg8::StaticOrder, true, true>(lds, g, S, E);
#ifdef DUP_G1
            GRID_BAR(); pg8::gemm_phase<EpiP, pg8::StaticOrder, true, true>(lds, g, S, E);
#endif
#endif
        }
        GRID_BAR();
#ifndef SK_PREP
#ifdef OLD_FIRST
        phase_prep_old(a, l, lds); GRID_BAR();
#endif
#ifdef ONLY_OLD
        phase_prep_old(a, l, lds);
#else
        phase_prep(a, l, lds);
#endif
#ifdef OLD_AFTER
        GRID_BAR(); phase_prep_old(a, l, lds);
#endif
#ifdef DUP_PREP
        GRID_BAR(); phase_prep(a, l, lds, false);
#endif
#endif
        GRID_BAR();
#ifndef SK_RWKV
        if (oblk() < 192) rwkv_scan_block(a, l, oblk(), lds);
#endif
#ifndef SK_HGRN
        if (oblk() >= 192 && oblk() < 240) hgrn_scan_block(a, l, oblk() - 192, lds);
#endif
#ifndef SK_LRU
        if (oblk() >= 240) lru_scan_block(a, l, oblk() - 240, lds);
#endif
#ifdef DUP_RWKV
        GRID_BAR(); if (oblk() < 192) rwkv_scan_block(a, l, oblk(), lds);
#endif
#ifdef DUP_HGRN
        GRID_BAR(); if (oblk() >= 192 && oblk() < 240) hgrn_scan_block(a, l, oblk() - 192, lds);
#endif
#ifdef DUP_LRU
        GRID_BAR(); if (oblk() >= 240) lru_scan_block(a, l, oblk() - 240, lds);
#endif
        GRID_BAR();
#ifndef SK_POST
        phase_post(a, l, lds);
#ifdef DUP_POST
        GRID_BAR(); phase_post(a, l, lds);
#endif
#endif
        GRID_BAR();
        {
            pg8::Gemm g{Ub, (const bf16*)(a.ws + WS_WTOUT), MT, DM, DM}; pg8::StaticOrder S; S.init(MT, DM, gridDim.x, oblk());
            EpiX E{a.out, (float*)(a.ws + WS_XS), Ua, a.in[I_N2G] + l * DM, rso};
#ifndef SK_GX
            pg8::gemm_phase<EpiX, pg8::StaticOrder, true, true, 64>(lds, g, S, E);
#endif
        }
        GRID_BAR();
        {
            pg8::Gemm g{Ua, (const bf16*)(a.ws + WS_WT1), MT, FF, DM}; pg8::StaticOrder S; S.init(MT, FF, gridDim.x, oblk());
            EpiH E{(bf16*)(a.ws + WS_H), rso};
#ifndef SK_G6
            pg8::gemm_phase<EpiH, pg8::StaticOrder, true, true, 64>(lds, g, S, E);
#ifdef DUP_G6
            GRID_BAR(); pg8::gemm_phase<EpiH, pg8::StaticOrder, true, true, 64>(lds, g, S, E);
#endif
#endif
        }
        GRID_BAR();
        {
            pg8::Gemm g{(const bf16*)(a.ws + WS_H), (const bf16*)(a.ws + WS_WT2), MP, DM, FF}; pg8::StaticOrder S; S.init(MP, DM, gridDim.x, oblk());
            EpiX E{a.out, (float*)(a.ws + WS_XS), Ub, l < 3 ? a.in[I_N1G] + (l + 1) * DM : a.in[I_FG], rse};
#ifndef SK_GX
            pg8::gemm_phase<EpiX, pg8::StaticOrder, true, true, 64>(lds, g, S, E);
#endif
            if (oblk() < 16) {
                const int ks = oblk() >> 2;
                pg8::Gemm g2{(const bf16*)(a.ws + WS_H) + (size_t)MP * FF + ks * 1024, (const bf16*)(a.ws + WS_WT2) + ks * 1024, 256, DM, 1024, FF};
                OneUnit S2{oblk() & 3}; EpiPart E2{(float*)(a.ws + WS_PART) + (size_t)ks * 128 * DM};
                pg8::gemm_phase<EpiPart, OneUnit, true, true, 0>(lds, g2, S2, E2);
            }
        }
        GRID_BAR();
        phase_sample_reduce(a, Ub, l < 3 ? a.in[I_N1G] + (l + 1) * DM : a.in[I_FG], rse);
        GRID_BAR();
    }
    phase_final(a);
}

extern "C" void kernel_launch(void* const* d_in, const int* in_sizes, int n_in, void* d_out, int out_size, void* d_ws, size_t ws_size, hipStream_t stream) {
    static int grid = 0;
    if (grid == 0) {
        int dev = 0, cus = 0;
        if (n_in != N_IN || ws_size < WS_END || out_size != 44761088) { fprintf(stderr, "kernel_launch: unexpected problem: n_in %d ws %zu (need %zu) out %d\n", n_in, ws_size, (size_t)WS_END, out_size); grid = -1; return; }
        if (hipGetDevice(&dev) != hipSuccess || hipDeviceGetAttribute(&cus, hipDeviceAttributeMultiprocessorCount, dev) != hipSuccess) { grid = -1; return; }
        if (hipFuncSetAttribute((const void*)mega_fwd, hipFuncAttributeMaxDynamicSharedMemorySize, LDS_BYTES) != hipSuccess) { fprintf(stderr, "kernel_launch: hipFuncSetAttribute failed\n"); grid = -1; return; }
        if (cus != 256) fprintf(stderr, "kernel_launch: %d CUs (built for 256)\n", cus);
        grid = 256;
    }
    if (grid < 0) return;
#ifdef DBG_POISON
    (void)hipMemsetAsync(d_ws, 0xAA, WS_END, stream); (void)hipMemsetAsync(d_out, 0xAA, (size_t)out_size * 4, stream);
#endif
    if (hipMemsetAsync((char*)d_ws + WS_BAR, 0, BAR_BYTES, stream) != hipSuccess) { fprintf(stderr, "kernel_launch: memset failed\n"); return; }
    Args a{};
    for (int i = 0; i < N_IN; ++i) a.in[i] = (const float*)d_in[i];
    a.out = (float*)d_out; a.ws = (unsigned char*)d_ws;
    void* args[] = {&a};
    hipError_t e = hipLaunchCooperativeKernel((const void*)mega_fwd, dim3(grid), dim3(NT), args, LDS_BYTES, stream);
    if (e != hipSuccess) fprintf(stderr, "kernel_launch: cooperative launch failed: %s\n", hipGetErrorString(e));
}
```

```cpp
#include <hip/hip_runtime.h>
#include <hip/hip_cooperative_groups.h>
#include <cstdio>
#include <cstdint>
namespace cg = cooperative_groups;
namespace pg8 {
#define PG8_LAS __attribute__((address_space(3)))
typedef unsigned short bf16_t;
typedef short bf16x8 __attribute__((ext_vector_type(8)));
typedef float f32x4 __attribute__((ext_vector_type(4)));
typedef unsigned u32x4 __attribute__((ext_vector_type(4)));
constexpr int BM = 256, BK = 64, HALF = 128, HTB = HALF * BK * 2  , STAGE_BYTES = 8 * HTB, NXCD = 8, WGM = 8;

__host__ __device__ __forceinline__ int lds_byte(int r, int c) { const int st = (r >> 4) * 2 + (c >> 5), rr = r & 15, cc = c & 31, ob = rr * 64 + cc * 2; return st * 1024 + (ob ^ (((ob >> 9) & 1) << 5)); }
__host__ __device__ __forceinline__ void stage_rc(int b, int& R, int& C) { const int st = b / 1024, sb = b % 1024, swz = sb ^ (((sb >> 9) & 1) << 5); R = (st >> 1) * 16 + swz / 64; C = (st & 1) * 32 + (swz % 64) / 2; }
__host__ __device__ __forceinline__ int perm32(int rho) { const int n = rho >> 4, i = rho & 15; return 8 * (i >> 2) + 4 * n + (i & 3); }

struct Unit { int pm, pn; };
struct Gemm { const bf16_t* A; const bf16_t* Bt; int M, N, K; int ld = 0; };

struct StaticOrder {
    int nM, nN, nwg, G, c;
    __host__ __device__ void init(int M, int N, int G_, int c_) { nM = M / BM; nN = N / BM; nwg = nM * nN; G = G_; c = c_; }
    __host__ __device__ bool next(int i, Unit& u) const {
        const long L = (long)i * G + c; if (L >= nwg) return false;
        int wgid = (int)L; { const int q = nwg / NXCD, r = nwg % NXCD, xcd = wgid % NXCD, off = wgid / NXCD; wgid = (xcd < r ? xcd * (q + 1) : r * (q + 1) + (xcd - r) * q) + off; }
        const int nig = WGM * nN, gid = wgid / nig, fm = gid * WGM, gsz = (nM - fm) < WGM ? (nM - fm) : WGM;
        u.pm = fm + ((wgid % nig) % gsz); u.pn = (wgid % nig) / gsz; return true;
    }
    __device__ __forceinline__ void a_ready(const Unit&) const {}
    __device__ __forceinline__ void done(const Unit&) const {}
};

__device__ __forceinline__ unsigned cvt_pk_bf16(float lo, float hi) { unsigned r; asm volatile("v_cvt_pk_bf16_f32 %0, %1, %2" : "=v"(r) : "v"(lo), "v"(hi)); return r; }
typedef float f32x2 __attribute__((ext_vector_type(2)));
template <class Epi, class Sched, bool ALIGN_EPI = false, bool SP2 = false, int HALF_PM = -1>
__device__ __forceinline__ void gemm_phase(PG8_LAS unsigned char* lds, const Gemm g, const Sched& S, const Epi& E) {
    int tid_ = threadIdx.x; asm volatile("" : "+v"(tid_)); const int tid = tid_, wid = __builtin_amdgcn_readfirstlane(tid >> 6), lane = tid & 63, wr = wid >> 2, wc = wid & 3, fr = lane & 15, fq = lane >> 4;
    const int K = g.K, nt = K / BK, LD = g.ld ? g.ld : g.K;
    unsigned voffA[2], voffB[2];
#pragma unroll
    for (int i = 0; i < 2; ++i) { int R, C; stage_rc(tid * 16 + i * 8192, R, C); const int Rb = Epi::PERM ? ((R & ~31) + perm32(R & 31)) : R;
        voffA[i] = (unsigned)(R * LD + C) * 2u; voffB[i] = (unsigned)(Rb * LD + C) * 2u; }
    const size_t kstep = (size_t)(BK * 2);
    const size_t hstep = (size_t)HALF * LD * 2;
    const size_t tstep = 2 * hstep;
    const unsigned ldsw = (unsigned)wid * 1024u;
    const int aoff = lds_byte(wr * 64 + fr, fq * 8), boff = lds_byte(wc * 32 + fr, fq * 8);
#define PG8_SA(b, h) (((b) * 2 + (h)) * HTB)
#define PG8_SB(b, h) ((4 + (b) * 2 + (h)) * HTB)
#define PG8_STAGE(bufoff, gbase, voff) do { _Pragma("unroll") for (int _i = 0; _i < 2; ++_i) \
        __builtin_amdgcn_global_load_lds((const unsigned*)((const char*)(gbase) + (voff)[_i]), (PG8_LAS unsigned*)(lds + (bufoff) + ldsw + _i * 8192), 16, 0, 0); } while (0)
#define PG8_LDA(dst, b, h) do { _Pragma("unroll") for (int m = 0; m < 4; ++m) _Pragma("unroll") for (int k = 0; k < 2; ++k) dst[m][k] = *(const PG8_LAS bf16x8*)(lds + PG8_SA(b, h) + aoff + m * 2048 + k * 1024); } while (0)
#define PG8_LDB(dst, b, h) do { _Pragma("unroll") for (int n = 0; n < 2; ++n) _Pragma("unroll") for (int k = 0; k < 2; ++k) dst[n][k] = *(const PG8_LAS bf16x8*)(lds + PG8_SB(b, h) + boff + n * 2048 + k * 1024); } while (0)
#define PG8_MMA(ai, bj, At, Bt) do { __builtin_amdgcn_s_setprio(1); _Pragma("unroll") for (int m = 0; m < 4; ++m) _Pragma("unroll") for (int n = 0; n < 2; ++n) _Pragma("unroll") for (int k = 0; k < 2; ++k) \
        acc[ai][bj][m][n] = __builtin_amdgcn_mfma_f32_16x16x32_bf16(Bt[n][k], At[m][k], acc[ai][bj][m][n], 0, 0, 0); __builtin_amdgcn_s_setprio(0); } while (0)
#define PG8_WAIT_V(n) asm volatile("s_waitcnt vmcnt(" #n ")" ::: "memory")
#define PG8_WAIT_L(n) asm volatile("s_waitcnt lgkmcnt(" #n ")" ::: "memory")
#define PG8_BAR __builtin_amdgcn_s_barrier()
#define PG8_SCHED __builtin_amdgcn_sched_barrier(0)
    Unit cur, nxt; int ui = 0;
    if (!S.next(0, cur)) return;
    f32x4 acc[2][2][4][2];
#pragma unroll
    for (int a = 0; a < 2; ++a)
#pragma unroll
        for (int b = 0; b < 2; ++b)
#pragma unroll
            for (int m = 0; m < 4; ++m)
#pragma unroll
                for (int n = 0; n < 2; ++n) acc[a][b][m][n] = (f32x4){0.f, 0.f, 0.f, 0.f};
    bf16x8 At[4][2], B0[2][2], B1[2][2];
    const char* cA = (const char*)g.A + (size_t)cur.pm * tstep; const char* cB = (const char*)g.Bt + (size_t)cur.pn * tstep;
    S.a_ready(cur);
    if constexpr (SP2) {
        PG8_STAGE(PG8_SB(0, 0), cB, voffB); PG8_STAGE(PG8_SB(0, 1), cB + hstep, voffB); PG8_STAGE(PG8_SA(0, 0), cA, voffA); PG8_STAGE(PG8_SA(0, 1), cA + hstep, voffA);
        if (wr == 1) PG8_BAR;
        PG8_WAIT_V(2); PG8_BAR;
        PG8_STAGE(PG8_SB(1, 0), cB + kstep, voffB); PG8_STAGE(PG8_SA(1, 0), cA + kstep, voffA); PG8_STAGE(PG8_SB(1, 1), cB + hstep + kstep, voffB);
        PG8_WAIT_V(6); PG8_BAR;
    } else {
        PG8_STAGE(PG8_SB(0, 0), cB, voffB); PG8_STAGE(PG8_SA(0, 0), cA, voffA); PG8_STAGE(PG8_SB(0, 1), cB + hstep, voffB); PG8_STAGE(PG8_SA(0, 1), cA + hstep, voffA);
        if (wr == 1) PG8_BAR;
        PG8_WAIT_V(4); PG8_BAR;
        PG8_STAGE(PG8_SB(1, 0), cB + kstep, voffB); PG8_STAGE(PG8_SA(1, 0), cA + kstep, voffA); PG8_STAGE(PG8_SB(1, 1), cB + hstep + kstep, voffB);
        PG8_WAIT_V(6); PG8_BAR;
    }
    for (;;) {
        const bool has_next = S.next(ui + 1, nxt);
        const char* nA = has_next ? (const char*)g.A + (size_t)nxt.pm * tstep : cA; const char* nB = has_next ? (const char*)g.Bt + (size_t)nxt.pn * tstep : cB;
        for (int t = 0; t < nt; t += 2) {
            const bool last = (t == nt - 2);
            const char* a1 = cA + (size_t)(t + 1) * kstep;
            const char* a2 = last ? nA : cA + (size_t)(t + 2) * kstep; const char* b2 = last ? nB : cB + (size_t)(t + 2) * kstep;
            const char* a3 = a2 + kstep; const char* b3 = b2 + kstep;
            if (last && has_next) S.a_ready(nxt);
            if constexpr (SP2) {
            PG8_LDB(B0, 0, 0); PG8_LDB(B1, 0, 1); PG8_SCHED; PG8_LDA(At, 0, 0); PG8_STAGE(PG8_SA(1, 1), a1 + hstep, voffA);
            PG8_WAIT_V(8); PG8_WAIT_L(0); PG8_BAR; PG8_MMA(0, 0, At, B0); PG8_MMA(0, 1, At, B1); PG8_BAR; PG8_SCHED;
            PG8_LDA(At, 0, 1); PG8_STAGE(PG8_SB(0, 0), b2, voffB); PG8_STAGE(PG8_SB(0, 1), b2 + hstep, voffB); PG8_STAGE(PG8_SA(0, 0), a2, voffA);
            PG8_WAIT_V(8); PG8_WAIT_L(0); PG8_BAR; if (cur.pm != HALF_PM) { PG8_MMA(1, 0, At, B0); PG8_MMA(1, 1, At, B1); } PG8_BAR; PG8_SCHED;
            PG8_LDB(B0, 1, 0); PG8_LDB(B1, 1, 1); PG8_SCHED; PG8_LDA(At, 1, 0); PG8_STAGE(PG8_SA(0, 1), a2 + hstep, voffA);
            PG8_WAIT_V(8); PG8_WAIT_L(0); PG8_BAR; PG8_MMA(0, 0, At, B0); PG8_MMA(0, 1, At, B1); PG8_BAR; PG8_SCHED;
            PG8_LDA(At, 1, 1); PG8_STAGE(PG8_SB(1, 0), b3, voffB); PG8_STAGE(PG8_SB(1, 1), b3 + hstep, voffB); PG8_STAGE(PG8_SA(1, 0), a3, voffA);
            PG8_WAIT_V(8); PG8_WAIT_L(0); PG8_BAR; if (cur.pm != HALF_PM) { PG8_MMA(1, 0, At, B0); PG8_MMA(1, 1, At, B1); } PG8_BAR; PG8_SCHED;
            } else {
            PG8_LDB(B0, 0, 0); PG8_SCHED; PG8_LDA(At, 0, 0); PG8_STAGE(PG8_SA(1, 1), a1 + hstep, voffA);
            PG8_WAIT_L(8); PG8_BAR; PG8_WAIT_L(0); PG8_MMA(0, 0, At, B0); PG8_BAR; PG8_SCHED;
            PG8_LDB(B1, 0, 1); PG8_STAGE(PG8_SB(0, 0), b2, voffB);
            PG8_BAR; PG8_WAIT_L(0); PG8_MMA(0, 1, At, B1); PG8_BAR;
            PG8_LDA(At, 0, 1); PG8_STAGE(PG8_SA(0, 0), a2, voffA);
            PG8_BAR; PG8_WAIT_L(0); PG8_MMA(1, 0, At, B0); PG8_BAR; PG8_SCHED;
            PG8_STAGE(PG8_SB(0, 1), b2 + hstep, voffB);
            PG8_WAIT_V(6); PG8_BAR; PG8_MMA(1, 1, At, B1); PG8_BAR;
            PG8_LDB(B0, 1, 0); PG8_SCHED; PG8_LDA(At, 1, 0); PG8_STAGE(PG8_SA(0, 1), a2 + hstep, voffA);
            PG8_WAIT_L(8); PG8_BAR; PG8_WAIT_L(0); PG8_MMA(0, 0, At, B0); PG8_BAR; PG8_SCHED;
            PG8_LDB(B1, 1, 1); PG8_STAGE(PG8_SB(1, 0), b3, voffB);
            PG8_BAR; PG8_WAIT_L(0); PG8_MMA(0, 1, At, B1); PG8_BAR;
            PG8_LDA(At, 1, 1); PG8_STAGE(PG8_SA(1, 0), a3, voffA);
            PG8_BAR; PG8_WAIT_L(0); PG8_MMA(1, 0, At, B0); PG8_BAR; PG8_SCHED;
            PG8_STAGE(PG8_SB(1, 1), b3 + hstep, voffB);
            PG8_WAIT_V(6); PG8_BAR; PG8_MMA(1, 1, At, B1); PG8_BAR;
            }
        }
        if constexpr (ALIGN_EPI) { if (wr == 0) PG8_BAR; }
        if constexpr (!Epi::AFTER_DRAIN) { E(acc, cur, wr, wc, fr, fq); S.done(cur); }
        if (!has_next) break;
#pragma unroll
        for (int a = 0; a < 2; ++a)
#pragma unroll
            for (int b = 0; b < 2; ++b)
#pragma unroll
                for (int m = 0; m < 4; ++m)
#pragma unroll
                    for (int n = 0; n < 2; ++n) acc[a][b][m][n] = (f32x4){0.f, 0.f, 0.f, 0.f};
        cur = nxt; cA = nA; cB = nB; ++ui;
        if constexpr (ALIGN_EPI) { if (wr == 1) PG8_BAR; }
    }
    PG8_WAIT_V(0);
    if constexpr (!ALIGN_EPI) { if (wr == 0) PG8_BAR; }
    PG8_BAR;
    if constexpr (Epi::AFTER_DRAIN) { E.fused(acc, cur, wr, wc, fr, fq, lds, wid, lane); S.done(cur); }
#undef PG8_SA
#undef PG8_SB
#undef PG8_STAGE
#undef PG8_LDA
#undef PG8_LDB
#undef PG8_MMA
#undef PG8_WAIT_V
#undef PG8_WAIT_L
#undef PG8_BAR
#undef PG8_SCHED
}
}
#define DEV __device__ __forceinline__
#define LAS __attribute__((address_space(3)))
typedef unsigned short bf16;
typedef float f32x4 __attribute__((ext_vector_type(4)));
typedef unsigned u32x4 __attribute__((ext_vector_type(4)));
typedef unsigned u32x2 __attribute__((ext_vector_type(2)));
typedef short bf16x8 __attribute__((ext_vector_type(8)));

constexpr int NT = 512, NWV = 8;
constexpr int DM = 1024, NP = 3584, FF = 4096;
constexpr int MP = 16384, MREAL = 16512, MT = 16640, TT = 2048;
constexpr int REC = 1152;
constexpr float EPS = 1e-6f;
constexpr size_t MiB = 1u << 20;
constexpr size_t WS_RSS = 0;
constexpr size_t WS_LBT = 640 * 1024, WS_BAR = 704 * 1024, BAR_BYTES = 16384;
constexpr size_t WS_WTIN = 1 * MiB, WS_WTOUT = 8 * MiB, WS_WT1 = 10 * MiB, WS_WT2 = 18 * MiB, WS_WLORA = 26 * MiB;
constexpr size_t WS_XS = 27 * MiB, WS_U0 = 28 * MiB, WS_U1 = 61 * MiB, WS_P = 94 * MiB, WS_SCAN = 208 * MiB, WS_SCANS = 316 * MiB;
constexpr size_t WS_H = 94 * MiB;
constexpr size_t WS_OUTR = 317 * MiB, WS_G = 329 * MiB, WS_LA = 342 * MiB, WS_LU = 351 * MiB, WS_RSE = 360 * MiB, WS_RSO = 360 * MiB + 1280 * 1024, WS_END = 360 * MiB + 2560 * 1024;
DEV float row_scale(const float* rs, int row) { const f32x4* p = (const f32x4*)(rs + (size_t)row * 16); const f32x4 a = p[0], b = p[1], c = p[2], d = p[3];
    const float t = ((a[0] + a[1]) + (a[2] + a[3])) + ((b[0] + b[1]) + (b[2] + b[3])) + (((c[0] + c[1]) + (c[2] + c[3])) + ((d[0] + d[1]) + (d[2] + d[3])));
    return rsqrtf(t * (1.f / 1024.f) + 1e-6f); }
static_assert(WS_P + (size_t)MT * NP * 2 <= WS_SCAN && WS_SCAN + (size_t)MP * 6 * REC <= WS_SCANS && WS_H + (size_t)MT * FF * 2 <= WS_SCANS, "ws map");
static_assert(WS_U0 + (size_t)MT * DM * 2 <= WS_U1 && WS_U1 + (size_t)MT * DM * 2 <= WS_P, "ws map 2");
constexpr int WL_STRIDE = 131072, WL_AUP = 24576, WL_GUP = 49152, WL_WA = 98304, WL_WX = 114688;
constexpr size_t O_YP = 0, O_YS = 16777216, O_PWKV = 16908288, O_PSHIFT = 17694720, O_PHGRN = 17727488, O_PLRU = 18513920, O_PCONV = 18522112,
                 O_SWKV = 18546688, O_SSHIFT = 31129600, O_SHGRN = 31653888, O_SLRU = 44236800, O_SCONV = 44367872;
constexpr int LDS_BYTES = 147456;
enum { I_XP = 0, I_XS, I_SWKV, I_SSHIFT, I_SHGRN, I_SLRU, I_SCONV, I_N1G, I_WIN, I_MU, I_W0, I_WUP, I_A0, I_AUP, I_GUP, I_KK, I_KA, I_RK, I_LNW, I_LNB,
       I_HLB, I_HNG, I_CW, I_CB, I_WA, I_BA, I_WX, I_BX, I_LAM, I_WOUT, I_N2G, I_W1, I_W2, I_FG, N_IN };
struct Args { const float* in[N_IN]; float* out; unsigned char* ws; };

DEV int otid() { int t = threadIdx.x; asm volatile("" : "+v"(t)); return t; }
DEV int oblk() { int b = blockIdx.x; asm volatile("" : "+s"(b)); return b; }
DEV float bflo(unsigned u) { return __uint_as_float(u << 16); }
DEV float bfhi(unsigned u) { return __uint_as_float(u & 0xffff0000u); }
DEV float bf2f(unsigned short h) { return __uint_as_float((unsigned)h << 16); }
typedef __bf16 bf16x2_t __attribute__((ext_vector_type(2)));
typedef float f32x2_t __attribute__((ext_vector_type(2)));
DEV unsigned pk2(float lo, float hi) { const f32x2_t v = {lo, hi}; const bf16x2_t b = __builtin_convertvector(v, bf16x2_t); return __builtin_bit_cast(unsigned, b); }
DEV unsigned short f2bf(float f) { return (unsigned short)(pk2(f, 0.f) & 0xffffu); }
DEV float sigm(float x) { return 1.f / (1.f + __expf(-x)); }
template <int CTRL> DEV float dppf(float x) { return __builtin_bit_cast(float, __builtin_amdgcn_update_dpp(0, __builtin_bit_cast(int, x), CTRL, 0xF, 0xF, true)); }
DEV float red16(float x) { x += dppf<0xB1>(x); x += dppf<0x4E>(x); x += dppf<0x141>(x); x += dppf<0x140>(x); return x; }
DEV float rl(float x, int l) { return __builtin_bit_cast(float, __builtin_amdgcn_readlane(__builtin_bit_cast(int, x), l)); }
#ifdef WS_SHFL
DEV float wave_sum(float v) {
#pragma unroll
    for (int o = 1; o < 64; o <<= 1) v += __shfl_xor(v, o);
    return v;
}
#else
DEV float wave_sum(float v) { v = red16(v); return (rl(v, 0) + rl(v, 16)) + (rl(v, 32) + rl(v, 48)); }
#endif
DEV void unpack8(u32x4 u, float* f) { f[0] = bflo(u.x); f[1] = bfhi(u.x); f[2] = bflo(u.y); f[3] = bfhi(u.y); f[4] = bflo(u.z); f[5] = bfhi(u.z); f[6] = bflo(u.w); f[7] = bfhi(u.w); }
DEV float gelu_t(float x) { return 0.5f * x * (1.f + tanhf(0.7978845608f * (x + 0.044715f * x * x * x))); }

struct EpiP {
    static constexpr bool PERM = true, AFTER_DRAIN = false;
    bf16* O; const float* rss;
    DEV void operator()(const pg8::f32x4 (&acc)[2][2][4][2], const pg8::Unit& u, int wr, int wc, int fr, int fq) const {
        const int row0 = u.pm * 256 + wr * 64 + fr, col0 = u.pn * 256 + wc * 32 + 8 * fq;
#pragma unroll
        for (int ai = 0; ai < 2; ++ai)
#pragma unroll
            for (int m = 0; m < 4; ++m) {
                const int row = row0 + ai * 128 + m * 16;
                const float s = row < MREAL ? row_scale(rss, row) : 1.f;
                bf16* rowp = O + (size_t)row * NP + col0;
#pragma unroll
                for (int bj = 0; bj < 2; ++bj) { const pg8::f32x4 v0 = acc[ai][bj][m][0] * s, v1 = acc[ai][bj][m][1] * s;
                    u32x4 w; w.x = pk2(v0[0], v0[1]); w.y = pk2(v0[2], v0[3]); w.z = pk2(v1[0], v1[1]); w.w = pk2(v1[2], v1[3]);
                    *(u32x4*)(rowp + bj * 128) = w; }
            }
    }
};
struct EpiH {
    static constexpr bool PERM = true, AFTER_DRAIN = false;
    bf16* O; const float* rss;
    DEV void operator()(const pg8::f32x4 (&acc)[2][2][4][2], const pg8::Unit& u, int wr, int wc, int fr, int fq) const {
        const int row0 = u.pm * 256 + wr * 64 + fr, col0 = u.pn * 256 + wc * 32 + 8 * fq;
#pragma unroll
        for (int ai = 0; ai < 2; ++ai)
#pragma unroll
            for (int m = 0; m < 4; ++m) {
                const int row = row0 + ai * 128 + m * 16;
                const float s = row < MREAL ? row_scale(rss, row) : 1.f;
                bf16* rowp = O + (size_t)row * FF + col0;
#pragma unroll
                for (int bj = 0; bj < 2; ++bj) { pg8::f32x4 v0 = acc[ai][bj][m][0] * s, v1 = acc[ai][bj][m][1] * s;
#pragma unroll
                    for (int e = 0; e < 4; ++e) { const float a0 = fmaxf(v0[e], 0.f), a1 = fmaxf(v1[e], 0.f); v0[e] = a0 * a0; v1[e] = a1 * a1; }
                    u32x4 w; w.x = pk2(v0[0], v0[1]); w.y = pk2(v0[2], v0[3]); w.z = pk2(v1[0], v1[1]); w.w = pk2(v1[2], v1[3]);
                    *(u32x4*)(rowp + bj * 128) = w; }
            }
    }
};
struct EpiX {
    static constexpr bool PERM = false, AFTER_DRAIN = false;
    float* xp; float* xs; bf16* U; const float* g; float* rss;
    DEV void operator()(const pg8::f32x4 (&acc)[2][2][4][2], const pg8::Unit& u, int wr, int wc, int fr, int fq) const {
        const int row0 = u.pm * 256 + wr * 64 + fr, col0 = u.pn * 256 + wc * 32 + 4 * fq;
#pragma unroll
        for (int ai = 0; ai < 2; ++ai) {
            if (u.pm * 256 + ai * 128 >= MREAL) continue;
#pragma unroll
            for (int m = 0; m < 4; ++m) {
                const int row = row0 + ai * 128 + m * 16;
                float* xr = (row < MP ? xp + (size_t)row * DM : xs + (size_t)(row - MP) * DM) + col0;
                bf16* ur = U + (size_t)row * DM + col0;
                float ss = 0.f;
#pragma unroll
                for (int bj = 0; bj < 2; ++bj)
#pragma unroll
                    for (int n = 0; n < 2; ++n) { const int co = bj * 128 + n * 16;
                        f32x4 x = *(const f32x4*)(xr + co); const pg8::f32x4 a = acc[ai][bj][m][n];
                        x[0] += a[0]; x[1] += a[1]; x[2] += a[2]; x[3] += a[3];
                        *(f32x4*)(xr + co) = x; ss += (x[0] * x[0] + x[1] * x[1]) + (x[2] * x[2] + x[3] * x[3]);
                        const f32x4 gv = *(const f32x4*)(g + col0 + co);
                        u32x2 w; w.x = pk2(x[0] * gv[0], x[1] * gv[1]); w.y = pk2(x[2] * gv[2], x[3] * gv[3]);
                        *(u32x2*)(ur + co) = w; }
                ss += __shfl_xor(ss, 16); ss += __shfl_xor(ss, 32);
                if (fq == 0) rss[(size_t)row * 16 + u.pn * 4 + wc] = ss;
            }
        }
    }
};

DEV void transpose_item(const float* W, int K, int N, bf16* WT, int row_off, LAS float* scr, int item, int lane) {
    const int nblk = N / 32, kb = item / nblk, nb = item % nblk, k0 = 64 * kb, n0 = 32 * nb;
#pragma unroll 8
    for (int i = 0; i < 32; ++i) { const int kk = 2 * i + (lane >> 5); scr[kk * 33 + (lane & 31)] = W[(size_t)(k0 + kk) * N + n0 + (lane & 31)]; }
    asm volatile("s_waitcnt lgkmcnt(0)" ::: "memory");
    const int c = lane & 7;
#pragma unroll
    for (int j = 0; j < 4; ++j) { const int n = (lane >> 3) + 8 * j; const LAS float* s = scr + (8 * c) * 33 + n;
        u32x4 o; o.x = pk2(s[0 * 33], s[1 * 33]); o.y = pk2(s[2 * 33], s[3 * 33]); o.z = pk2(s[4 * 33], s[5 * 33]); o.w = pk2(s[6 * 33], s[7 * 33]);
        *(u32x4*)(WT + (size_t)(row_off + n0 + n) * K + k0 + 8 * c) = o; }
    asm volatile("s_waitcnt lgkmcnt(0)" ::: "memory");
}
DEV void transpose_job(const float* W, int K, int N, bf16* WT, int& it, int NGW, LAS float* scr, int lane) {
    const int n_items = (K / 64) * (N / 32);
    while (it < n_items) { transpose_item(W, K, N, WT, 0, scr, it, lane); it += NGW; }
    it -= n_items;
}

DEV void phase0(const Args& a, LAS unsigned char* lds) {
    const int tid = otid(), lane = tid & 63, wave = tid >> 6;
    const int gw = blockIdx.x * NWV + wave, NGW = gridDim.x * NWV, gt = blockIdx.x * NT + tid, NGT = gridDim.x * NT;
    unsigned char* ws = a.ws;
    float* rss = (float*)(ws + WS_RSE);
    {
        u32x4* z = (u32x4*)(ws + WS_WTIN + (size_t)3456 * DM * 2);
        for (int i = gt; i < 128 * DM * 2 / 16; i += NGT) z[i] = (u32x4){0u, 0u, 0u, 0u};
    }
    if (gt < 384) {
        const float* hl = a.in[I_HLB]; float e[4], mx = -1e30f, sm = 0.f;
        _Pragma("unroll") for (int d = 0; d < 4; ++d) { e[d] = hl[d * 384 + gt]; mx = fmaxf(mx, e[d]); }
        _Pragma("unroll") for (int d = 0; d < 4; ++d) { e[d] = __expf(e[d] - mx); sm += e[d]; }
        float* lbt = (float*)(ws + WS_LBT); float acc = 0.f; lbt[gt] = 0.f;
        _Pragma("unroll") for (int d = 1; d < 4; ++d) { acc += e[d] / sm; lbt[d * 384 + gt] = acc; }
    }
    bf16* U0 = (bf16*)(ws + WS_U0); bf16* U1 = (bf16*)(ws + WS_U1); float* xs = (float*)(ws + WS_XS);
    const f32x4* g4 = (const f32x4*)a.in[I_N1G];
    for (int row = gw; row < MREAL; row += NGW) {
        const f32x4* src = (const f32x4*)(row < MP ? a.in[I_XP] + (size_t)row * DM : a.in[I_XS] + (size_t)(row - MP) * DM);
        f32x4* dst = (f32x4*)(row < MP ? a.out + (size_t)row * DM : xs + (size_t)(row - MP) * DM);
        u32x2* ud = (u32x2*)(U0 + (size_t)row * DM);
        float ss = 0.f;
#pragma unroll
        for (int j = 0; j < 4; ++j) { const f32x4 v = src[lane + 64 * j], g = g4[lane + 64 * j]; dst[lane + 64 * j] = v;
            ss += (v[0] * v[0] + v[1] * v[1]) + (v[2] * v[2] + v[3] * v[3]);
            u32x2 w; w.x = pk2(v[0] * g[0], v[1] * g[1]); w.y = pk2(v[2] * g[2], v[3] * g[3]); ud[lane + 64 * j] = w; }
        ss = wave_sum(ss); if (lane < 16) rss[(size_t)row * 16 + lane] = lane == 0 ? ss : 0.f;
    }
    for (int r = gw; r < 256; r += NGW) { const int lay = r >> 7, i = r & 127;
        const f32x4* src = (const f32x4*)(a.in[I_SSHIFT] + (size_t)(lay * 128 + i) * DM);
        u32x2* ud = (u32x2*)((lay ? U1 : U0) + (size_t)(MREAL + i) * DM);
#pragma unroll
        for (int j = 0; j < 4; ++j) { const f32x4 v = src[lane + 64 * j]; u32x2 w; w.x = pk2(v[0], v[1]); w.y = pk2(v[2], v[3]); ud[lane + 64 * j] = w; }
    }
    LAS float* scr = (LAS float*)(lds + wave * 8448);
    int it = gw;
    transpose_job(a.in[I_WIN], DM, 3456, (bf16*)(ws + WS_WTIN), it, NGW, scr, lane);
    for (int l = 0; l < 4; ++l) {
        bf16* WL = (bf16*)(ws + WS_WLORA) + (size_t)l * WL_STRIDE;
        transpose_job(a.in[I_WUP] + (size_t)l * 64 * 384, 64, 384, WL, it, NGW, scr, lane);
        transpose_job(a.in[I_AUP] + (size_t)l * 64 * 384, 64, 384, WL + WL_AUP, it, NGW, scr, lane);
        transpose_job(a.in[I_GUP] + (size_t)l * 128 * 384, 128, 384, WL + WL_GUP, it, NGW, scr, lane);
        for (int n = 0; n < 4; ++n) {
            transpose_job(a.in[I_WA] + (size_t)(l * 4 + n) * 4096, 64, 64, WL + WL_WA + n * 4096, it, NGW, scr, lane);
            transpose_job(a.in[I_WX] + (size_t)(l * 4 + n) * 4096, 64, 64, WL + WL_WX + n * 4096, it, NGW, scr, lane);
        }
    }
}

constexpr int PL_PRM = 0, PL_AL = 14336, PL_XC = 31232, PL_LW = 48128, PL_LA = 73216, PL_GR = 98304, PL_GI = 115200;
template <int C> DEV float dpp_sum8(float x) { x += __shfl_xor(x, 1); x += __shfl_xor(x, 2); x += __shfl_xor(x, 4); return x; }
DEV void prep_tile(const Args& a, int l, int tt, LAS unsigned char* lds, bool do_gelu = true, int mi_lo = 0, int mi_hi = 2) {
    const int tid = otid(), lane = tid & 63, wave = __builtin_amdgcn_readfirstlane(tid >> 6);
    unsigned char* ws = a.ws;
    LAS float* PRM = (LAS float*)(lds + PL_PRM);
    LAS bf16* AL = (LAS bf16*)(lds + PL_AL);
    LAS bf16* XC = (LAS bf16*)(lds + PL_XC);
    LAS bf16* LW = (LAS bf16*)(lds + PL_LW);
    LAS bf16* LAo = (LAS bf16*)(lds + PL_LA);
    LAS bf16* GR = (LAS bf16*)(lds + PL_GR);
    LAS bf16* GI = (LAS bf16*)(lds + PL_GI);
    bf16* P = (bf16*)(ws + WS_P);
    const bool samp = tt >= 512;
    const int row0 = tt * 32;
    const float* mu = a.in[I_MU] + l * 1408;
#ifndef SK_PREP_A
#pragma unroll 1
    for (int itx = mi_lo; itx < mi_hi; ++itx) {
        const int idx = itx * NT + tid, r = idx >> 5, col = (idx & 31) * 8, row = row0 + r, t = row & (TT - 1);
        float p[8], pp[8], x[8];
        {
            unpack8(*(const u32x4*)(P + (size_t)row * NP + 1152 + col), p);
            const bool valid = samp || t > 0; const int prow = samp ? row + 128 : row - 1;
            if (valid) unpack8(*(const u32x4*)(P + (size_t)prow * NP + 1152 + col), pp);
            else { _Pragma("unroll") for (int e = 0; e < 8; ++e) pp[e] = 0.f; }
            const f32x4 m0 = *(const f32x4*)(mu + 1152 + col), m1 = *(const f32x4*)(mu + 1152 + col + 4);
#pragma unroll
            for (int e = 0; e < 8; ++e) { const float m = e < 4 ? m0[e] : m1[e - 4]; x[e] = p[e] + m * (pp[e] - p[e]); }
            if (col < 64) { _Pragma("unroll") for (int e = 0; e < 8; ++e) x[e] = tanhf(x[e]); }
            else if (col >= 128) { _Pragma("unroll") for (int e = 0; e < 8; ++e) x[e] = sigm(x[e]); }
            u32x4 w; w.x = pk2(x[0], x[1]); w.y = pk2(x[2], x[3]); w.z = pk2(x[4], x[5]); w.w = pk2(x[6], x[7]);
            *(LAS u32x4*)(AL + r * 264 + col) = w;
        }
        {
            float xr[4][8];
            unpack8(*(const u32x4*)(P + (size_t)row * NP + 2944 + col), xr[0]);
            if (!samp) {
#pragma unroll
                for (int j = 1; j < 4; ++j) { if (t - j >= 0) unpack8(*(const u32x4*)(P + (size_t)(row - j) * NP + 2944 + col), xr[j]); else { _Pragma("unroll") for (int e = 0; e < 8; ++e) xr[j][e] = 0.f; } }
                if (t >= TT - 3) { float* pc = a.out + O_PCONV + ((size_t)((l * 8 + (row >> 11)) * 3 + (t - (TT - 3)))) * 256 + col;
                    *(f32x4*)pc = (f32x4){xr[0][0], xr[0][1], xr[0][2], xr[0][3]}; *(f32x4*)(pc + 4) = (f32x4){xr[0][4], xr[0][5], xr[0][6], xr[0][7]}; }
            } else {
                const int i = row - MP; const float* c0 = a.in[I_SCONV] + (size_t)((l * 128 + i) * 3) * 256 + col;
#pragma unroll
                for (int j = 1; j < 4; ++j) { const f32x4 q0 = *(const f32x4*)(c0 + (3 - j) * 256), q1 = *(const f32x4*)(c0 + (3 - j) * 256 + 4);
                    xr[j][0] = q0[0]; xr[j][1] = q0[1]; xr[j][2] = q0[2]; xr[j][3] = q0[3]; xr[j][4] = q1[0]; xr[j][5] = q1[1]; xr[j][6] = q1[2]; xr[j][7] = q1[3]; }
                float* sc = a.out + O_SCONV + (size_t)((l * 128 + i) * 3) * 256 + col;
                *(f32x4*)(sc) = (f32x4){xr[2][0], xr[2][1], xr[2][2], xr[2][3]}; *(f32x4*)(sc + 4) = (f32x4){xr[2][4], xr[2][5], xr[2][6], xr[2][7]};
                *(f32x4*)(sc + 256) = (f32x4){xr[1][0], xr[1][1], xr[1][2], xr[1][3]}; *(f32x4*)(sc + 260) = (f32x4){xr[1][4], xr[1][5], xr[1][6], xr[1][7]};
                *(f32x4*)(sc + 512) = (f32x4){xr[0][0], xr[0][1], xr[0][2], xr[0][3]}; *(f32x4*)(sc + 516) = (f32x4){xr[0][4], xr[0][5], xr[0][6], xr[0][7]};
            }
            const float* cw = a.in[I_CW] + (size_t)l * 4 * 256 + col; const float* cb = a.in[I_CB] + l * 256 + col;
            float xc[8];
#pragma unroll
            for (int e = 0; e < 8; ++e) xc[e] = cb[e] + cw[e] * xr[3][e] + cw[256 + e] * xr[2][e] + cw[512 + e] * xr[1][e] + cw[768 + e] * xr[0][e];
            u32x4 w; w.x = pk2(xc[0], xc[1]); w.y = pk2(xc[2], xc[3]); w.z = pk2(xc[4], xc[5]); w.w = pk2(xc[6], xc[7]);
            *(LAS u32x4*)(XC + r * 264 + col) = w;
        }
    }
#endif
    __syncthreads();
    const int fr = lane & 15, fq = lane >> 4;
    const bf16* WL = (const bf16*)(ws + WS_WLORA) + (size_t)l * WL_STRIDE;
#ifndef SK_PREP_R
    if (wave < 6) {
        const int h = wave;
        bf16* G = (bf16*)(ws + WS_G);
#ifndef NP_NO_WA
#pragma unroll
        for (int which = 0; which < 2; ++which) {
            const bf16* Wm = WL + (which ? WL_AUP : 0); LAS bf16* Lo = which ? LAo : LW;
            bf16x8 Wf[4][2];
#pragma unroll
            for (int ni = 0; ni < 4; ++ni)
#pragma unroll
                for (int ks = 0; ks < 2; ++ks) Wf[ni][ks] = *(const bf16x8*)(Wm + (h * 64 + ni * 16 + fr) * 64 + ks * 32 + fq * 8);
#pragma unroll 1
            for (int mi = mi_lo; mi < mi_hi; ++mi) {
                f32x4 acc[4];
#pragma unroll
                for (int ni = 0; ni < 4; ++ni) acc[ni] = (f32x4){0.f, 0.f, 0.f, 0.f};
#pragma unroll
                for (int ks = 0; ks < 2; ++ks) { const bf16x8 Af = *(const LAS bf16x8*)(AL + (mi * 16 + fr) * 264 + which * 64 + ks * 32 + fq * 8);
#pragma unroll
                    for (int ni = 0; ni < 4; ++ni) acc[ni] = __builtin_amdgcn_mfma_f32_16x16x32_bf16(Wf[ni][ks], Af, acc[ni], 0, 0, 0); }
#pragma unroll
                for (int ni = 0; ni < 4; ++ni) { u32x2 w; w.x = pk2(acc[ni][0], acc[ni][1]); w.y = pk2(acc[ni][2], acc[ni][3]);
                    *(LAS u32x2*)(Lo + (mi * 16 + fr) * 392 + h * 64 + ni * 16 + fq * 4) = w; }
            }
        }
#endif
        {
            bf16x8 Wf[4][4];
#pragma unroll
            for (int ni = 0; ni < 4; ++ni)
#pragma unroll
                for (int ks = 0; ks < 4; ++ks) Wf[ni][ks] = *(const bf16x8*)(WL + WL_GUP + (h * 64 + ni * 16 + fr) * 128 + ks * 32 + fq * 8);
#pragma unroll 1
            for (int mi = mi_lo; mi < mi_hi; ++mi) {
                f32x4 acc[4];
#pragma unroll
                for (int ni = 0; ni < 4; ++ni) acc[ni] = (f32x4){0.f, 0.f, 0.f, 0.f};
#pragma unroll
                for (int ks = 0; ks < 4; ++ks) { const bf16x8 Af = *(const LAS bf16x8*)(AL + (mi * 16 + fr) * 264 + 128 + ks * 32 + fq * 8);
#pragma unroll
                    for (int ni = 0; ni < 4; ++ni) acc[ni] = __builtin_amdgcn_mfma_f32_16x16x32_bf16(Wf[ni][ks], Af, acc[ni], 0, 0, 0); }
                const int row = row0 + mi * 16 + fr;
#pragma unroll
                for (int ni = 0; ni < 4; ++ni) { u32x2 w; w.x = pk2(acc[ni][0], acc[ni][1]); w.y = pk2(acc[ni][2], acc[ni][3]);
#ifndef NP_NO_G
                    *(u32x2*)(G + (size_t)row * 384 + h * 64 + ni * 16 + fq * 4) = w;
#endif
                }
            }
        }
    } else
#endif
#ifndef SK_PREP_L
    if (wave >= 6) {
#pragma unroll 1
        for (int nn = 0; nn < 2; ++nn) {
            const int n = (wave - 6) * 2 + nn;
            bf16x8 Wa[4][2], Wx[4][2];
#pragma unroll
            for (int ni = 0; ni < 4; ++ni)
#pragma unroll
                for (int ks = 0; ks < 2; ++ks) { Wa[ni][ks] = *(const bf16x8*)(WL + WL_WA + n * 4096 + (ni * 16 + fr) * 64 + ks * 32 + fq * 8);
                                                  Wx[ni][ks] = *(const bf16x8*)(WL + WL_WX + n * 4096 + (ni * 16 + fr) * 64 + ks * 32 + fq * 8); }
#pragma unroll 1
            for (int mi = mi_lo; mi < mi_hi; ++mi) {
                f32x4 ar[4], ax[4];
#pragma unroll
                for (int ni = 0; ni < 4; ++ni) { ar[ni] = (f32x4){0.f, 0.f, 0.f, 0.f}; ax[ni] = ar[ni]; }
#pragma unroll
                for (int ks = 0; ks < 2; ++ks) { const bf16x8 Af = *(const LAS bf16x8*)(XC + (mi * 16 + fr) * 264 + n * 64 + ks * 32 + fq * 8);
#pragma unroll
                    for (int ni = 0; ni < 4; ++ni) { ar[ni] = __builtin_amdgcn_mfma_f32_16x16x32_bf16(Wa[ni][ks], Af, ar[ni], 0, 0, 0); ax[ni] = __builtin_amdgcn_mfma_f32_16x16x32_bf16(Wx[ni][ks], Af, ax[ni], 0, 0, 0); } }
#pragma unroll
                for (int ni = 0; ni < 4; ++ni) { u32x2 w1, w2; w1.x = pk2(ar[ni][0], ar[ni][1]); w1.y = pk2(ar[ni][2], ar[ni][3]); w2.x = pk2(ax[ni][0], ax[ni][1]); w2.y = pk2(ax[ni][2], ax[ni][3]);
                    *(LAS u32x2*)(GR + (mi * 16 + fr) * 264 + n * 64 + ni * 16 + fq * 4) = w1; *(LAS u32x2*)(GI + (mi * 16 + fr) * 264 + n * 64 + ni * 16 + fq * 4) = w2; }
            }
        }
    }
#endif
    __syncthreads();
#ifndef NP_NO_RW
#pragma unroll 1
    for (int itx = 0; itx < 3; ++itx) {
        const int idx = itx * NT + tid, r = idx / 48, cg = idx % 48, c0 = cg * 8, h = cg >> 3, i0 = c0 & 63;
        if (r < 16 * mi_lo || r >= 16 * mi_hi) continue;
        const int row = row0 + r, t = row & (TT - 1);
        const bool valid = samp || t > 0; const int prow = samp ? row + 128 : row - 1;
        float cr[8], ck[8], cv[8], er[8], ek[8], ev[8], lw[8], la[8];
        const bf16* pr = P + (size_t)row * NP + c0; const bf16* pq = P + (size_t)prow * NP + c0;
        unpack8(*(const u32x4*)pr, cr); unpack8(*(const u32x4*)(pr + 384), ck); unpack8(*(const u32x4*)(pr + 768), cv);
        if (valid) { unpack8(*(const u32x4*)pq, er); unpack8(*(const u32x4*)(pq + 384), ek); unpack8(*(const u32x4*)(pq + 768), ev); }
        else { _Pragma("unroll") for (int e = 0; e < 8; ++e) { er[e] = 0.f; ek[e] = 0.f; ev[e] = 0.f; } }
        unpack8(*(const LAS u32x4*)(LW + r * 392 + c0), lw); unpack8(*(const LAS u32x4*)(LAo + r * 392 + c0), la);
        float wq[8], kq[8], av[8], rv[8], kv[8], vv[8]; float ssq = 0.f;
#pragma unroll
        for (int e = 0; e < 8; ++e) {
            const float mr = PRM[c0 + e], mk = PRM[384 + c0 + e], mv = PRM[768 + c0 + e], w0 = PRM[1152 + c0 + e], a0 = PRM[1536 + c0 + e], kk_ = PRM[1920 + c0 + e], ka_ = PRM[2304 + c0 + e];
            rv[e] = cr[e] + mr * (er[e] - cr[e]); const float kx = ck[e] + mk * (ek[e] - ck[e]); vv[e] = cv[e] + mv * (ev[e] - cv[e]);
            wq[e] = __expf(-0.6065306597f * sigm(w0 + lw[e]));
            av[e] = sigm(a0 + la[e]);
            kq[e] = kx * kk_; ssq += kq[e] * kq[e];
            kv[e] = kx * (1.f + (av[e] - 1.f) * ka_);
        }
        ssq = dpp_sum8<0>(ssq);
        const float inv = rsqrtf(fmaxf(ssq, 1e-24f));
        unsigned char* rec = samp ? ws + WS_SCANS + (size_t)((row - MP) * 6 + h) * REC
                                  : ws + WS_SCAN + ((size_t)((row >> 11) * 6 + h) * TT + t) * REC;
        f32x4 o0, o1;
        o0 = (f32x4){wq[0], wq[1], wq[2], wq[3]}; o1 = (f32x4){wq[4], wq[5], wq[6], wq[7]};
        *(f32x4*)(rec + 4 * i0) = o0; *(f32x4*)(rec + 4 * i0 + 16) = o1;
#pragma unroll
        for (int e = 0; e < 8; ++e) kq[e] *= inv;
        o0 = (f32x4){kq[0], kq[1], kq[2], kq[3]}; o1 = (f32x4){kq[4], kq[5], kq[6], kq[7]};
        *(f32x4*)(rec + 256 + 4 * i0) = o0; *(f32x4*)(rec + 256 + 4 * i0 + 16) = o1;
        o0 = (f32x4){kq[0] * av[0], kq[1] * av[1], kq[2] * av[2], kq[3] * av[3]}; o1 = (f32x4){kq[4] * av[4], kq[5] * av[5], kq[6] * av[6], kq[7] * av[7]};
        *(f32x4*)(rec + 512 + 4 * i0) = o0; *(f32x4*)(rec + 512 + 4 * i0 + 16) = o1;
        u32x4 rk; rk.x = pk2(rv[0], rv[1]); rk.y = pk2(rv[2], rv[3]); rk.z = pk2(kv[0], kv[1]); rk.w = pk2(kv[2], kv[3]);
        *(u32x4*)(rec + 768 + 4 * i0) = rk;
        rk.x = pk2(rv[4], rv[5]); rk.y = pk2(rv[6], rv[7]); rk.z = pk2(kv[4], kv[5]); rk.w = pk2(kv[6], kv[7]);
        *(u32x4*)(rec + 768 + 4 * i0 + 16) = rk;
        u32x4 vp; vp.x = pk2(vv[0], vv[1]); vp.y = pk2(vv[2], vv[3]); vp.z = pk2(vv[4], vv[5]); vp.w = pk2(vv[6], vv[7]);
        *(u32x4*)(rec + 1024 + 2 * i0) = vp;
    }
#endif
    {
        bf16* LA = (bf16*)(ws + WS_LA); bf16* LU = (bf16*)(ws + WS_LU);
#pragma unroll 1
        for (int itx = 0; itx < 2; ++itx) {
            const int idx = itx * NT + tid, r = idx >> 5, c0 = (idx & 31) * 8, row = row0 + r;
            if (r < 16 * mi_lo || r >= 16 * mi_hi) continue;
            float gr[8], gi[8], xc[8], la[8], uu[8];
            unpack8(*(const LAS u32x4*)(GR + r * 264 + c0), gr); unpack8(*(const LAS u32x4*)(GI + r * 264 + c0), gi); unpack8(*(const LAS u32x4*)(XC + r * 264 + c0), xc);
#pragma unroll
            for (int e = 0; e < 8; ++e) { const float rr = sigm(gr[e] + PRM[2688 + c0 + e]), ii = sigm(gi[e] + PRM[2944 + c0 + e]);
                la[e] = -8.f * rr * PRM[3200 + c0 + e];
                uu[e] = xc[e] * ii * sqrtf(fmaxf(-expm1f(2.f * la[e]), 1e-12f)); }
            u32x4 o1, o2; o1.x = pk2(la[0], la[1]); o1.y = pk2(la[2], la[3]); o1.z = pk2(la[4], la[5]); o1.w = pk2(la[6], la[7]);
            o2.x = pk2(uu[0], uu[1]); o2.y = pk2(uu[2], uu[3]); o2.z = pk2(uu[4], uu[5]); o2.w = pk2(uu[6], uu[7]);
#ifndef NP_NO_LRU
            *(u32x4*)(LA + (size_t)row * 256 + c0) = o1; *(u32x4*)(LU + (size_t)row * 256 + c0) = o2;
#endif
        }
    }
    __syncthreads();
}

DEV void phase_prep(const Args& a, int l, LAS unsigned char* lds, bool do_gelu = true) {
    const int tid = otid(), lane = tid & 63, wave = tid >> 6;
    const int gw = blockIdx.x * NWV + wave, NGW = gridDim.x * NWV;
    unsigned char* ws = a.ws;
    {
        LAS float* PRM = (LAS float*)(lds + PL_PRM);
        for (int i = tid; i < 384; i += NT) { PRM[i] = a.in[I_MU][l * 1408 + i]; PRM[384 + i] = a.in[I_MU][l * 1408 + 384 + i]; PRM[768 + i] = a.in[I_MU][l * 1408 + 768 + i];
            PRM[1152 + i] = a.in[I_W0][l * 384 + i]; PRM[1536 + i] = a.in[I_A0][l * 384 + i]; PRM[1920 + i] = a.in[I_KK][l * 384 + i]; PRM[2304 + i] = a.in[I_KA][l * 384 + i]; }
        for (int i = tid; i < 256; i += NT) { PRM[2688 + i] = a.in[I_BA][l * 256 + i]; PRM[2944 + i] = a.in[I_BX][l * 256 + i]; PRM[3200 + i] = log1pf(__expf(-a.in[I_LAM][l * 256 + i])); }
    }
    __syncthreads();
    prep_tile(a, l, blockIdx.x, lds, do_gelu); prep_tile(a, l, blockIdx.x + 256, lds, do_gelu);
    if (blockIdx.x >= 248) { const int q = blockIdx.x - 248; prep_tile(a, l, 512 + (q >> 1), lds, do_gelu, q & 1, (q & 1) + 1); }
    const float* rss = (const float*)(ws + WS_RSE);
    for (int r = gw; r < 136; r += NGW) {
        const int row = r < 8 ? r * TT + TT - 1 : MP + (r - 8);
        const f32x4* src = (const f32x4*)(row < MP ? a.out + (size_t)row * DM : (const float*)(ws + WS_XS) + (size_t)(row - MP) * DM);
        f32x4* dst = (f32x4*)(r < 8 ? a.out + O_PSHIFT + (size_t)(l * 8 + r) * DM : a.out + O_SSHIFT + (size_t)(l * 128 + (r - 8)) * DM);
        const f32x4* g4 = (const f32x4*)(a.in[I_N1G] + l * DM);
        const float s = row_scale(rss, row);
#pragma unroll
        for (int j = 0; j < 4; ++j) { const f32x4 v = src[lane + 64 * j], g = g4[lane + 64 * j]; dst[lane + 64 * j] = (f32x4){v[0] * s * g[0], v[1] * s * g[1], v[2] * s * g[2], v[3] * s * g[3]}; }
    }
    if (l + 2 < 4) {
        bf16* U = (bf16*)(ws + ((l & 1) ? WS_U1 : WS_U0));
        for (int i = gw; i < 128; i += NGW) {
            const f32x4* src = (const f32x4*)(a.in[I_SSHIFT] + (size_t)((l + 2) * 128 + i) * DM);
            u32x2* ud = (u32x2*)(U + (size_t)(MREAL + i) * DM);
#pragma unroll
            for (int j = 0; j < 4; ++j) { const f32x4 v = src[lane + 64 * j]; u32x2 w; w.x = pk2(v[0], v[1]); w.y = pk2(v[2], v[3]); ud[lane + 64 * j] = w; }
        }
    }
    __syncthreads();
    LAS float* scr = (LAS float*)(lds + wave * 8448);
    if (blockIdx.x < 248) {
    const int NGW2 = 248 * NWV; int it = gw;
    transpose_job(a.in[I_WOUT] + (size_t)l * DM * DM, DM, DM, (bf16*)(ws + WS_WTOUT), it, NGW2, scr, lane);
    transpose_job(a.in[I_W1] + (size_t)l * DM * FF, DM, FF, (bf16*)(ws + WS_WT1), it, NGW2, scr, lane);
    transpose_job(a.in[I_W2] + (size_t)l * FF * DM, FF, DM, (bf16*)(ws + WS_WT2), it, NGW2, scr, lane);
    }
}

DEV void prep_tile_old(const Args& a, int l, int tt, LAS unsigned char* lds, bool do_gelu = true, int mi_lo = 0, int mi_hi = 4) {
    const int tid = otid(), lane = tid & 63, wave = __builtin_amdgcn_readfirstlane(tid >> 6);
    unsigned char* ws = a.ws;
    LAS bf16* AL = (LAS bf16*)lds;
    LAS bf16* XC = (LAS bf16*)(lds + 33792);
    bf16* P = (bf16*)(ws + WS_P);
    const bool samp = tt >= 256;
    const int row0 = tt * 64;
    const float* mu = a.in[I_MU] + l * 1408;
    LAS float* SPT = (LAS float*)(lds + 67584);
    if (tid < 256) SPT[tid] = log1pf(__expf(-a.in[I_LAM][l * 256 + tid]));
#ifndef SK_PREP_A
#pragma unroll 1
    for (int itx = mi_lo; itx < mi_hi; ++itx) {
        const int idx = itx * NT + tid, r = idx >> 5, col = (idx & 31) * 8, row = row0 + r, t = row & (TT - 1);
        float p[8], pp[8], x[8];
        {
            unpack8(*(const u32x4*)(P + (size_t)row * NP + 1152 + col), p);
            const bool valid = samp || t > 0; const int prow = samp ? row + 128 : row - 1;
            if (valid) unpack8(*(const u32x4*)(P + (size_t)prow * NP + 1152 + col), pp);
            else { _Pragma("unroll") for (int e = 0; e < 8; ++e) pp[e] = 0.f; }
            const f32x4 m0 = *(const f32x4*)(mu + 1152 + col), m1 = *(const f32x4*)(mu + 1152 + col + 4);
#pragma unroll
            for (int e = 0; e < 8; ++e) { const float m = e < 4 ? m0[e] : m1[e - 4]; x[e] = p[e] + m * (pp[e] - p[e]); }
            if (col < 64) { _Pragma("unroll") for (int e = 0; e < 8; ++e) x[e] = tanhf(x[e]); }
            else if (col >= 128) { _Pragma("unroll") for (int e = 0; e < 8; ++e) x[e] = sigm(x[e]); }
            u32x4 w; w.x = pk2(x[0], x[1]); w.y = pk2(x[2], x[3]); w.z = pk2(x[4], x[5]); w.w = pk2(x[6], x[7]);
            *(LAS u32x4*)(AL + r * 264 + col) = w;
        }
        {
            float xr[4][8];
            unpack8(*(const u32x4*)(P + (size_t)row * NP + 2944 + col), xr[0]);
            if (!samp) {
#pragma unroll
                for (int j = 1; j < 4; ++j) { if (t - j >= 0) unpack8(*(const u32x4*)(P + (size_t)(row - j) * NP + 2944 + col), xr[j]); else { _Pragma("unroll") for (int e = 0; e < 8; ++e) xr[j][e] = 0.f; } }
                if (t >= TT - 3) { float* pc = a.out + O_PCONV + ((size_t)((l * 8 + (row >> 11)) * 3 + (t - (TT - 3)))) * 256 + col;
                    *(f32x4*)pc = (f32x4){xr[0][0], xr[0][1], xr[0][2], xr[0][3]}; *(f32x4*)(pc + 4) = (f32x4){xr[0][4], xr[0][5], xr[0][6], xr[0][7]}; }
            } else {
                const int i = row - MP; const float* c0 = a.in[I_SCONV] + (size_t)((l * 128 + i) * 3) * 256 + col;
#pragma unroll
                for (int j = 1; j < 4; ++j) { const f32x4 q0 = *(const f32x4*)(c0 + (3 - j) * 256), q1 = *(const f32x4*)(c0 + (3 - j) * 256 + 4);
                    xr[j][0] = q0[0]; xr[j][1] = q0[1]; xr[j][2] = q0[2]; xr[j][3] = q0[3]; xr[j][4] = q1[0]; xr[j][5] = q1[1]; xr[j][6] = q1[2]; xr[j][7] = q1[3]; }
                float* sc = a.out + O_SCONV + (size_t)((l * 128 + i) * 3) * 256 + col;
                *(f32x4*)(sc) = (f32x4){xr[2][0], xr[2][1], xr[2][2], xr[2][3]}; *(f32x4*)(sc + 4) = (f32x4){xr[2][4], xr[2][5], xr[2][6], xr[2][7]};
                *(f32x4*)(sc + 256) = (f32x4){xr[1][0], xr[1][1], xr[1][2], xr[1][3]}; *(f32x4*)(sc + 260) = (f32x4){xr[1][4], xr[1][5], xr[1][6], xr[1][7]};
                *(f32x4*)(sc + 512) = (f32x4){xr[0][0], xr[0][1], xr[0][2], xr[0][3]}; *(f32x4*)(sc + 516) = (f32x4){xr[0][4], xr[0][5], xr[0][6], xr[0][7]};
            }
            const float* cw = a.in[I_CW] + (size_t)l * 4 * 256 + col; const float* cb = a.in[I_CB] + l * 256 + col;
            float xc[8];
#pragma unroll
            for (int e = 0; e < 8; ++e) xc[e] = cb[e] + cw[e] * xr[3][e] + cw[256 + e] * xr[2][e] + cw[512 + e] * xr[1][e] + cw[768 + e] * xr[0][e];
            u32x4 w; w.x = pk2(xc[0], xc[1]); w.y = pk2(xc[2], xc[3]); w.z = pk2(xc[4], xc[5]); w.w = pk2(xc[6], xc[7]);
            *(LAS u32x4*)(XC + r * 264 + col) = w;
            float gt8[8]; bf16* gp = P + (size_t)row * NP + 3200 + col;
            unpack8(*(const u32x4*)gp, gt8);
#pragma unroll
            for (int e = 0; e < 8; ++e) gt8[e] = gelu_t(gt8[e]);
            u32x4 gw; gw.x = pk2(gt8[0], gt8[1]); gw.y = pk2(gt8[2], gt8[3]); gw.z = pk2(gt8[4], gt8[5]); gw.w = pk2(gt8[6], gt8[7]);
        }
    }
#endif
    __syncthreads();
    const int fr = lane & 15, fq = lane >> 4;
    const bf16* WL = (const bf16*)(ws + WS_WLORA) + (size_t)l * WL_STRIDE;
#ifdef SK_PREP_R
    if (false) {
#else
    if (wave < 6) {
#endif
        const int h = wave;
        const float* w0 = a.in[I_W0] + l * 384; const float* a0 = a.in[I_A0] + l * 384; const float* kkp = a.in[I_KK] + l * 384; const float* kap = a.in[I_KA] + l * 384;
        bf16* G = (bf16*)(ws + WS_G);
        bf16x8 Ww[4][2], Wa2[4][2];
#pragma unroll
        for (int ni = 0; ni < 4; ++ni)
#pragma unroll
            for (int ks = 0; ks < 2; ++ks) { const int n = h * 64 + ni * 16 + fr; Ww[ni][ks] = *(const bf16x8*)(WL + n * 64 + ks * 32 + fq * 8); Wa2[ni][ks] = *(const bf16x8*)(WL + WL_AUP + n * 64 + ks * 32 + fq * 8); }
#pragma unroll 1
        for (int mi = mi_lo; mi < mi_hi; ++mi) {
            f32x4 aw[4], aa[4], ag[4];
#pragma unroll
            for (int ni = 0; ni < 4; ++ni) { aw[ni] = (f32x4){0.f, 0.f, 0.f, 0.f}; aa[ni] = aw[ni]; ag[ni] = aw[ni]; }
            const LAS bf16* arow = AL + (mi * 16 + fr) * 264 + fq * 8;
#pragma unroll
            for (int ks = 0; ks < 2; ++ks) { const bf16x8 Af = *(const LAS bf16x8*)(arow + ks * 32), Bf = *(const LAS bf16x8*)(arow + 64 + ks * 32);
#pragma unroll
                for (int ni = 0; ni < 4; ++ni) {
                    aw[ni] = __builtin_amdgcn_mfma_f32_16x16x32_bf16(Ww[ni][ks], Af, aw[ni], 0, 0, 0);
                    aa[ni] = __builtin_amdgcn_mfma_f32_16x16x32_bf16(Wa2[ni][ks], Bf, aa[ni], 0, 0, 0); } }
#pragma unroll
            for (int ks = 0; ks < 4; ++ks) { const bf16x8 Af = *(const LAS bf16x8*)(arow + 128 + ks * 32);
#pragma unroll
                for (int ni = 0; ni < 4; ++ni) { const int n = h * 64 + ni * 16 + fr;
                    ag[ni] = __builtin_amdgcn_mfma_f32_16x16x32_bf16(*(const bf16x8*)(WL + WL_GUP + n * 128 + ks * 32 + fq * 8), Af, ag[ni], 0, 0, 0); } }
            const int r = mi * 16 + fr, row = row0 + r, t = row & (TT - 1);
#pragma unroll
            for (int ni = 0; ni < 4; ++ni) { u32x2 gp; gp.x = pk2(ag[ni][0], ag[ni][1]); gp.y = pk2(ag[ni][2], ag[ni][3]); *(u32x2*)(G + (size_t)row * 384 + h * 64 + ni * 16 + fq * 4) = gp; }
            const bool valid = samp || t > 0; const int prow = samp ? row + 128 : row - 1;
            float ssq = 0.f;
#pragma unroll
            for (int ni = 0; ni < 4; ++ni) {
                const int c0 = h * 64 + ni * 16 + fq * 4;
                const u32x2 uk = *(const u32x2*)(P + (size_t)row * NP + 384 + c0);
                u32x2 qk = (u32x2){0u, 0u}; if (valid) qk = *(const u32x2*)(P + (size_t)prow * NP + 384 + c0);
                const f32x4 mk = *(const f32x4*)(mu + 384 + c0), kk4 = *(const f32x4*)(kkp + c0);
                const float ck[4] = {bflo(uk.x), bfhi(uk.x), bflo(uk.y), bfhi(uk.y)}, ek[4] = {bflo(qk.x), bfhi(qk.x), bflo(qk.y), bfhi(qk.y)};
#pragma unroll
                for (int j = 0; j < 4; ++j) { const float kr = (ck[j] + mk[j] * (ek[j] - ck[j])) * kk4[j]; ssq += kr * kr; }
            }
            ssq += __shfl_xor(ssq, 16); ssq += __shfl_xor(ssq, 32);
            const float inv = rsqrtf(fmaxf(ssq, 1e-24f));
            unsigned char* rec = samp ? ws + WS_SCANS + (size_t)((row - MP) * 6 + h) * REC
                                      : ws + WS_SCAN + ((size_t)((row >> 11) * 6 + h) * TT + t) * REC;
#pragma unroll
            for (int ni = 0; ni < 4; ++ni) {
                asm volatile("" ::: "memory");
                const int i0 = ni * 16 + fq * 4, c0 = h * 64 + i0;
                const bf16* pr = P + (size_t)row * NP + c0; const bf16* pq = P + (size_t)prow * NP + c0;
                const u32x2 ur = *(const u32x2*)pr, uk = *(const u32x2*)(pr + 384), uv = *(const u32x2*)(pr + 768);
                u32x2 qr = (u32x2){0u, 0u}, qk = qr, qv = qr;
                if (valid) { qr = *(const u32x2*)pq; qk = *(const u32x2*)(pq + 384); qv = *(const u32x2*)(pq + 768); }
                const f32x4 mr = *(const f32x4*)(mu + c0), mk = *(const f32x4*)(mu + 384 + c0), mv = *(const f32x4*)(mu + 768 + c0);
                const f32x4 w04 = *(const f32x4*)(w0 + c0), a04 = *(const f32x4*)(a0 + c0), kk4 = *(const f32x4*)(kkp + c0), ka4 = *(const f32x4*)(kap + c0);
                const float cr[4] = {bflo(ur.x), bfhi(ur.x), bflo(ur.y), bfhi(ur.y)}, ck[4] = {bflo(uk.x), bfhi(uk.x), bflo(uk.y), bfhi(uk.y)}, cv[4] = {bflo(uv.x), bfhi(uv.x), bflo(uv.y), bfhi(uv.y)};
                const float er[4] = {bflo(qr.x), bfhi(qr.x), bflo(qr.y), bfhi(qr.y)}, ek[4] = {bflo(qk.x), bfhi(qk.x), bflo(qk.y), bfhi(qk.y)}, ev[4] = {bflo(qv.x), bfhi(qv.x), bflo(qv.y), bfhi(qv.y)};
                f32x4 wq, kq, bq; float rv[4], kv[4], vv[4];
#pragma unroll
                for (int j = 0; j < 4; ++j) {
                    const float rr = cr[j] + mr[j] * (er[j] - cr[j]), kx = ck[j] + mk[j] * (ek[j] - ck[j]), vx = cv[j] + mv[j] * (ev[j] - cv[j]);
                    const float sg = sigm(w04[j] + aw[ni][j]);
                    wq[j] = __expf(-0.6065306597f * sg);
                    const float aj = sigm(a04[j] + aa[ni][j]);
                    kq[j] = kx * kk4[j] * inv; bq[j] = kq[j] * aj;
                    kv[j] = kx * (1.f + (aj - 1.f) * ka4[j]); rv[j] = rr; vv[j] = vx;
                }
                *(f32x4*)(rec + 4 * i0) = wq; *(f32x4*)(rec + 256 + 4 * i0) = kq; *(f32x4*)(rec + 512 + 4 * i0) = bq;
                u32x4 rk; rk.x = pk2(rv[0], rv[1]); rk.y = pk2(rv[2], rv[3]); rk.z = pk2(kv[0], kv[1]); rk.w = pk2(kv[2], kv[3]);
                *(u32x4*)(rec + 768 + 4 * i0) = rk;
                u32x2 vp; vp.x = pk2(vv[0], vv[1]); vp.y = pk2(vv[2], vv[3]);
                *(u32x2*)(rec + 1024 + 2 * i0) = vp;
            }
        }
    } else
#ifdef SK_PREP_L
    if (false)
#endif
    {
        const float* ba = a.in[I_BA] + l * 256; const float* bx = a.in[I_BX] + l * 256; const float* lam = a.in[I_LAM] + l * 256;
        bf16* LA = (bf16*)(ws + WS_LA); bf16* LU = (bf16*)(ws + WS_LU);
#pragma unroll 1
        for (int nn = 0; nn < 2; ++nn) {
            const int n = (wave - 6) * 2 + nn;
            bf16x8 Wa[4][2], Wx[4][2];
#pragma unroll
            for (int ni = 0; ni < 4; ++ni) { const int d = ni * 16 + fr;
#pragma unroll
                for (int ks = 0; ks < 2; ++ks) { Wa[ni][ks] = *(const bf16x8*)(WL + WL_WA + n * 4096 + d * 64 + ks * 32 + fq * 8); Wx[ni][ks] = *(const bf16x8*)(WL + WL_WX + n * 4096 + d * 64 + ks * 32 + fq * 8); }
            }
#pragma unroll 1
            for (int mi = mi_lo; mi < mi_hi; ++mi) {
                f32x4 ar[4], ax[4];
#pragma unroll
                for (int ni = 0; ni < 4; ++ni) { ar[ni] = (f32x4){0.f, 0.f, 0.f, 0.f}; ax[ni] = ar[ni]; }
#pragma unroll
                for (int ks = 0; ks < 2; ++ks) { const bf16x8 Af = *(const LAS bf16x8*)(XC + (mi * 16 + fr) * 264 + n * 64 + ks * 32 + fq * 8);
#pragma unroll
                    for (int ni = 0; ni < 4; ++ni) { ar[ni] = __builtin_amdgcn_mfma_f32_16x16x32_bf16(Wa[ni][ks], Af, ar[ni], 0, 0, 0); ax[ni] = __builtin_amdgcn_mfma_f32_16x16x32_bf16(Wx[ni][ks], Af, ax[ni], 0, 0, 0); } }
                const int r = mi * 16 + fr, row = row0 + r;
#pragma unroll
                for (int ni = 0; ni < 4; ++ni) {
                    const int c0 = n * 64 + ni * 16 + fq * 4;
                    const f32x4 ba4 = *(const f32x4*)(ba + c0), bx4 = *(const f32x4*)(bx + c0), sp4 = *(const LAS f32x4*)(SPT + c0);
                    const u32x2 xu = *(const LAS u32x2*)(XC + r * 264 + c0);
                    const float xcv[4] = {bflo(xu.x), bfhi(xu.x), bflo(xu.y), bfhi(xu.y)};
                    float la[4], uu[4];
#pragma unroll
                    for (int j = 0; j < 4; ++j) {
                        const float rr = sigm(ar[ni][j] + ba4[j]), ii = sigm(ax[ni][j] + bx4[j]);
                        la[j] = -8.f * rr * sp4[j];
                        uu[j] = xcv[j] * ii * sqrtf(fmaxf(-expm1f(2.f * la[j]), 1e-12f));
                    }
                    u32x2 o1, o2; o1.x = pk2(la[0], la[1]); o1.y = pk2(la[2], la[3]); o2.x = pk2(uu[0], uu[1]); o2.y = pk2(uu[2], uu[3]);
                    *(u32x2*)(LA + (size_t)row * 256 + c0) = o1; *(u32x2*)(LU + (size_t)row * 256 + c0) = o2;
                }
            }
        }
    }
    __syncthreads();
}

DEV void phase_prep_old(const Args& a, int l, LAS unsigned char* lds, bool do_gelu = true) {
    const int tid = otid(), lane = tid & 63, wave = tid >> 6;
    const int gw = blockIdx.x * NWV + wave, NGW = gridDim.x * NWV;
    unsigned char* ws = a.ws;
    prep_tile_old(a, l, blockIdx.x, lds, do_gelu);
    if (blockIdx.x >= 248) { const int q = blockIdx.x - 248; prep_tile_old(a, l, 256 + (q >> 2), lds, do_gelu, q & 3, (q & 3) + 1); }
    const float* rss = (const float*)(ws + WS_RSE);
    for (int r = gw; r < 136; r += NGW) {
        const int row = r < 8 ? r * TT + TT - 1 : MP + (r - 8);
        const f32x4* src = (const f32x4*)(row < MP ? a.out + (size_t)row * DM : (const float*)(ws + WS_XS) + (size_t)(row - MP) * DM);
        f32x4* dst = (f32x4*)(r < 8 ? a.out + O_PSHIFT + (size_t)(l * 8 + r) * DM : a.out + O_SSHIFT + (size_t)(l * 128 + (r - 8)) * DM);
        const f32x4* g4 = (const f32x4*)(a.in[I_N1G] + l * DM);
        const float s = row_scale(rss, row);
#pragma unroll
        for (int j = 0; j < 4; ++j) { const f32x4 v = src[lane + 64 * j], g = g4[lane + 64 * j]; dst[lane + 64 * j] = (f32x4){v[0] * s * g[0], v[1] * s * g[1], v[2] * s * g[2], v[3] * s * g[3]}; }
    }
    if (l + 2 < 4) {
        bf16* U = (bf16*)(ws + ((l & 1) ? WS_U1 : WS_U0));
        for (int i = gw; i < 128; i += NGW) {
            const f32x4* src = (const f32x4*)(a.in[I_SSHIFT] + (size_t)((l + 2) * 128 + i) * DM);
            u32x2* ud = (u32x2*)(U + (size_t)(MREAL + i) * DM);
#pragma unroll
            for (int j = 0; j < 4; ++j) { const f32x4 v = src[lane + 64 * j]; u32x2 w; w.x = pk2(v[0], v[1]); w.y = pk2(v[2], v[3]); ud[lane + 64 * j] = w; }
        }
    }
    __syncthreads();
    LAS float* scr = (LAS float*)(lds + wave * 8448);
    if (blockIdx.x < 248) {
    const int NGW2 = 248 * NWV; int it = gw;
    transpose_job(a.in[I_WOUT] + (size_t)l * DM * DM, DM, DM, (bf16*)(ws + WS_WTOUT), it, NGW2, scr, lane);
    transpose_job(a.in[I_W1] + (size_t)l * DM * FF, DM, FF, (bf16*)(ws + WS_WT1), it, NGW2, scr, lane);
    transpose_job(a.in[I_W2] + (size_t)l * FF * DM, FF, DM, (bf16*)(ws + WS_WT2), it, NGW2, scr, lane);
    }
#ifdef DUP_TR
    if (blockIdx.x < 248) { const int NGW2 = 248 * NWV; int it = gw;
    transpose_job(a.in[I_WOUT] + (size_t)l * DM * DM, DM, DM, (bf16*)(ws + WS_WTOUT), it, NGW2, scr, lane);
    transpose_job(a.in[I_W1] + (size_t)l * DM * FF, DM, FF, (bf16*)(ws + WS_WT1), it, NGW2, scr, lane);
    transpose_job(a.in[I_W2] + (size_t)l * FF * DM, FF, DM, (bf16*)(ws + WS_WT2), it, NGW2, scr, lane);
    }
#endif
}

DEV void rwkv_scan_block(const Args& a, int l, int blk, LAS unsigned char* lds) {
    const int tid = otid(), lane = tid & 63, wave = __builtin_amdgcn_readfirstlane(tid >> 6);
    unsigned char* ws = a.ws;
    const int bh = blk >> 2, rg = blk & 3;
    const unsigned char* recbase = ws + WS_SCAN + (size_t)bh * TT * REC;
    constexpr int CH = 32, CHB = CH * REC, NCH = TT / CH;
    const int lt = tid - 256;
    u32x4 ra[9], rb[9];
#define RW_LOAD(dst, chunk) do { const u32x4* src_ = (const u32x4*)(recbase + (size_t)(chunk) * CHB); _Pragma("unroll") for (int q = 0; q < 9; ++q) dst[q] = src_[lt + 256 * q]; } while (0)
#define RW_STORE(srcv, buf) do { LAS unsigned char* d_ = lds + (buf) * CHB; _Pragma("unroll") for (int q = 0; q < 9; ++q) *(LAS u32x4*)(d_ + (lt + 256 * q) * 16) = srcv[q]; } while (0)
    if (wave >= 4) { RW_LOAD(ra, 0); RW_LOAD(rb, 1); RW_STORE(ra, 0); RW_LOAD(ra, 2); }
    __syncthreads();
    const int g = lane >> 4, j = lane & 15, rowv = rg * 16 + (wave & 3) * 4 + g;
    float S0 = 0.f, S1 = 0.f, S2 = 0.f, S3 = 0.f, keep = 0.f;
    bf16* outr = (bf16*)(ws + WS_OUTR) + (size_t)(bh * 64 + rowv) * TT;
#define RW_LD(W, K, B, RK, V, tl) do { const LAS unsigned char* rec_ = buf + (tl) * REC; W = *(const LAS f32x4*)(rec_ + 16 * j); K = *(const LAS f32x4*)(rec_ + 256 + 16 * j); \
        B = *(const LAS f32x4*)(rec_ + 512 + 16 * j); RK = *(const LAS u32x4*)(rec_ + 768 + 16 * j); V = *(const LAS unsigned short*)(rec_ + 1024 + 2 * rowv); } while (0)
#define RW_SCAN(c) do { const LAS unsigned char* buf = lds + ((c) & 1) * CHB; \
        f32x4 w4, k4, b4, nw, nk, nb; u32x4 rk, nrk; unsigned short vs, nvs; \
        RW_LD(w4, k4, b4, rk, vs, 0); nw = w4; nk = k4; nb = b4; nrk = rk; nvs = vs; \
        _Pragma("unroll 16") for (int tl = 0; tl < CH; ++tl) { \
            if (tl + 1 < CH) RW_LD(nw, nk, nb, nrk, nvs, tl + 1); \
            const float vv = bf2f(vs); \
            float sa = (S0 * k4[0] + S1 * k4[1]) + (S2 * k4[2] + S3 * k4[3]); \
            sa = -red16(sa); \
            S0 = S0 * w4[0] + (sa * b4[0] + vv * bflo(rk.z)); S1 = S1 * w4[1] + (sa * b4[1] + vv * bfhi(rk.z)); \
            S2 = S2 * w4[2] + (sa * b4[2] + vv * bflo(rk.w)); S3 = S3 * w4[3] + (sa * b4[3] + vv * bfhi(rk.w)); \
            float o = (S0 * bflo(rk.x) + S1 * bfhi(rk.x)) + (S2 * bflo(rk.y) + S3 * bfhi(rk.y)); \
            o = red16(o); \
            if (j == (tl & 15)) keep = o; \
            if ((tl & 15) == 15) outr[(c) * CH + (tl - 15) + j] = f2bf(keep); \
            w4 = nw; k4 = nk; b4 = nb; rk = nrk; vs = nvs; } } while (0)
#pragma unroll 1
    for (int c = 0; c < NCH; c += 2) {
        if (wave >= 4) { RW_STORE(rb, 1); if (c + 3 < NCH) RW_LOAD(rb, c + 3); }
        else RW_SCAN(c);
        __syncthreads();
        if (wave >= 4) { if (c + 2 < NCH) { RW_STORE(ra, 0); if (c + 4 < NCH) RW_LOAD(ra, c + 4); } }
        else RW_SCAN(c + 1);
        __syncthreads();
    }
#undef RW_LOAD
#undef RW_STORE
#undef RW_SCAN
#undef RW_LD
    if (wave < 4) { float* so = a.out + O_PWKV + ((size_t)(l * 48 + bh) * 64 + rowv) * 64 + 4 * j; *(f32x4*)so = (f32x4){S0, S1, S2, S3}; }
}

DEV void hgrn_scan_block(const Args& a, int l, int bh, LAS unsigned char* lds) {
    const int tid = otid(), lane = tid & 63, wave = __builtin_amdgcn_readfirstlane(tid >> 6);
    unsigned char* ws = a.ws;
    const int b = bh / 6, h = bh % 6;
    const bf16* P = (const bf16*)(ws + WS_P);
    bf16* mix = (bf16*)(ws + (((l + 1) & 1) ? WS_U1 : WS_U0));
    constexpr int PT = 72, ARR = 64 * PT * 2;
    LAS bf16* Qm = (LAS bf16*)lds; LAS bf16* Km = Qm + 64 * PT; LAS bf16* Qb = Km + 64 * PT; LAS bf16* KbT = Qb + 64 * PT; LAS bf16* VT = KbT + 64 * PT;
    LAS bf16* AT = VT + 64 * PT; LAS bf16* ST0 = AT + 64 * PT;
    LAS float* O = (LAS float*)(lds + 8 * ARR);
    LAS float* GT = O + 4096;
    LAS float* EB = GT + 512;
    const int k = lane, tg = wave;
    const float lb = ((const float*)(ws + WS_LBT))[l * 384 + h * 64 + k];
    const float ng = a.in[I_HNG][l * 384 + h * 64 + lane];
    const int fr = lane & 15, fq = lane >> 4;
    f32x4 Sacc[2];
    Sacc[0] = (f32x4){0.f, 0.f, 0.f, 0.f}; Sacc[1] = Sacc[0];
    {
        for (int i = tid; i < 64 * PT / 2; i += NT) ((LAS unsigned*)ST0)[i] = 0u;
    }
    __syncthreads();
#define HG_BAR() asm volatile("s_waitcnt lgkmcnt(0)\n\ts_barrier" ::: "memory")
    unsigned short nq[8], nf[8], nv[8], ngt[8];
#define HG_PREF(chunk) do { _Pragma("unroll") for (int i = 0; i < 8; ++i) { const bf16* pr_ = P + (size_t)(b * TT + (chunk) * 64 + tg * 8 + i) * NP + 1408 + h * 64 + k; \
        nq[i] = pr_[0]; nf[i] = pr_[384]; nv[i] = pr_[768]; ngt[i] = pr_[1152]; } } while (0)
    HG_PREF(0);
#pragma unroll 1
    for (int c = 0; c < TT / 64; ++c) {
        const int rowc = b * TT + c * 64;
        LAS bf16* STr = ST0 + (c & 1) * 64 * PT; LAS bf16* STw = ST0 + ((c + 1) & 1) * 64 * PT;
        float q[8], kin[8], cs[8], iv[8], gcur[8];
#pragma unroll
        for (int i = 0; i < 8; ++i) {
            q[i] = bf2f(nq[i]); const float fp = bf2f(nf[i]); iv[i] = bf2f(nv[i]); gcur[i] = bf2f(ngt[i]);
            const float sg = sigm(fp); kin[i] = (1.f - lb) * sigm(-fp); const float f = lb + (1.f - lb) * sg;
            cs[i] = __logf(f) + (i ? cs[i - 1] : 0.f); }
        if (c + 1 < TT / 64) HG_PREF(c + 1);
        GT[tg * 64 + k] = cs[7];
        HG_BAR();
        float off = 0.f, m = 0.f, bl = 0.f;
#pragma unroll
        for (int g2 = 0; g2 < 8; ++g2) { const float gv = GT[g2 * 64 + k]; if (g2 < tg) off += gv; if (g2 < 4) m += gv; bl += gv; }
        if (tg == 0) EB[k] = __expf(bl);
        {
            unsigned kb8[8], vt8[8];
#pragma unroll
            for (int i = 0; i < 8; ++i) { const int t = tg * 8 + i; const float bb = off + cs[i];
                Qm[t * PT + k] = f2bf(q[i] * __expf(bb - m)); Km[t * PT + k] = f2bf(kin[i] * __expf(m - bb)); Qb[t * PT + k] = f2bf(q[i] * __expf(bb));
                kb8[i] = f2bf(kin[i] * __expf(bl - bb)); vt8[i] = f2bf(iv[i]); }
            u32x4 w1, w2; w1.x = kb8[0] | (kb8[1] << 16); w1.y = kb8[2] | (kb8[3] << 16); w1.z = kb8[4] | (kb8[5] << 16); w1.w = kb8[6] | (kb8[7] << 16);
            w2.x = vt8[0] | (vt8[1] << 16); w2.y = vt8[2] | (vt8[3] << 16); w2.z = vt8[4] | (vt8[5] << 16); w2.w = vt8[6] | (vt8[7] << 16);
            *(LAS u32x4*)(KbT + k * PT + tg * 8) = w1; *(LAS u32x4*)(VT + k * PT + tg * 8) = w2;
        }
        HG_BAR();
        {
            const int tr = wave >> 1;
#pragma unroll
            for (int i = 0; i < 2; ++i) { const int sc = (wave & 1) * 2 + i;
                f32x4 acc = (f32x4){0.f, 0.f, 0.f, 0.f};
                if (sc <= tr) {
#pragma unroll
                    for (int ks = 0; ks < 2; ++ks) { const bf16x8 af = *(const LAS bf16x8*)(Km + (sc * 16 + fr) * PT + ks * 32 + fq * 8), bfr = *(const LAS bf16x8*)(Qm + (tr * 16 + fr) * PT + ks * 32 + fq * 8);
                        acc = __builtin_amdgcn_mfma_f32_16x16x32_bf16(af, bfr, acc, 0, 0, 0); }
                }
                const int t = tr * 16 + fr, s0 = sc * 16 + fq * 4;
                u32x2 w; w.x = pk2(s0 <= t ? acc[0] : 0.f, s0 + 1 <= t ? acc[1] : 0.f); w.y = pk2(s0 + 2 <= t ? acc[2] : 0.f, s0 + 3 <= t ? acc[3] : 0.f);
                *(LAS u32x2*)(AT + t * PT + s0) = w; }
        }
        HG_BAR();
        {
            const int tr = wave >> 1, kb = wave >> 1;
#pragma unroll
            for (int i = 0; i < 2; ++i) { const int vb = (wave & 1) * 2 + i;
                f32x4 acc = (f32x4){0.f, 0.f, 0.f, 0.f};
#pragma unroll
                for (int ks = 0; ks < 2; ++ks) {
                    if (ks * 2 <= tr) { const bf16x8 af = *(const LAS bf16x8*)(VT + (vb * 16 + fr) * PT + ks * 32 + fq * 8), bfr = *(const LAS bf16x8*)(AT + (tr * 16 + fr) * PT + ks * 32 + fq * 8);
                        acc = __builtin_amdgcn_mfma_f32_16x16x32_bf16(af, bfr, acc, 0, 0, 0); }
                    const bf16x8 a2 = *(const LAS bf16x8*)(STr + (vb * 16 + fr) * PT + ks * 32 + fq * 8), b2 = *(const LAS bf16x8*)(Qb + (tr * 16 + fr) * PT + ks * 32 + fq * 8);
                    acc = __builtin_amdgcn_mfma_f32_16x16x32_bf16(a2, b2, acc, 0, 0, 0); }
                *(LAS f32x4*)(O + (tr * 16 + fr) * 64 + vb * 16 + fq * 4) = acc;
                f32x4 kv = (f32x4){0.f, 0.f, 0.f, 0.f};
#pragma unroll
                for (int ks = 0; ks < 2; ++ks) { const bf16x8 af = *(const LAS bf16x8*)(KbT + (kb * 16 + fr) * PT + ks * 32 + fq * 8), bfr = *(const LAS bf16x8*)(VT + (vb * 16 + fr) * PT + ks * 32 + fq * 8);
                    kv = __builtin_amdgcn_mfma_f32_16x16x32_bf16(af, bfr, kv, 0, 0, 0); }
                const f32x4 eb = *(const LAS f32x4*)(EB + kb * 16 + fq * 4);
                Sacc[i][0] = eb[0] * Sacc[i][0] + kv[0]; Sacc[i][1] = eb[1] * Sacc[i][1] + kv[1]; Sacc[i][2] = eb[2] * Sacc[i][2] + kv[2]; Sacc[i][3] = eb[3] * Sacc[i][3] + kv[3];
                u32x2 w; w.x = pk2(Sacc[i][0], Sacc[i][1]); w.y = pk2(Sacc[i][2], Sacc[i][3]);
                *(LAS u32x2*)(STw + (vb * 16 + fr) * PT + kb * 16 + fq * 4) = w; }
        }
        HG_BAR();
#pragma unroll
        for (int itx = 0; itx < 8; ++itx) { const int t = wave * 8 + itx, row = rowc + t;
            const float o = O[t * 64 + lane];
            const float ss = wave_sum(o * o);
            const float gte = gcur[itx];
            mix[(size_t)row * DM + 384 + h * 64 + lane] = f2bf(o * rsqrtf(ss * (1.f / 64.f) + EPS) * ng * (gte * sigm(gte))); }
    }
#undef HG_BAR
#undef HG_PREF
    {
        const int kb = wave >> 1;
#pragma unroll
        for (int i = 0; i < 2; ++i) { const int vb = (wave & 1) * 2 + i;
            float* so = a.out + O_PHGRN + ((size_t)(l * 48 + bh) * 64 + kb * 16 + fq * 4) * 64 + vb * 16 + fr;
            so[0] = Sacc[i][0]; so[64] = Sacc[i][1]; so[128] = Sacc[i][2]; so[192] = Sacc[i][3]; }
    }
}

DEV void lru_scan_block(const Args& a, int l, int i, LAS unsigned char* lds) {
    const int tid = otid();
    unsigned char* ws = a.ws;
    const int b = i >> 1, cb = (i & 1) * 128;
    const bf16* P = (const bf16*)(ws + WS_P); const bf16* LA = (const bf16*)(ws + WS_LA); const bf16* LU = (const bf16*)(ws + WS_LU);
    bf16* mix = (bf16*)(ws + (((l + 1) & 1) ? WS_U1 : WS_U0));
    constexpr int TILE = 64 * 128 * 2;
    u32x4 rg[6];
#define LRU_LOAD(tile) do { _Pragma("unroll") for (int q = 0; q < 2; ++q) { const int p = tid + 512 * q; const size_t row = (size_t)b * TT + (tile) * 64 + (p >> 4); const int cc = cb + (p & 15) * 8; \
        rg[q] = *(const u32x4*)(LA + row * 256 + cc); rg[2 + q] = *(const u32x4*)(LU + row * 256 + cc); rg[4 + q] = *(const u32x4*)(P + row * NP + 3200 + cc); } } while (0)
#define LRU_STORE(buf) do { _Pragma("unroll") for (int q = 0; q < 2; ++q) { const int p = tid + 512 * q; \
        *(LAS u32x4*)(lds + (buf) * 3 * TILE + p * 16) = rg[q]; *(LAS u32x4*)(lds + (buf) * 3 * TILE + TILE + p * 16) = rg[2 + q]; { float g8_[8]; unpack8(rg[4 + q], g8_); _Pragma("unroll") for (int e_ = 0; e_ < 8; ++e_) g8_[e_] = gelu_t(g8_[e_]); u32x4 gw_; gw_.x = pk2(g8_[0], g8_[1]); gw_.y = pk2(g8_[2], g8_[3]); gw_.z = pk2(g8_[4], g8_[5]); gw_.w = pk2(g8_[6], g8_[7]); \
          *(LAS u32x4*)(lds + (buf) * 3 * TILE + 2 * TILE + p * 16) = gw_; } } } while (0)
    LRU_LOAD(0); LRU_STORE(0);
    __syncthreads();
    float h = 0.f;
#pragma unroll 1
    for (int tile = 0; tile < TT / 64; ++tile) {
        if (tile + 1 < TT / 64) LRU_LOAD(tile + 1);
        if (tid < 128) {
            const LAS unsigned short* la = (const LAS unsigned short*)(lds + (tile & 1) * 3 * TILE) + tid; const LAS unsigned short* lu = la + TILE / 2; const LAS unsigned short* gg = lu + TILE / 2;
            bf16* mo = mix + ((size_t)b * TT + tile * 64) * DM + 768 + cb + tid;
#pragma unroll 8
            for (int t = 0; t < 64; ++t) { h = __expf(bf2f(la[t * 128])) * h + bf2f(lu[t * 128]); mo[(size_t)t * DM] = f2bf(h * bf2f(gg[t * 128])); }
        }
        if (tile + 1 < TT / 64) LRU_STORE((tile + 1) & 1);
        __syncthreads();
    }
#undef LRU_LOAD
#undef LRU_STORE
    if (tid < 128) a.out[O_PLRU + (size_t)(l * 8 + b) * 256 + cb + tid] = h;
}

DEV void phase_post(const Args& a, int l, LAS unsigned char* lds) {
    const int tid = otid(), lane = tid & 63, wave = __builtin_amdgcn_readfirstlane(tid >> 6);
    unsigned char* ws = a.ws;
    const bf16* P = (const bf16*)(ws + WS_P); const bf16* G = (const bf16*)(ws + WS_G);
    bf16* mix = (bf16*)(ws + (((l + 1) & 1) ? WS_U1 : WS_U0));
    LAS unsigned short* OT = (LAS unsigned short*)lds;
    const float* lnw = a.in[I_LNW] + l * 384; const float* lnb = a.in[I_LNB] + l * 384; const float* rkp = a.in[I_RK] + l * 384;
#pragma unroll 1
    for (int item = blockIdx.x; item < 1536; item += gridDim.x) {
        const int b = item / 192, rem = item % 192, h = rem >> 5, t0 = (rem & 31) * 64, bh = b * 6 + h;
        { const int v = tid >> 3, seg = tid & 7; const u32x4 u = *(const u32x4*)((const bf16*)(ws + WS_OUTR) + (size_t)(bh * 64 + v) * TT + t0 + seg * 8);
          LAS unsigned* d = (LAS unsigned*)(OT + v * 66 + seg * 8); d[0] = u.x; d[1] = u.y; d[2] = u.z; d[3] = u.w; }
        __syncthreads();
        const float w_ = lnw[h * 64 + lane], b_ = lnb[h * 64 + lane], rk_ = rkp[h * 64 + lane];
#pragma unroll 2
        for (int q = 0; q < 8; ++q) {
            const int tt = wave * 8 + q, row = b * TT + t0 + tt;
            const float o = bf2f(OT[lane * 66 + tt]);
            const float mean = wave_sum(o) * (1.f / 64.f), d = o - mean, var = wave_sum(d * d) * (1.f / 64.f);
            const float gn = d * rsqrtf(var + 64e-5f) * w_ + b_;
            const unsigned char* rec = ws + WS_SCAN + ((size_t)bh * TT + t0 + tt) * REC;
            const float rr = bf2f(*(const unsigned short*)(rec + 768 + 16 * (lane >> 2) + 2 * (lane & 3))), kk = bf2f(*(const unsigned short*)(rec + 776 + 16 * (lane >> 2) + 2 * (lane & 3)));
            const float cb = wave_sum(rr * kk * rk_), vv = bf2f(*(const unsigned short*)(rec + 1024 + 2 * lane));
            const float gg = bf2f(G[(size_t)row * 384 + h * 64 + lane]);
            mix[(size_t)row * DM + h * 64 + lane] = f2bf((gn + cb * vv) * gg);
        }
        __syncthreads();
    }
    const int gw = __builtin_amdgcn_readfirstlane(blockIdx.x * NWV + wave), NGW = gridDim.x * NWV;
#pragma unroll 1
    for (int it = gw; it < 1664; it += NGW) {
        if (it < 768) {
            const int i = it / 6, h = it % 6, row = MP + i;
            const unsigned char* rec = ws + WS_SCANS + (size_t)(i * 6 + h) * REC;
            const float* s0 = a.in[I_SWKV] + ((size_t)((l * 128 + i) * 6 + h) * 64 + lane) * 64;
            float* s1 = a.out + O_SWKV + ((size_t)((l * 128 + i) * 6 + h) * 64 + lane) * 64;
            float sa = 0.f;
#pragma unroll 4
            for (int k4 = 0; k4 < 16; ++k4) { const f32x4 v = *(const f32x4*)(s0 + 4 * k4), kq = *(const f32x4*)(rec + 256 + 16 * k4);
                sa -= (v[0] * kq[0] + v[1] * kq[1]) + (v[2] * kq[2] + v[3] * kq[3]); }
            const float vv = bf2f(*(const unsigned short*)(rec + 1024 + 2 * lane));
            float o = 0.f, cb = 0.f;
#pragma unroll 4
            for (int k4 = 0; k4 < 16; ++k4) {
                f32x4 v = *(const f32x4*)(s0 + 4 * k4); const f32x4 w = *(const f32x4*)(rec + 16 * k4), bb = *(const f32x4*)(rec + 512 + 16 * k4), rk4 = *(const f32x4*)(rkp + h * 64 + 4 * k4);
                const u32x4 rk = *(const u32x4*)(rec + 768 + 16 * k4);
                const float rr[4] = {bflo(rk.x), bfhi(rk.x), bflo(rk.y), bfhi(rk.y)}, kx[4] = {bflo(rk.z), bfhi(rk.z), bflo(rk.w), bfhi(rk.w)};
#pragma unroll
                for (int e = 0; e < 4; ++e) { v[e] = v[e] * w[e] + (sa * bb[e] + vv * kx[e]); o += v[e] * rr[e]; cb += rr[e] * kx[e] * rk4[e]; }
                *(f32x4*)(s1 + 4 * k4) = v; }
            const float mean = wave_sum(o) * (1.f / 64.f), d = o - mean, var = wave_sum(d * d) * (1.f / 64.f);
            const float gn = d * rsqrtf(var + 64e-5f) * lnw[h * 64 + lane] + lnb[h * 64 + lane];
            const float gg = bf2f(G[(size_t)row * 384 + h * 64 + lane]);
            mix[(size_t)row * DM + h * 64 + lane] = f2bf((gn + cb * vv) * gg);
        } else if (it < 1536) {
            const int i = (it - 768) / 6, h = (it - 768) % 6, row = MP + i;
            const bf16* pr = P + (size_t)row * NP + 1408 + h * 64;
            const float* s0 = a.in[I_SHGRN] + (size_t)((l * 128 + i) * 6 + h) * 4096 + lane;
            float* s1 = a.out + O_SHGRN + (size_t)((l * 128 + i) * 6 + h) * 4096 + lane;
            const float* lbt = (const float*)(ws + WS_LBT) + l * 384 + h * 64;
            const float iv = bf2f(pr[768 + lane]); float o = 0.f;
#pragma unroll 8
            for (int k = 0; k < 64; ++k) { const float q = bf2f(pr[k]), fp = bf2f(pr[384 + k]), lb = lbt[k];
                const float f = lb + (1.f - lb) * sigm(fp), ki = (1.f - lb) * sigm(-fp);
                const float s = f * s0[k * 64] + ki * iv; s1[k * 64] = s; o += q * s; }
            const float ss = wave_sum(o * o), gte = bf2f(pr[1152 + lane]);
            mix[(size_t)row * DM + 384 + h * 64 + lane] = f2bf(o * rsqrtf(ss * (1.f / 64.f) + EPS) * a.in[I_HNG][l * 384 + h * 64 + lane] * (gte * sigm(gte)));
        } else {
            const int i = it - 1536, row = MP + i;
#pragma unroll
            for (int q = 0; q < 4; ++q) { const int c = lane + 64 * q;
                const float la = bf2f(((const bf16*)(ws + WS_LA))[(size_t)row * 256 + c]), u = bf2f(((const bf16*)(ws + WS_LU))[(size_t)row * 256 + c]);
                const float hh = __expf(la) * a.in[I_SLRU][(size_t)(l * 128 + i) * 256 + c] + u;
                a.out[O_SLRU + (size_t)(l * 128 + i) * 256 + c] = hh;
                mix[(size_t)row * DM + 768 + c] = f2bf(hh * gelu_t(bf2f(P[(size_t)row * NP + 3200 + c]))); }
        }
    }
    if (l + 1 < 4) {
        __syncthreads();
        LAS float* scr = (LAS float*)(lds + wave * 8448);
        int it = gw;
        transpose_job(a.in[I_WIN] + (size_t)(l + 1) * DM * 3456, DM, 3456, (bf16*)(ws + WS_WTIN), it, NGW, scr, lane);
    }
}

DEV void phase_final(const Args& a) {
    const int tid = otid(), lane = tid & 63, wave = tid >> 6;
    const int gw = blockIdx.x * NWV + wave, NGW = gridDim.x * NWV;
    const float* rss = (const float*)(a.ws + WS_RSE);
    const f32x4* g4 = (const f32x4*)a.in[I_FG];
    for (int row = gw; row < MREAL; row += NGW) {
        const f32x4* src = (const f32x4*)(row < MP ? a.out + (size_t)row * DM : (const float*)(a.ws + WS_XS) + (size_t)(row - MP) * DM);
        f32x4* dst = (f32x4*)(a.out + (size_t)row * DM);
        const float s = row_scale(rss, row);
#pragma unroll
        for (int j = 0; j < 4; ++j) { const f32x4 v = src[lane + 64 * j], g = g4[lane + 64 * j]; dst[lane + 64 * j] = (f32x4){v[0] * s * g[0], v[1] * s * g[1], v[2] * s * g[2], v[3] * s * g[3]}; }
    }
}

constexpr size_t WS_PART = 232 * MiB;
struct EpiPart {
    static constexpr bool PERM = false, AFTER_DRAIN = false;
    float* O;
    DEV void operator()(const pg8::f32x4 (&acc)[2][2][4][2], const pg8::Unit& u, int wr, int wc, int fr, int fq) const {
        const int col0 = u.pn * 256 + wc * 32 + 4 * fq;
#pragma unroll
        for (int m = 0; m < 4; ++m) { const int row = wr * 64 + fr + m * 16;
            float* rp_ = O + (size_t)row * DM + col0;
#pragma unroll
            for (int bj = 0; bj < 2; ++bj)
#pragma unroll
                for (int n = 0; n < 2; ++n) { const pg8::f32x4 v = acc[0][bj][m][n]; *(f32x4*)(rp_ + bj * 128 + n * 16) = (f32x4){v[0], v[1], v[2], v[3]}; } }
    }
};
struct OneUnit {
    int pn;
    DEV bool next(int i, pg8::Unit& u) const { if (i) return false; u.pm = 0; u.pn = pn; return true; }
    DEV void a_ready(const pg8::Unit&) const {}
    DEV void done(const pg8::Unit&) const {}
};
DEV void phase_sample_reduce(const Args& a, bf16* U, const float* g, float* rs) {
    const int tid = otid(), lane = tid & 63, wave = tid >> 6;
    const int gw = blockIdx.x * NWV + wave;
    if (gw >= 128) return;
    const float* part = (const float*)(a.ws + WS_PART);
    f32x4* xr = (f32x4*)((float*)(a.ws + WS_XS) + (size_t)gw * DM);
    u32x2* ud = (u32x2*)(U + (size_t)(MP + gw) * DM);
    const f32x4* g4 = (const f32x4*)g;
    float ss = 0.f;
#pragma unroll
    for (int j = 0; j < 4; ++j) { const int o = lane + 64 * j;
        f32x4 x = xr[o];
        const f32x4 p0 = ((const f32x4*)(part + (size_t)(0 * 128 + gw) * DM))[o], p1 = ((const f32x4*)(part + (size_t)(1 * 128 + gw) * DM))[o],
                    p2 = ((const f32x4*)(part + (size_t)(2 * 128 + gw) * DM))[o], p3 = ((const f32x4*)(part + (size_t)(3 * 128 + gw) * DM))[o];
#pragma unroll
        for (int e = 0; e < 4; ++e) x[e] += (p0[e] + p1[e]) + (p2[e] + p3[e]);
        xr[o] = x; ss += (x[0] * x[0] + x[1] * x[1]) + (x[2] * x[2] + x[3] * x[3]);
        const f32x4 gv = g4[o]; u32x2 w; w.x = pk2(x[0] * gv[0], x[1] * gv[1]); w.y = pk2(x[2] * gv[2], x[3] * gv[3]); ud[o] = w; }
    ss = wave_sum(ss);
    if (lane < 16) rs[(size_t)(MP + gw) * 16 + lane] = lane == 0 ? ss : 0.f;
}

#define XB_TMO      128
#define XB_XCNT(j)  (256  + 64 * (j))
#define XB_XSUB(j)  (1280 + 64 * (j))
#define XB_XGEN(j)  (2304 + 64 * (j))
#define XB_TOP      3328
#define XB_TOPGEN   3392
#define XCD_BAR_WORDS 3456
#define XB_SPIN_CAP (1u << 22)

__device__ __forceinline__ unsigned xb_ld(unsigned* p)              { return __hip_atomic_load(p, __ATOMIC_RELAXED, __HIP_MEMORY_SCOPE_AGENT); }
__device__ __forceinline__ unsigned xb_add(unsigned* p, unsigned v) { return __hip_atomic_fetch_add(p, v, __ATOMIC_RELAXED, __HIP_MEMORY_SCOPE_AGENT); }
__device__ __forceinline__ unsigned xb_xcc_id() { return (unsigned)__builtin_amdgcn_s_getreg((3 << 11) | 20) & 0xFu; }
#define XB_SPIN(cond, bar) do { unsigned _sp = 0; while (cond) { __builtin_amdgcn_s_sleep(1); \
    if ((++_sp & 255u) == 0u) { if (xb_ld(&(bar)[XB_TMO])) break; if (_sp > XB_SPIN_CAP) { atomicAdd(&(bar)[XB_TMO], 1u); break; } } } } while (0)

struct XcdBarrier {
    unsigned* bar; unsigned x;
    volatile LAS unsigned* st;
};

__device__ __forceinline__ XcdBarrier xcd_barrier_post(unsigned* bar, volatile LAS unsigned* st) {
    XcdBarrier b; b.bar = bar; b.x = xb_xcc_id(); b.st = st;
    if (threadIdx.x == 0) (void)xb_add(&bar[XB_XCNT(b.x)], 1u);
    return b;
}
__device__ __forceinline__ void xcd_barrier_complete(unsigned* bar, unsigned x, unsigned& nloc, unsigned& nx) {
    const unsigned G = gridDim.x * gridDim.y * gridDim.z;
    unsigned sum, cnt, mine, sp = 0u;
    for (;;) {
        sum = 0u; cnt = 0u; mine = 0u;
#pragma unroll
        for (unsigned j = 0; j < 16; ++j) { const unsigned c = xb_ld(&bar[XB_XCNT(j)]); sum += c; cnt += (c > 0u) ? 1u : 0u; mine = (j == x) ? c : mine; }
        if (sum == G) break;
        __builtin_amdgcn_s_sleep(1);
        if ((++sp & 255u) == 0u) { if (xb_ld(&bar[XB_TMO])) break; if (sp > XB_SPIN_CAP) { atomicAdd(&bar[XB_TMO], 1u); break; } }
    }
    nloc = mine > 0u ? mine : 1u; nx = cnt > 0u ? cnt : 1u;
}

__device__ __forceinline__ void xcd_barrier(const XcdBarrier& b) {
    asm volatile("s_waitcnt vmcnt(0)" ::: "memory");
    __syncthreads();
    if (otid() == 0) {
        unsigned* bar = b.bar;
        __builtin_amdgcn_s_waitcnt(0);
        unsigned nloc = b.st[0], nx = b.st[1];
        if (nloc == 0u) { xcd_barrier_complete(bar, b.x, nloc, nx); b.st[0] = nloc; b.st[1] = nx; }
        const unsigned old = xb_add(&bar[XB_XSUB(b.x)], 1u);
        const unsigned gen = old / nloc;
        if (old + 1u == (gen + 1u) * nloc) {
            __builtin_amdgcn_fence(__ATOMIC_RELEASE, "agent");
            asm volatile("s_waitcnt vmcnt(0)" ::: "memory");
            const unsigned og = xb_add(&bar[XB_TOP], 1u);
            const unsigned tg = og / nx;
            if (og + 1u == (tg + 1u) * nx) xb_add(&bar[XB_TOPGEN], 1u);
            else XB_SPIN(xb_ld(&bar[XB_TOPGEN]) == tg, bar);
            __builtin_amdgcn_fence(__ATOMIC_ACQUIRE, "agent");
            xb_add(&bar[XB_XGEN(b.x)], 1u);
            asm volatile("s_waitcnt vmcnt(0)" ::: "memory");
        } else {
            XB_SPIN(xb_ld(&bar[XB_XGEN(b.x)]) == gen, bar);
            __builtin_amdgcn_fence(__ATOMIC_ACQUIRE, "agent");
            asm volatile("s_waitcnt vmcnt(0)" ::: "memory");
        }
    }
    __syncthreads();
}

__global__ void __launch_bounds__(NT, 2) mega_fwd(Args a) {
    extern __shared__ __attribute__((aligned(16))) unsigned char lds_raw[];
    LAS unsigned char* lds = (LAS unsigned char*)lds_raw;
    cg::grid_group grid = cg::this_grid();
    volatile LAS unsigned* st = (volatile LAS unsigned*)(lds + LDS_BYTES - 16);
    if (threadIdx.x < 4) st[threadIdx.x] = 0u;
    __syncthreads();
    { const XcdBarrier b0 = xcd_barrier_post((unsigned*)(a.ws + WS_BAR), st); if (threadIdx.x == 0) st[2] = b0.x; }
#define GRID_BAR() do { XcdBarrier b_; b_.bar = (unsigned*)(a.ws + WS_BAR); b_.st = (volatile LAS unsigned*)(lds + LDS_BYTES - 16); b_.x = otid() == 0 ? b_.st[2] : 0u; xcd_barrier(b_); } while (0)
    grid.sync();
#ifndef SK_P0
    phase0(a, lds);
#endif
    GRID_BAR();
#pragma unroll 1
    for (int l = 0; l < 4; ++l) {
#define Ua ((bf16*)(a.ws + ((l & 1) ? WS_U1 : WS_U0)))
#define Ub ((bf16*)(a.ws + ((l & 1) ? WS_U0 : WS_U1)))
#define rse ((float*)(a.ws + WS_RSE))
#define rso ((float*)(a.ws + WS_RSO))
        {
            pg8::Gemm g{Ua, (const bf16*)(a.ws + WS_WTIN), MT, NP, DM}; pg8::StaticOrder S; S.init(MT, NP, gridDim.x, oblk());
            EpiP E{(bf16*)(a.ws + WS_P), rse};
#ifndef SK_G1
            pg8::gemm_phase<EpiP, pg8::StaticOrder, true, true>(lds, g, S, E);
#ifdef DUP_G1
            GRID_BAR(); pg8::gemm_phase<EpiP, pg8::StaticOrder, true, true>(lds, g, S, E);
#endif
#endif
        }
        GRID_BAR();
#ifndef SK_PREP
#ifdef OLD_FIRST
        phase_prep_old(a, l, lds); GRID_BAR();
#endif
#ifdef ONLY_OLD
        phase_prep_old(a, l, lds);
#else
        phase_prep(a, l, lds);
#endif
#ifdef OLD_AFTER
        GRID_BAR(); phase_prep_old(a, l, lds);
#endif
#ifdef DUP_PREP
        GRID_BAR(); phase_prep(a, l, lds, false);
#endif
#endif
        GRID_BAR();
#ifndef SK_RWKV
        if (oblk() < 192) rwkv_scan_block(a, l, oblk(), lds);
#endif
#ifndef SK_HGRN
        if (oblk() >= 192 && oblk() < 240) hgrn_scan_block(a, l, oblk() - 192, lds);
#endif
#ifndef SK_LRU
        if (oblk() >= 240) lru_scan_block(a, l, oblk() - 240, lds);
#endif
#ifdef DUP_RWKV
        GRID_BAR(); if (oblk() < 192) rwkv_scan_block(a, l, oblk(), lds);
#endif
#ifdef DUP_HGRN
        GRID_BAR(); if (oblk() >= 192 && oblk() < 240) hgrn_scan_block(a, l, oblk() - 192, lds);
#endif
#ifdef DUP_LRU
        GRID_BAR(); if (oblk() >= 240) lru_scan_block(a, l, oblk() - 240, lds);
#endif
        GRID_BAR();
#ifndef SK_POST
        phase_post(a, l, lds);
#ifdef DUP_POST
        GRID_BAR(); phase_post(a, l, lds);
#endif
#endif
        GRID_BAR();
        {
            pg8::Gemm g{Ub, (const bf16*)(a.ws + WS_WTOUT), MT, DM, DM}; pg8::StaticOrder S; S.init(MT, DM, gridDim.x, oblk());
            EpiX E{a.out, (float*)(a.ws + WS_XS), Ua, a.in[I_N2G] + l * DM, rso};
#ifndef SK_GX
            pg8::gemm_phase<EpiX, pg8::StaticOrder, true, true, 64>(lds, g, S, E);
#endif
        }
        GRID_BAR();
        {
            pg8::Gemm g{Ua, (const bf16*)(a.ws + WS_WT1), MT, FF, DM}; pg8::StaticOrder S; S.init(MT, FF, gridDim.x, oblk());
            EpiH E{(bf16*)(a.ws + WS_H), rso};
#ifndef SK_G6
            pg8::gemm_phase<EpiH, pg8::StaticOrder, true, true, 64>(lds, g, S, E);
#ifdef DUP_G6
            GRID_BAR(); pg8::gemm_phase<EpiH, pg8::StaticOrder, true, true, 64>(lds, g, S, E);
#endif
#endif
        }
        GRID_BAR();
        {
            pg8::Gemm g{(const bf16*)(a.ws + WS_H), (const bf16*)(a.ws + WS_WT2), MP, DM, FF}; pg8::StaticOrder S; S.init(MP, DM, gridDim.x, oblk());
            EpiX E{a.out, (float*)(a.ws + WS_XS), Ub, l < 3 ? a.in[I_N1G] + (l + 1) * DM : a.in[I_FG], rse};
#ifndef SK_GX
            pg8::gemm_phase<EpiX, pg8::StaticOrder, true, true, 64>(lds, g, S, E);
#endif
            if (oblk() < 16) {
                const int ks = oblk() >> 2;
                pg8::Gemm g2{(const bf16*)(a.ws + WS_H) + (size_t)MP * FF + ks * 1024, (const bf16*)(a.ws + WS_WT2) + ks * 1024, 256, DM, 1024, FF};
                OneUnit S2{oblk() & 3}; EpiPart E2{(float*)(a.ws + WS_PART) + (size_t)ks * 128 * DM};
                pg8::gemm_phase<EpiPart, OneUnit, true, true, 0>(lds, g2, S2, E2);
            }
        }
        GRID_BAR();
        phase_sample_reduce(a, Ub, l < 3 ? a.in[I_N1G] + (l + 1) * DM : a.in[I_FG], rse);
        GRID_BAR();
    }
    phase_final(a);
}

extern "C" void kernel_launch(void* const* d_in, const int* in_sizes, int n_in, void* d_out, int out_size, void* d_ws, size_t ws_size, hipStream_t stream) {
    static int grid = 0;
    if (grid == 0) {
        int dev = 0, cus = 0;
        if (n_in != N_IN || ws_size < WS_END || out_size != 44761088) { fprintf(stderr, "kernel_launch: unexpected problem: n_in %d ws %zu (need %zu) out %d\n", n_in, ws_size, (size_t)WS_END, out_size); grid = -1; return; }
        if (hipGetDevice(&dev) != hipSuccess || hipDeviceGetAttribute(&cus, hipDeviceAttributeMultiprocessorCount, dev) != hipSuccess) { grid = -1; return; }
        if (hipFuncSetAttribute((const void*)mega_fwd, hipFuncAttributeMaxDynamicSharedMemorySize, LDS_BYTES) != hipSuccess) { fprintf(stderr, "kernel_launch: hipFuncSetAttribute failed\n"); grid = -1; return; }
        if (cus != 256) fprintf(stderr, "kernel_launch: %d CUs (built for 256)\n", cus);
        grid = 256;
    }
    if (grid < 0) return;
#ifdef DBG_POISON
    (void)hipMemsetAsync(d_ws, 0xAA, WS_END, stream); (void)hipMemsetAsync(d_out, 0xAA, (size_t)out_size * 4, stream);
#endif
    if (hipMemsetAsync((char*)d_ws + WS_BAR, 0, BAR_BYTES, stream) != hipSuccess) { fprintf(stderr, "kernel_launch: memset failed\n"); return; }
    Args a{};
    for (int i = 0; i < N_IN; ++i) a.in[i] = (const float*)d_in[i];
    a.out = (float*)d_out; a.ws = (unsigned char*)d_ws;
    void* args[] = {&a};
    hipError_t e = hipLaunchCooperativeKernel((const void*)mega_fwd, dim3(grid), dim3(NT), args, LDS_BYTES, stream);
    if (e != hipSuccess) fprintf(stderr, "kernel_launch: cooperative launch failed: %s\n", hipGetErrorString(e));
}
```

```cpp
#include <hip/hip_runtime.h>
#include <hip/hip_cooperative_groups.h>
#include <cstdio>
#include <cstdint>
namespace cg = cooperative_groups;
namespace pg8 {
#define PG8_LAS __attribute__((address_space(3)))
typedef unsigned short bf16_t;
typedef short bf16x8 __attribute__((ext_vector_type(8)));
typedef float f32x4 __attribute__((ext_vector_type(4)));
typedef unsigned u32x4 __attribute__((ext_vector_type(4)));
constexpr int BM = 256, BK = 64, HALF = 128, HTB = HALF * BK * 2  , STAGE_BYTES = 8 * HTB, NXCD = 8, WGM = 8;

__host__ __device__ __forceinline__ int lds_byte(int r, int c) { const int st = (r >> 4) * 2 + (c >> 5), rr = r & 15, cc = c & 31, ob = rr * 64 + cc * 2; return st * 1024 + (ob ^ (((ob >> 9) & 1) << 5)); }
__host__ __device__ __forceinline__ void stage_rc(int b, int& R, int& C) { const int st = b / 1024, sb = b % 1024, swz = sb ^ (((sb >> 9) & 1) << 5); R = (st >> 1) * 16 + swz / 64; C = (st & 1) * 32 + (swz % 64) / 2; }
__host__ __device__ __forceinline__ int perm32(int rho) { const int n = rho >> 4, i = rho & 15; return 8 * (i >> 2) + 4 * n + (i & 3); }

struct Unit { int pm, pn; };
struct Gemm { const bf16_t* A; const bf16_t* Bt; int M, N, K; int ld = 0; };

struct StaticOrder {
    int nM, nN, nwg, G, c;
    __host__ __device__ void init(int M, int N, int G_, int c_) { nM = M / BM; nN = N / BM; nwg = nM * nN; G = G_; c = c_; }
    __host__ __device__ bool next(int i, Unit& u) const {
        const long L = (long)i * G + c; if (L >= nwg) return false;
        int wgid = (int)L; { const int q = nwg / NXCD, r = nwg % NXCD, xcd = wgid % NXCD, off = wgid / NXCD; wgid = (xcd < r ? xcd * (q + 1) : r * (q + 1) + (xcd - r) * q) + off; }
        const int nig = WGM * nN, gid = wgid / nig, fm = gid * WGM, gsz = (nM - fm) < WGM ? (nM - fm) : WGM;
        u.pm = fm + ((wgid % nig) % gsz); u.pn = (wgid % nig) / gsz; return true;
    }
    __device__ __forceinline__ void a_ready(const Unit&) const {}
    __device__ __forceinline__ void done(const Unit&) const {}
};

__device__ __forceinline__ unsigned cvt_pk_bf16(float lo, float hi) { unsigned r; asm volatile("v_cvt_pk_bf16_f32 %0, %1, %2" : "=v"(r) : "v"(lo), "v"(hi)); return r; }
typedef float f32x2 __attribute__((ext_vector_type(2)));
template <class Epi, class Sched, bool ALIGN_EPI = false, bool SP2 = false, int HALF_PM = -1>
__device__ __forceinline__ void gemm_phase(PG8_LAS unsigned char* lds, const Gemm g, const Sched& S, const Epi& E) {
    int tid_ = threadIdx.x; asm volatile("" : "+v"(tid_)); const int tid = tid_, wid = __builtin_amdgcn_readfirstlane(tid >> 6), lane = tid & 63, wr = wid >> 2, wc = wid & 3, fr = lane & 15, fq = lane >> 4;
    const int K = g.K, nt = K / BK, LD = g.ld ? g.ld : g.K;
    unsigned voffA[2], voffB[2];
#pragma unroll
    for (int i = 0; i < 2; ++i) { int R, C; stage_rc(tid * 16 + i * 8192, R, C); const int Rb = Epi::PERM ? ((R & ~31) + perm32(R & 31)) : R;
        voffA[i] = (unsigned)(R * LD + C) * 2u; voffB[i] = (unsigned)(Rb * LD + C) * 2u; }
    const size_t kstep = (size_t)(BK * 2);
    const size_t hstep = (size_t)HALF * LD * 2;
    const size_t tstep = 2 * hstep;
    const unsigned ldsw = (unsigned)wid * 1024u;
    const int aoff = lds_byte(wr * 64 + fr, fq * 8), boff = lds_byte(wc * 32 + fr, fq * 8);
#define PG8_SA(b, h) (((b) * 2 + (h)) * HTB)
#define PG8_SB(b, h) ((4 + (b) * 2 + (h)) * HTB)
#define PG8_STAGE(bufoff, gbase, voff) do { _Pragma("unroll") for (int _i = 0; _i < 2; ++_i) \
        __builtin_amdgcn_global_load_lds((const unsigned*)((const char*)(gbase) + (voff)[_i]), (PG8_LAS unsigned*)(lds + (bufoff) + ldsw + _i * 8192), 16, 0, 0); } while (0)
#define PG8_LDA(dst, b, h) do { _Pragma("unroll") for (int m = 0; m < 4; ++m) _Pragma("unroll") for (int k = 0; k < 2; ++k) dst[m][k] = *(const PG8_LAS bf16x8*)(lds + PG8_SA(b, h) + aoff + m * 2048 + k * 1024); } while (0)
#define PG8_LDB(dst, b, h) do { _Pragma("unroll") for (int n = 0; n < 2; ++n) _Pragma("unroll") for (int k = 0; k < 2; ++k) dst[n][k] = *(const PG8_LAS bf16x8*)(lds + PG8_SB(b, h) + boff + n * 2048 + k * 1024); } while (0)
#define PG8_MMA(ai, bj, At, Bt) do { __builtin_amdgcn_s_setprio(1); _Pragma("unroll") for (int m = 0; m < 4; ++m) _Pragma("unroll") for (int n = 0; n < 2; ++n) _Pragma("unroll") for (int k = 0; k < 2; ++k) \
        acc[ai][bj][m][n] = __builtin_amdgcn_mfma_f32_16x16x32_bf16(Bt[n][k], At[m][k], acc[ai][bj][m][n], 0, 0, 0); __builtin_amdgcn_s_setprio(0); } while (0)
#define PG8_WAIT_V(n) asm volatile("s_waitcnt vmcnt(" #n ")" ::: "memory")
#define PG8_WAIT_L(n) asm volatile("s_waitcnt lgkmcnt(" #n ")" ::: "memory")
#define PG8_BAR __builtin_amdgcn_s_barrier()
#define PG8_SCHED __builtin_amdgcn_sched_barrier(0)
    Unit cur, nxt; int ui = 0;
    if (!S.next(0, cur)) return;
    f32x4 acc[2][2][4][2];
#pragma unroll
    for (int a = 0; a < 2; ++a)
#pragma unroll
        for (int b = 0; b < 2; ++b)
#pragma unroll
            for (int m = 0; m < 4; ++m)
#pragma unroll
                for (int n = 0; n < 2; ++n) acc[a][b][m][n] = (f32x4){0.f, 0.f, 0.f, 0.f};
    bf16x8 At[4][2], B0[2][2], B1[2][2];
    const char* cA = (const char*)g.A + (size_t)cur.pm * tstep; const char* cB = (const char*)g.Bt + (size_t)cur.pn * tstep;
    S.a_ready(cur);
    if constexpr (SP2) {
        PG8_STAGE(PG8_SB(0, 0), cB, voffB); PG8_STAGE(PG8_SB(0, 1), cB + hstep, voffB); PG8_STAGE(PG8_SA(0, 0), cA, voffA); PG8_STAGE(PG8_SA(0, 1), cA + hstep, voffA);
        if (wr == 1) PG8_BAR;
        PG8_WAIT_V(2); PG8_BAR;
        PG8_STAGE(PG8_SB(1, 0), cB + kstep, voffB); PG8_STAGE(PG8_SA(1, 0), cA + kstep, voffA); PG8_STAGE(PG8_SB(1, 1), cB + hstep + kstep, voffB);
        PG8_WAIT_V(6); PG8_BAR;
    } else {
        PG8_STAGE(PG8_SB(0, 0), cB, voffB); PG8_STAGE(PG8_SA(0, 0), cA, voffA); PG8_STAGE(PG8_SB(0, 1), cB + hstep, voffB); PG8_STAGE(PG8_SA(0, 1), cA + hstep, voffA);
        if (wr == 1) PG8_BAR;
        PG8_WAIT_V(4); PG8_BAR;
        PG8_STAGE(PG8_SB(1, 0), cB + kstep, voffB); PG8_STAGE(PG8_SA(1, 0), cA + kstep, voffA); PG8_STAGE(PG8_SB(1, 1), cB + hstep + kstep, voffB);
        PG8_WAIT_V(6); PG8_BAR;
    }
    for (;;) {
        const bool has_next = S.next(ui + 1, nxt);
        const char* nA = has_next ? (const char*)g.A + (size_t)nxt.pm * tstep : cA; const char* nB = has_next ? (const char*)g.Bt + (size_t)nxt.pn * tstep : cB;
        for (int t = 0; t < nt; t += 2) {
            const bool last = (t == nt - 2);
            const char* a1 = cA + (size_t)(t + 1) * kstep;
            const char* a2 = last ? nA : cA + (size_t)(t + 2) * kstep; const char* b2 = last ? nB : cB + (size_t)(t + 2) * kstep;
            const char* a3 = a2 + kstep; const char* b3 = b2 + kstep;
            if (last && has_next) S.a_ready(nxt);
            if constexpr (SP2) {
            PG8_LDB(B0, 0, 0); PG8_LDB(B1, 0, 1); PG8_SCHED; PG8_LDA(At, 0, 0); PG8_STAGE(PG8_SA(1, 1), a1 + hstep, voffA);
            PG8_WAIT_V(8); PG8_WAIT_L(0); PG8_BAR; PG8_MMA(0, 0, At, B0); PG8_MMA(0, 1, At, B1); PG8_BAR; PG8_SCHED;
            PG8_LDA(At, 0, 1); PG8_STAGE(PG8_SB(0, 0), b2, voffB); PG8_STAGE(PG8_SB(0, 1), b2 + hstep, voffB); PG8_STAGE(PG8_SA(0, 0), a2, voffA);
            PG8_WAIT_V(8); PG8_WAIT_L(0); PG8_BAR; if (cur.pm != HALF_PM) { PG8_MMA(1, 0, At, B0); PG8_MMA(1, 1, At, B1); } PG8_BAR; PG8_SCHED;
            PG8_LDB(B0, 1, 0); PG8_LDB(B1, 1, 1); PG8_SCHED; PG8_LDA(At, 1, 0); PG8_STAGE(PG8_SA(0, 1), a2 + hstep, voffA);
            PG8_WAIT_V(8); PG8_WAIT_L(0); PG8_BAR; PG8_MMA(0, 0, At, B0); PG8_MMA(0, 1, At, B1); PG8_BAR; PG8_SCHED;
            PG8_LDA(At, 1, 1); PG8_STAGE(PG8_SB(1, 0), b3, voffB); PG8_STAGE(PG8_SB(1, 1), b3 + hstep, voffB); PG8_STAGE(PG8_SA(1, 0), a3, voffA);
            PG8_WAIT_V(8); PG8_WAIT_L(0); PG8_BAR; if (cur.pm != HALF_PM) { PG8_MMA(1, 0, At, B0); PG8_MMA(1, 1, At, B1); } PG8_BAR; PG8_SCHED;
            } else {
            PG8_LDB(B0, 0, 0); PG8_SCHED; PG8_LDA(At, 0, 0); PG8_STAGE(PG8_SA(1, 1), a1 + hstep, voffA);
            PG8_WAIT_L(8); PG8_BAR; PG8_WAIT_L(0); PG8_MMA(0, 0, At, B0); PG8_BAR; PG8_SCHED;
            PG8_LDB(B1, 0, 1); PG8_STAGE(PG8_SB(0, 0), b2, voffB);
            PG8_BAR; PG8_WAIT_L(0); PG8_MMA(0, 1, At, B1); PG8_BAR;
            PG8_LDA(At, 0, 1); PG8_STAGE(PG8_SA(0, 0), a2, voffA);
            PG8_BAR; PG8_WAIT_L(0); PG8_MMA(1, 0, At, B0); PG8_BAR; PG8_SCHED;
            PG8_STAGE(PG8_SB(0, 1), b2 + hstep, voffB);
            PG8_WAIT_V(6); PG8_BAR; PG8_MMA(1, 1, At, B1); PG8_BAR;
            PG8_LDB(B0, 1, 0); PG8_SCHED; PG8_LDA(At, 1, 0); PG8_STAGE(PG8_SA(0, 1), a2 + hstep, voffA);
            PG8_WAIT_L(8); PG8_BAR; PG8_WAIT_L(0); PG8_MMA(0, 0, At, B0); PG8_BAR; PG8_SCHED;
            PG8_LDB(B1, 1, 1); PG8_STAGE(PG8_SB(1, 0), b3, voffB);
            PG8_BAR; PG8_WAIT_L(0); PG8_MMA(0, 1, At, B1); PG8_BAR;
            PG8_LDA(At, 1, 1); PG8_STAGE(PG8_SA(1, 0), a3, voffA);
            PG8_BAR; PG8_WAIT_L(0); PG8_MMA(1, 0, At, B0); PG8_BAR; PG8_SCHED;
            PG8_STAGE(PG8_SB(1, 1), b3 + hstep, voffB);
            PG8_WAIT_V(6); PG8_BAR; PG8_MMA(1, 1, At, B1); PG8_BAR;
            }
        }
        if constexpr (ALIGN_EPI) { if (wr == 0) PG8_BAR; }
        if constexpr (!Epi::AFTER_DRAIN) { E(acc, cur, wr, wc, fr, fq); S.done(cur); }
        if (!has_next) break;
#pragma unroll
        for (int a = 0; a < 2; ++a)
#pragma unroll
            for (int b = 0; b < 2; ++b)
#pragma unroll
                for (int m = 0; m < 4; ++m)
#pragma unroll
                    for (int n = 0; n < 2; ++n) acc[a][b][m][n] = (f32x4){0.f, 0.f, 0.f, 0.f};
        cur = nxt; cA = nA; cB = nB; ++ui;
        if constexpr (ALIGN_EPI) { if (wr == 1) PG8_BAR; }
    }
    PG8_WAIT_V(0);
    if constexpr (!ALIGN_EPI) { if (wr == 0) PG8_BAR; }
    PG8_BAR;
    if constexpr (Epi::AFTER_DRAIN) { E.fused(acc, cur, wr, wc, fr, fq, lds, wid, lane); S.done(cur); }
#undef PG8_SA
#undef PG8_SB
#undef PG8_STAGE
#undef PG8_LDA
#undef PG8_LDB
#undef PG8_MMA
#undef PG8_WAIT_V
#undef PG8_WAIT_L
#undef PG8_BAR
#undef PG8_SCHED
}
}
#define DEV __device__ __forceinline__
#define LAS __attribute__((address_space(3)))
typedef unsigned short bf16;
typedef float f32x4 __attribute__((ext_vector_type(4)));
typedef unsigned u32x4 __attribute__((ext_vector_type(4)));
typedef unsigned u32x2 __attribute__((ext_vector_type(2)));
typedef short bf16x8 __attribute__((ext_vector_type(8)));

constexpr int NT = 512, NWV = 8;
constexpr int DM = 1024, NP = 3584, FF = 4096;
constexpr int MP = 16384, MREAL = 16512, MT = 16640, TT = 2048;
constexpr int REC = 1152;
constexpr float EPS = 1e-6f;
constexpr size_t MiB = 1u << 20;
constexpr size_t WS_RSS = 0;
constexpr size_t WS_LBT = 640 * 1024, WS_BAR = 704 * 1024, BAR_BYTES = 16384;
constexpr size_t WS_WTIN = 1 * MiB, WS_WTOUT = 8 * MiB, WS_WT1 = 10 * MiB, WS_WT2 = 18 * MiB, WS_WLORA = 26 * MiB;
constexpr size_t WS_XS = 27 * MiB, WS_U0 = 28 * MiB, WS_U1 = 61 * MiB, WS_P = 94 * MiB, WS_SCAN = 208 * MiB, WS_SCANS = 316 * MiB;
constexpr size_t WS_H = 94 * MiB;
constexpr size_t WS_OUTR = 317 * MiB, WS_G = 329 * MiB, WS_LA = 342 * MiB, WS_LU = 351 * MiB, WS_RSE = 360 * MiB, WS_RSO = 360 * MiB + 1280 * 1024, WS_END = 360 * MiB + 2560 * 1024;
DEV float row_scale(const float* rs, int row) { const f32x4* p = (const f32x4*)(rs + (size_t)row * 16); const f32x4 a = p[0], b = p[1], c = p[2], d = p[3];
    const float t = ((a[0] + a[1]) + (a[2] + a[3])) + ((b[0] + b[1]) + (b[2] + b[3])) + (((c[0] + c[1]) + (c[2] + c[3])) + ((d[0] + d[1]) + (d[2] + d[3])));
    return rsqrtf(t * (1.f / 1024.f) + 1e-6f); }
static_assert(WS_P + (size_t)MT * NP * 2 <= WS_SCAN && WS_SCAN + (size_t)MP * 6 * REC <= WS_SCANS && WS_H + (size_t)MT * FF * 2 <= WS_SCANS, "ws map");
static_assert(WS_U0 + (size_t)MT * DM * 2 <= WS_U1 && WS_U1 + (size_t)MT * DM * 2 <= WS_P, "ws map 2");
constexpr int WL_STRIDE = 131072, WL_AUP = 24576, WL_GUP = 49152, WL_WA = 98304, WL_WX = 114688;
constexpr size_t O_YP = 0, O_YS = 16777216, O_PWKV = 16908288, O_PSHIFT = 17694720, O_PHGRN = 17727488, O_PLRU = 18513920, O_PCONV = 18522112,
                 O_SWKV = 18546688, O_SSHIFT = 31129600, O_SHGRN = 31653888, O_SLRU = 44236800, O_SCONV = 44367872;
constexpr int LDS_BYTES = 147456;
enum { I_XP = 0, I_XS, I_SWKV, I_SSHIFT, I_SHGRN, I_SLRU, I_SCONV, I_N1G, I_WIN, I_MU, I_W0, I_WUP, I_A0, I_AUP, I_GUP, I_KK, I_KA, I_RK, I_LNW, I_LNB,
       I_HLB, I_HNG, I_CW, I_CB, I_WA, I_BA, I_WX, I_BX, I_LAM, I_WOUT, I_N2G, I_W1, I_W2, I_FG, N_IN };
struct Args { const float* in[N_IN]; float* out; unsigned char* ws; };

DEV int otid() { int t = threadIdx.x; asm volatile("" : "+v"(t)); return t; }
DEV int oblk() { int b = blockIdx.x; asm volatile("" : "+s"(b)); return b; }
DEV float bflo(unsigned u) { return __uint_as_float(u << 16); }
DEV float bfhi(unsigned u) { return __uint_as_float(u & 0xffff0000u); }
DEV float bf2f(unsigned short h) { return __uint_as_float((unsigned)h << 16); }
typedef __bf16 bf16x2_t __attribute__((ext_vector_type(2)));
typedef float f32x2_t __attribute__((ext_vector_type(2)));
DEV unsigned pk2(float lo, float hi) { const f32x2_t v = {lo, hi}; const bf16x2_t b = __builtin_convertvector(v, bf16x2_t); return __builtin_bit_cast(unsigned, b); }
DEV unsigned short f2bf(float f) { return (unsigned short)(pk2(f, 0.f) & 0xffffu); }
DEV float sigm(float x) { return 1.f / (1.f + __expf(-x)); }
template <int CTRL> DEV float dppf(float x) { return __builtin_bit_cast(float, __builtin_amdgcn_update_dpp(0, __builtin_bit_cast(int, x), CTRL, 0xF, 0xF, true)); }
DEV float red16(float x) { x += dppf<0xB1>(x); x += dppf<0x4E>(x); x += dppf<0x141>(x); x += dppf<0x140>(x); return x; }
DEV float rl(float x, int l) { return __builtin_bit_cast(float, __builtin_amdgcn_readlane(__builtin_bit_cast(int, x), l)); }
#ifdef WS_SHFL
DEV float wave_sum(float v) {
#pragma unroll
    for (int o = 1; o < 64; o <<= 1) v += __shfl_xor(v, o);
    return v;
}
#else
DEV float wave_sum(float v) { v = red16(v); return (rl(v, 0) + rl(v, 16)) + (rl(v, 32) + rl(v, 48)); }
#endif
DEV void unpack8(u32x4 u, float* f) { f[0] = bflo(u.x); f[1] = bfhi(u.x); f[2] = bflo(u.y); f[3] = bfhi(u.y); f[4] = bflo(u.z); f[5] = bfhi(u.z); f[6] = bflo(u.w); f[7] = bfhi(u.w); }
DEV float gelu_t(float x) { return 0.5f * x * (1.f + tanhf(0.7978845608f * (x + 0.044715f * x * x * x))); }

struct EpiP {
    static constexpr bool PERM = true, AFTER_DRAIN = false;
    bf16* O; const float* rss;
    DEV void operator()(const pg8::f32x4 (&acc)[2][2][4][2], const pg8::Unit& u, int wr, int wc, int fr, int fq) const {
        const int row0 = u.pm * 256 + wr * 64 + fr, col0 = u.pn * 256 + wc * 32 + 8 * fq;
#pragma unroll
        for (int ai = 0; ai < 2; ++ai)
#pragma unroll
            for (int m = 0; m < 4; ++m) {
                const int row = row0 + ai * 128 + m * 16;
                const float s = row < MREAL ? row_scale(rss, row) : 1.f;
                bf16* rowp = O + (size_t)row * NP + col0;
#pragma unroll
                for (int bj = 0; bj < 2; ++bj) { const pg8::f32x4 v0 = acc[ai][bj][m][0] * s, v1 = acc[ai][bj][m][1] * s;
                    u32x4 w; w.x = pk2(v0[0], v0[1]); w.y = pk2(v0[2], v0[3]); w.z = pk2(v1[0], v1[1]); w.w = pk2(v1[2], v1[3]);
                    *(u32x4*)(rowp + bj * 128) = w; }
            }
    }
};
struct EpiH {
    static constexpr bool PERM = true, AFTER_DRAIN = false;
    bf16* O; const float* rss;
    DEV void operator()(const pg8::f32x4 (&acc)[2][2][4][2], const pg8::Unit& u, int wr, int wc, int fr, int fq) const {
        const int row0 = u.pm * 256 + wr * 64 + fr, col0 = u.pn * 256 + wc * 32 + 8 * fq;
#pragma unroll
        for (int ai = 0; ai < 2; ++ai)
#pragma unroll
            for (int m = 0; m < 4; ++m) {
                const int row = row0 + ai * 128 + m * 16;
                const float s = row < MREAL ? row_scale(rss, row) : 1.f;
                bf16* rowp = O + (size_t)row * FF + col0;
#pragma unroll
                for (int bj = 0; bj < 2; ++bj) { pg8::f32x4 v0 = acc[ai][bj][m][0] * s, v1 = acc[ai][bj][m][1] * s;
#pragma unroll
                    for (int e = 0; e < 4; ++e) { const float a0 = fmaxf(v0[e], 0.f), a1 = fmaxf(v1[e], 0.f); v0[e] = a0 * a0; v1[e] = a1 * a1; }
                    u32x4 w; w.x = pk2(v0[0], v0[1]); w.y = pk2(v0[2], v0[3]); w.z = pk2(v1[0], v1[1]); w.w = pk2(v1[2], v1[3]);
                    *(u32x4*)(rowp + bj * 128) = w; }
            }
    }
};
struct EpiX {
    static constexpr bool PERM = false, AFTER_DRAIN = false;
    float* xp; float* xs; bf16* U; const float* g; float* rss;
    DEV void operator()(const pg8::f32x4 (&acc)[2][2][4][2], const pg8::Unit& u, int wr, int wc, int fr, int fq) const {
        const int row0 = u.pm * 256 + wr * 64 + fr, col0 = u.pn * 256 + wc * 32 + 4 * fq;
#pragma unroll
        for (int ai = 0; ai < 2; ++ai) {
            if (u.pm * 256 + ai * 128 >= MREAL) continue;
#pragma unroll
            for (int m = 0; m < 4; ++m) {
                const int row = row0 + ai * 128 + m * 16;
                float* xr = (row < MP ? xp + (size_t)row * DM : xs + (size_t)(row - MP) * DM) + col0;
                bf16* ur = U + (size_t)row * DM + col0;
                float ss = 0.f;
#pragma unroll
                for (int bj = 0; bj < 2; ++bj)
#pragma unroll
                    for (int n = 0; n < 2; ++n) { const int co = bj * 128 + n * 16;
                        f32x4 x = *(const f32x4*)(xr + co); const pg8::f32x4 a = acc[ai][bj][m][n];
                        x[0] += a[0]; x[1] += a[1]; x[2] += a[2]; x[3] += a[3];
                        *(f32x4*)(xr + co) = x; ss += (x[0] * x[0] + x[1] * x[1]) + (x[2] * x[2] + x[3] * x[3]);
                        const f32x4 gv = *(const f32x4*)(g + col0 + co);
                        u32x2 w; w.x = pk2(x[0] * gv[0], x[1] * gv[1]); w.y = pk2(x[2] * gv[2], x[3] * gv[3]);
                        *(u32x2*)(ur + co) = w; }
                ss += __shfl_xor(ss, 16); ss += __shfl_xor(ss, 32);
                if (fq == 0) rss[(size_t)row * 16 + u.pn * 4 + wc] = ss;
            }
        }
    }
};

DEV void transpose_item(const float* W, int K, int N, bf16* WT, int row_off, LAS float* scr, int item, int lane) {
    const int nblk = N / 32, kb = item / nblk, nb = item % nblk, k0 = 64 * kb, n0 = 32 * nb;
#pragma unroll 8
    for (int i = 0; i < 32; ++i) { const int kk = 2 * i + (lane >> 5); scr[kk * 33 + (lane & 31)] = W[(size_t)(k0 + kk) * N + n0 + (lane & 31)]; }
    asm volatile("s_waitcnt lgkmcnt(0)" ::: "memory");
    const int c = lane & 7;
#pragma unroll
    for (int j = 0; j < 4; ++j) { const int n = (lane >> 3) + 8 * j; const LAS float* s = scr + (8 * c) * 33 + n;
        u32x4 o; o.x = pk2(s[0 * 33], s[1 * 33]); o.y = pk2(s[2 * 33], s[3 * 33]); o.z = pk2(s[4 * 33], s[5 * 33]); o.w = pk2(s[6 * 33], s[7 * 33]);
        *(u32x4*)(WT + (size_t)(row_off + n0 + n) * K + k0 + 8 * c) = o; }
    asm volatile("s_waitcnt lgkmcnt(0)" ::: "memory");
}
DEV void transpose_job(const float* W, int K, int N, bf16* WT, int& it, int NGW, LAS float* scr, int lane) {
    const int n_items = (K / 64) * (N / 32);
    while (it < n_items) { transpose_item(W, K, N, WT, 0, scr, it, lane); it += NGW; }
    it -= n_items;
}

DEV void phase0(const Args& a, LAS unsigned char* lds) {
    const int tid = otid(), lane = tid & 63, wave = tid >> 6;
    const int gw = blockIdx.x * NWV + wave, NGW = gridDim.x * NWV, gt = blockIdx.x * NT + tid, NGT = gridDim.x * NT;
    unsigned char* ws = a.ws;
    float* rss = (float*)(ws + WS_RSE);
    {
        u32x4* z = (u32x4*)(ws + WS_WTIN + (size_t)3456 * DM * 2);
        for (int i = gt; i < 128 * DM * 2 / 16; i += NGT) z[i] = (u32x4){0u, 0u, 0u, 0u};
    }
    if (gt < 384) {
        const float* hl = a.in[I_HLB]; float e[4], mx = -1e30f, sm = 0.f;
        _Pragma("unroll") for (int d = 0; d < 4; ++d) { e[d] = hl[d * 384 + gt]; mx = fmaxf(mx, e[d]); }
        _Pragma("unroll") for (int d = 0; d < 4; ++d) { e[d] = __expf(e[d] - mx); sm += e[d]; }
        float* lbt = (float*)(ws + WS_LBT); float acc = 0.f; lbt[gt] = 0.f;
        _Pragma("unroll") for (int d = 1; d < 4; ++d) { acc += e[d] / sm; lbt[d * 384 + gt] = acc; }
    }
    bf16* U0 = (bf16*)(ws + WS_U0); bf16* U1 = (bf16*)(ws + WS_U1); float* xs = (float*)(ws + WS_XS);
    const f32x4* g4 = (const f32x4*)a.in[I_N1G];
    for (int row = gw; row < MREAL; row += NGW) {
        const f32x4* src = (const f32x4*)(row < MP ? a.in[I_XP] + (size_t)row * DM : a.in[I_XS] + (size_t)(row - MP) * DM);
        f32x4* dst = (f32x4*)(row < MP ? a.out + (size_t)row * DM : xs + (size_t)(row - MP) * DM);
        u32x2* ud = (u32x2*)(U0 + (size_t)row * DM);
        float ss = 0.f;
#pragma unroll
        for (int j = 0; j < 4; ++j) { const f32x4 v = src[lane + 64 * j], g = g4[lane + 64 * j]; dst[lane + 64 * j] = v;
            ss += (v[0] * v[0] + v[1] * v[1]) + (v[2] * v[2] + v[3] * v[3]);
            u32x2 w; w.x = pk2(v[0] * g[0], v[1] * g[1]); w.y = pk2(v[2] * g[2], v[3] * g[3]); ud[lane + 64 * j] = w; }
        ss = wave_sum(ss); if (lane < 16) rss[(size_t)row * 16 + lane] = lane == 0 ? ss : 0.f;
    }
    for (int r = gw; r < 256; r += NGW) { const int lay = r >> 7, i = r & 127;
        const f32x4* src = (const f32x4*)(a.in[I_SSHIFT] + (size_t)(lay * 128 + i) * DM);
        u32x2* ud = (u32x2*)((lay ? U1 : U0) + (size_t)(MREAL + i) * DM);
#pragma unroll
        for (int j = 0; j < 4; ++j) { const f32x4 v = src[lane + 64 * j]; u32x2 w; w.x = pk2(v[0], v[1]); w.y = pk2(v[2], v[3]); ud[lane + 64 * j] = w; }
    }
    LAS float* scr = (LAS float*)(lds + wave * 8448);
    int it = gw;
    transpose_job(a.in[I_WIN], DM, 3456, (bf16*)(ws + WS_WTIN), it, NGW, scr, lane);
    for (int l = 0; l < 4; ++l) {
        bf16* WL = (bf16*)(ws + WS_WLORA) + (size_t)l * WL_STRIDE;
        transpose_job(a.in[I_WUP] + (size_t)l * 64 * 384, 64, 384, WL, it, NGW, scr, lane);
        transpose_job(a.in[I_AUP] + (size_t)l * 64 * 384, 64, 384, WL + WL_AUP, it, NGW, scr, lane);
        transpose_job(a.in[I_GUP] + (size_t)l * 128 * 384, 128, 384, WL + WL_GUP, it, NGW, scr, lane);
        for (int n = 0; n < 4; ++n) {
            transpose_job(a.in[I_WA] + (size_t)(l * 4 + n) * 4096, 64, 64, WL + WL_WA + n * 4096, it, NGW, scr, lane);
            transpose_job(a.in[I_WX] + (size_t)(l * 4 + n) * 4096, 64, 64, WL + WL_WX + n * 4096, it, NGW, scr, lane);
        }
    }
}

constexpr int PL_PRM = 0, PL_AL = 14336, PL_XC = 31232, PL_LW = 48128, PL_LA = 73216, PL_GR = 98304, PL_GI = 115200;
template <int C> DEV float dpp_sum8(float x) { x += __shfl_xor(x, 1); x += __shfl_xor(x, 2); x += __shfl_xor(x, 4); return x; }
DEV void prep_tile(const Args& a, int l, int tt, LAS unsigned char* lds, bool do_gelu = true, int mi_lo = 0, int mi_hi = 2) {
    const int tid = otid(), lane = tid & 63, wave = __builtin_amdgcn_readfirstlane(tid >> 6);
    unsigned char* ws = a.ws;
    LAS float* PRM = (LAS float*)(lds + PL_PRM);
    LAS bf16* AL = (LAS bf16*)(lds + PL_AL);
    LAS bf16* XC = (LAS bf16*)(lds + PL_XC);
    LAS bf16* LW = (LAS bf16*)(lds + PL_LW);
    LAS bf16* LAo = (LAS bf16*)(lds + PL_LA);
    LAS bf16* GR = (LAS bf16*)(lds + PL_GR);
    LAS bf16* GI = (LAS bf16*)(lds + PL_GI);
    bf16* P = (bf16*)(ws + WS_P);
    const bool samp = tt >= 512;
    const int row0 = tt * 32;
    const float* mu = a.in[I_MU] + l * 1408;
#ifndef SK_PREP_A
#pragma unroll 1
    for (int itx = mi_lo; itx < mi_hi; ++itx) {
        const int idx = itx * NT + tid, r = idx >> 5, col = (idx & 31) * 8, row = row0 + r, t = row & (TT - 1);
        float p[8], pp[8], x[8];
        {
            unpack8(*(const u32x4*)(P + (size_t)row * NP + 1152 + col), p);
            const bool valid = samp || t > 0; const int prow = samp ? row + 128 : row - 1;
            if (valid) unpack8(*(const u32x4*)(P + (size_t)prow * NP + 1152 + col), pp);
            else { _Pragma("unroll") for (int e = 0; e < 8; ++e) pp[e] = 0.f; }
            const f32x4 m0 = *(const f32x4*)(mu + 1152 + col), m1 = *(const f32x4*)(mu + 1152 + col + 4);
#pragma unroll
            for (int e = 0; e < 8; ++e) { const float m = e < 4 ? m0[e] : m1[e - 4]; x[e] = p[e] + m * (pp[e] - p[e]); }
            if (col < 64) { _Pragma("unroll") for (int e = 0; e < 8; ++e) x[e] = tanhf(x[e]); }
            else if (col >= 128) { _Pragma("unroll") for (int e = 0; e < 8; ++e) x[e] = sigm(x[e]); }
            u32x4 w; w.x = pk2(x[0], x[1]); w.y = pk2(x[2], x[3]); w.z = pk2(x[4], x[5]); w.w = pk2(x[6], x[7]);
            *(LAS u32x4*)(AL + r * 264 + col) = w;
        }
        {
            float xr[4][8];
            unpack8(*(const u32x4*)(P + (size_t)row * NP + 2944 + col), xr[0]);
            if (!samp) {
#pragma unroll
                for (int j = 1; j < 4; ++j) { if (t - j >= 0) unpack8(*(const u32x4*)(P + (size_t)(row - j) * NP + 2944 + col), xr[j]); else { _Pragma("unroll") for (int e = 0; e < 8; ++e) xr[j][e] = 0.f; } }
                if (t >= TT - 3) { float* pc = a.out + O_PCONV + ((size_t)((l * 8 + (row >> 11)) * 3 + (t - (TT - 3)))) * 256 + col;
                    *(f32x4*)pc = (f32x4){xr[0][0], xr[0][1], xr[0][2], xr[0][3]}; *(f32x4*)(pc + 4) = (f32x4){xr[0][4], xr[0][5], xr[0][6], xr[0][7]}; }
            } else {
                const int i = row - MP; const float* c0 = a.in[I_SCONV] + (size_t)((l * 128 + i) * 3) * 256 + col;
#pragma unroll
                for (int j = 1; j < 4; ++j) { const f32x4 q0 = *(const f32x4*)(c0 + (3 - j) * 256), q1 = *(const f32x4*)(c0 + (3 - j) * 256 + 4);
                    xr[j][0] = q0[0]; xr[j][1] = q0[1]; xr[j][2] = q0[2]; xr[j][3] = q0[3]; xr[j][4] = q1[0]; xr[j][5] = q1[1]; xr[j][6] = q1[2]; xr[j][7] = q1[3]; }
                float* sc = a.out + O_SCONV + (size_t)((l * 128 + i) * 3) * 256 + col;
                *(f32x4*)(sc) = (f32x4){xr[2][0], xr[2][1], xr[2][2], xr[2][3]}; *(f32x4*)(sc + 4) = (f32x4){xr[2][4], xr[2][5], xr[2][6], xr[2][7]};
                *(f32x4*)(sc + 256) = (f32x4){xr[1][0], xr[1][1], xr[1][2], xr[1][3]}; *(f32x4*)(sc + 260) = (f32x4){xr[1][4], xr[1][5], xr[1][6], xr[1][7]};
                *(f32x4*)(sc + 512) = (f32x4){xr[0][0], xr[0][1], xr[0][2], xr[0][3]}; *(f32x4*)(sc + 516) = (f32x4){xr[0][4], xr[0][5], xr[0][6], xr[0][7]};
            }
            const float* cw = a.in[I_CW] + (size_t)l * 4 * 256 + col; const float* cb = a.in[I_CB] + l * 256 + col;
            float xc[8];
#pragma unroll
            for (int e = 0; e < 8; ++e) xc[e] = cb[e] + cw[e] * xr[3][e] + cw[256 + e] * xr[2][e] + cw[512 + e] * xr[1][e] + cw[768 + e] * xr[0][e];
            u32x4 w; w.x = pk2(xc[0], xc[1]); w.y = pk2(xc[2], xc[3]); w.z = pk2(xc[4], xc[5]); w.w = pk2(xc[6], xc[7]);
            *(LAS u32x4*)(XC + r * 264 + col) = w;
        }
    }
#endif
    __syncthreads();
    const int fr = lane & 15, fq = lane >> 4;
    const bf16* WL = (const bf16*)(ws + WS_WLORA) + (size_t)l * WL_STRIDE;
#ifndef SK_PREP_R
    if (wave < 6) {
        const int h = wave;
        bf16* G = (bf16*)(ws + WS_G);
#ifndef NP_NO_WA
#pragma unroll
        for (int which = 0; which < 2; ++which) {
            const bf16* Wm = WL + (which ? WL_AUP : 0); LAS bf16* Lo = which ? LAo : LW;
            bf16x8 Wf[4][2];
#pragma unroll
            for (int ni = 0; ni < 4; ++ni)
#pragma unroll
                for (int ks = 0; ks < 2; ++ks) Wf[ni][ks] = *(const bf16x8*)(Wm + (h * 64 + ni * 16 + fr) * 64 + ks * 32 + fq * 8);
#pragma unroll 1
            for (int mi = mi_lo; mi < mi_hi; ++mi) {
                f32x4 acc[4];
#pragma unroll
                for (int ni = 0; ni < 4; ++ni) acc[ni] = (f32x4){0.f, 0.f, 0.f, 0.f};
#pragma unroll
                for (int ks = 0; ks < 2; ++ks) { const bf16x8 Af = *(const LAS bf16x8*)(AL + (mi * 16 + fr) * 264 + which * 64 + ks * 32 + fq * 8);
#pragma unroll
                    for (int ni = 0; ni < 4; ++ni) acc[ni] = __builtin_amdgcn_mfma_f32_16x16x32_bf16(Wf[ni][ks], Af, acc[ni], 0, 0, 0); }
#pragma unroll
                for (int ni = 0; ni < 4; ++ni) { u32x2 w; w.x = pk2(acc[ni][0], acc[ni][1]); w.y = pk2(acc[ni][2], acc[ni][3]);
                    *(LAS u32x2*)(Lo + (mi * 16 + fr) * 392 + h * 64 + ni * 16 + fq * 4) = w; }
            }
        }
#endif
        {
            bf16x8 Wf[4][4];
#pragma unroll
            for (int ni = 0; ni < 4; ++ni)
#pragma unroll
                for (int ks = 0; ks < 4; ++ks) Wf[ni][ks] = *(const bf16x8*)(WL + WL_GUP + (h * 64 + ni * 16 + fr) * 128 + ks * 32 + fq * 8);
#pragma unroll 1
            for (int mi = mi_lo; mi < mi_hi; ++mi) {
                f32x4 acc[4];
#pragma unroll
                for (int ni = 0; ni < 4; ++ni) acc[ni] = (f32x4){0.f, 0.f, 0.f, 0.f};
#pragma unroll
                for (int ks = 0; ks < 4; ++ks) { const bf16x8 Af = *(const LAS bf16x8*)(AL + (mi * 16 + fr) * 264 + 128 + ks * 32 + fq * 8);
#pragma unroll
                    for (int ni = 0; ni < 4; ++ni) acc[ni] = __builtin_amdgcn_mfma_f32_16x16x32_bf16(Wf[ni][ks], Af, acc[ni], 0, 0, 0); }
                const int row = row0 + mi * 16 + fr;
#pragma unroll
                for (int ni = 0; ni < 4; ++ni) { u32x2 w; w.x = pk2(acc[ni][0], acc[ni][1]); w.y = pk2(acc[ni][2], acc[ni][3]);
#ifndef NP_NO_G
                    *(u32x2*)(G + (size_t)row * 384 + h * 64 + ni * 16 + fq * 4) = w;
#endif
                }
            }
        }
    } else
#endif
#ifndef SK_PREP_L
    if (wave >= 6) {
#pragma unroll 1
        for (int nn = 0; nn < 2; ++nn) {
            const int n = (wave - 6) * 2 + nn;
            bf16x8 Wa[4][2], Wx[4][2];
#pragma unroll
            for (int ni = 0; ni < 4; ++ni)
#pragma unroll
                for (int ks = 0; ks < 2; ++ks) { Wa[ni][ks] = *(const bf16x8*)(WL + WL_WA + n * 4096 + (ni * 16 + fr) * 64 + ks * 32 + fq * 8);
                                                  Wx[ni][ks] = *(const bf16x8*)(WL + WL_WX + n * 4096 + (ni * 16 + fr) * 64 + ks * 32 + fq * 8); }
#pragma unroll 1
            for (int mi = mi_lo; mi < mi_hi; ++mi) {
                f32x4 ar[4], ax[4];
#pragma unroll
                for (int ni = 0; ni < 4; ++ni) { ar[ni] = (f32x4){0.f, 0.f, 0.f, 0.f}; ax[ni] = ar[ni]; }
#pragma unroll
                for (int ks = 0; ks < 2; ++ks) { const bf16x8 Af = *(const LAS bf16x8*)(XC + (mi * 16 + fr) * 264 + n * 64 + ks * 32 + fq * 8);
#pragma unroll
                    for (int ni = 0; ni < 4; ++ni) { ar[ni] = __builtin_amdgcn_mfma_f32_16x16x32_bf16(Wa[ni][ks], Af, ar[ni], 0, 0, 0); ax[ni] = __builtin_amdgcn_mfma_f32_16x16x32_bf16(Wx[ni][ks], Af, ax[ni], 0, 0, 0); } }
#pragma unroll
                for (int ni = 0; ni < 4; ++ni) { u32x2 w1, w2; w1.x = pk2(ar[ni][0], ar[ni][1]); w1.y = pk2(ar[ni][2], ar[ni][3]); w2.x = pk2(ax[ni][0], ax[ni][1]); w2.y = pk2(ax[ni][2], ax[ni][3]);
                    *(LAS u32x2*)(GR + (mi * 16 + fr) * 264 + n * 64 + ni * 16 + fq * 4) = w1; *(LAS u32x2*)(GI + (mi * 16 + fr) * 264 + n * 64 + ni * 16 + fq * 4) = w2; }
            }
        }
    }
#endif
    __syncthreads();
#ifndef NP_NO_RW
#pragma unroll 1
    for (int itx = 0; itx < 3; ++itx) {
        const int idx = itx * NT + tid, r = idx / 48, cg = idx % 48, c0 = cg * 8, h = cg >> 3, i0 = c0 & 63;
        if (r < 16 * mi_lo || r >= 16 * mi_hi) continue;
        const int row = row0 + r, t = row & (TT - 1);
        const bool valid = samp || t > 0; const int prow = samp ? row + 128 : row - 1;
        float cr[8], ck[8], cv[8], er[8], ek[8], ev[8], lw[8], la[8];
        const bf16* pr = P + (size_t)row * NP + c0; const bf16* pq = P + (size_t)prow * NP + c0;
        unpack8(*(const u32x4*)pr, cr); unpack8(*(const u32x4*)(pr + 384), ck); unpack8(*(const u32x4*)(pr + 768), cv);
        if (valid) { unpack8(*(const u32x4*)pq, er); unpack8(*(const u32x4*)(pq + 384), ek); unpack8(*(const u32x4*)(pq + 768), ev); }
        else { _Pragma("unroll") for (int e = 0; e < 8; ++e) { er[e] = 0.f; ek[e] = 0.f; ev[e] = 0.f; } }
        unpack8(*(const LAS u32x4*)(LW + r * 392 + c0), lw); unpack8(*(const LAS u32x4*)(LAo + r * 392 + c0), la);
        float wq[8], kq[8], av[8], rv[8], kv[8], vv[8]; float ssq = 0.f;
#pragma unroll
        for (int e = 0; e < 8; ++e) {
            const float mr = PRM[c0 + e], mk = PRM[384 + c0 + e], mv = PRM[768 + c0 + e], w0 = PRM[1152 + c0 + e], a0 = PRM[1536 + c0 + e], kk_ = PRM[1920 + c0 + e], ka_ = PRM[2304 + c0 + e];
            rv[e] = cr[e] + mr * (er[e] - cr[e]); const float kx = ck[e] + mk * (ek[e] - ck[e]); vv[e] = cv[e] + mv * (ev[e] - cv[e]);
            wq[e] = __expf(-0.6065306597f * sigm(w0 + lw[e]));
            av[e] = sigm(a0 + la[e]);
            kq[e] = kx * kk_; ssq += kq[e] * kq[e];
            kv[e] = kx * (1.f + (av[e] - 1.f) * ka_);
        }
        ssq = dpp_sum8<0>(ssq);
        const float inv = rsqrtf(fmaxf(ssq, 1e-24f));
        unsigned char* rec = samp ? ws + WS_SCANS + (size_t)((row - MP) * 6 + h) * REC
                                  : ws + WS_SCAN + ((size_t)((row >> 11) * 6 + h) * TT + t) * REC;
        f32x4 o0, o1;
        o0 = (f32x4){wq[0], wq[1], wq[2], wq[3]}; o1 = (f32x4){wq[4], wq[5], wq[6], wq[7]};
        *(f32x4*)(rec + 4 * i0) = o0; *(f32x4*)(rec + 4 * i0 + 16) = o1;
#pragma unroll
        for (int e = 0; e < 8; ++e) kq[e] *= inv;
        o0 = (f32x4){kq[0], kq[1], kq[2], kq[3]}; o1 = (f32x4){kq[4], kq[5], kq[6], kq[7]};
        *(f32x4*)(rec + 256 + 4 * i0) = o0; *(f32x4*)(rec + 256 + 4 * i0 + 16) = o1;
        o0 = (f32x4){kq[0] * av[0], kq[1] * av[1], kq[2] * av[2], kq[3] * av[3]}; o1 = (f32x4){kq[4] * av[4], kq[5] * av[5], kq[6] * av[6], kq[7] * av[7]};
        *(f32x4*)(rec + 512 + 4 * i0) = o0; *(f32x4*)(rec + 512 + 4 * i0 + 16) = o1;
        u32x4 rk; rk.x = pk2(rv[0], rv[1]); rk.y = pk2(rv[2], rv[3]); rk.z = pk2(kv[0], kv[1]); rk.w = pk2(kv[2], kv[3]);
        *(u32x4*)(rec + 768 + 4 * i0) = rk;
        rk.x = pk2(rv[4], rv[5]); rk.y = pk2(rv[6], rv[7]); rk.z = pk2(kv[4], kv[5]); rk.w = pk2(kv[6], kv[7]);
        *(u32x4*)(rec + 768 + 4 * i0 + 16) = rk;
        u32x4 vp; vp.x = pk2(vv[0], vv[1]); vp.y = pk2(vv[2], vv[3]); vp.z = pk2(vv[4], vv[5]); vp.w = pk2(vv[6], vv[7]);
        *(u32x4*)(rec + 1024 + 2 * i0) = vp;
    }
#endif
    {
        bf16* LA = (bf16*)(ws + WS_LA); bf16* LU = (bf16*)(ws + WS_LU);
#pragma unroll 1
        for (int itx = 0; itx < 2; ++itx) {
            const int idx = itx * NT + tid, r = idx >> 5, c0 = (idx & 31) * 8, row = row0 + r;
            if (r < 16 * mi_lo || r >= 16 * mi_hi) continue;
            float gr[8], gi[8], xc[8], la[8], uu[8];
            unpack8(*(const LAS u32x4*)(GR + r * 264 + c0), gr); unpack8(*(const LAS u32x4*)(GI + r * 264 + c0), gi); unpack8(*(const LAS u32x4*)(XC + r * 264 + c0), xc);
#pragma unroll
            for (int e = 0; e < 8; ++e) { const float rr = sigm(gr[e] + PRM[2688 + c0 + e]), ii = sigm(gi[e] + PRM[2944 + c0 + e]);
                la[e] = -8.f * rr * PRM[3200 + c0 + e];
                uu[e] = xc[e] * ii * sqrtf(fmaxf(-expm1f(2.f * la[e]), 1e-12f)); }
            u32x4 o1, o2; o1.x = pk2(la[0], la[1]); o1.y = pk2(la[2], la[3]); o1.z = pk2(la[4], la[5]); o1.w = pk2(la[6], la[7]);
            o2.x = pk2(uu[0], uu[1]); o2.y = pk2(uu[2], uu[3]); o2.z = pk2(uu[4], uu[5]); o2.w = pk2(uu[6], uu[7]);
#ifndef NP_NO_LRU
            *(u32x4*)(LA + (size_t)row * 256 + c0) = o1; *(u32x4*)(LU + (size_t)row * 256 + c0) = o2;
#endif
        }
    }
    __syncthreads();
}

DEV void phase_prep(const Args& a, int l, LAS unsigned char* lds, bool do_gelu = true) {
    const int tid = otid(), lane = tid & 63, wave = tid >> 6;
    const int gw = blockIdx.x * NWV + wave, NGW = gridDim.x * NWV;
    unsigned char* ws = a.ws;
    {
        LAS float* PRM = (LAS float*)(lds + PL_PRM);
        for (int i = tid; i < 384; i += NT) { PRM[i] = a.in[I_MU][l * 1408 + i]; PRM[384 + i] = a.in[I_MU][l * 1408 + 384 + i]; PRM[768 + i] = a.in[I_MU][l * 1408 + 768 + i];
            PRM[1152 + i] = a.in[I_W0][l * 384 + i]; PRM[1536 + i] = a.in[I_A0][l * 384 + i]; PRM[1920 + i] = a.in[I_KK][l * 384 + i]; PRM[2304 + i] = a.in[I_KA][l * 384 + i]; }
        for (int i = tid; i < 256; i += NT) { PRM[2688 + i] = a.in[I_BA][l * 256 + i]; PRM[2944 + i] = a.in[I_BX][l * 256 + i]; PRM[3200 + i] = log1pf(__expf(-a.in[I_LAM][l * 256 + i])); }
    }
    __syncthreads();
    prep_tile(a, l, blockIdx.x, lds, do_gelu); prep_tile(a, l, blockIdx.x + 256, lds, do_gelu);
    if (blockIdx.x >= 248) { const int q = blockIdx.x - 248; prep_tile(a, l, 512 + (q >> 1), lds, do_gelu, q & 1, (q & 1) + 1); }
    const float* rss = (const float*)(ws + WS_RSE);
    for (int r = gw; r < 136; r += NGW) {
        const int row = r < 8 ? r * TT + TT - 1 : MP + (r - 8);
        const f32x4* src = (const f32x4*)(row < MP ? a.out + (size_t)row * DM : (const float*)(ws + WS_XS) + (size_t)(row - MP) * DM);
        f32x4* dst = (f32x4*)(r < 8 ? a.out + O_PSHIFT + (size_t)(l * 8 + r) * DM : a.out + O_SSHIFT + (size_t)(l * 128 + (r - 8)) * DM);
        const f32x4* g4 = (const f32x4*)(a.in[I_N1G] + l * DM);
        const float s = row_scale(rss, row);
#pragma unroll
        for (int j = 0; j < 4; ++j) { const f32x4 v = src[lane + 64 * j], g = g4[lane + 64 * j]; dst[lane + 64 * j] = (f32x4){v[0] * s * g[0], v[1] * s * g[1], v[2] * s * g[2], v[3] * s * g[3]}; }
    }
    if (l + 2 < 4) {
        bf16* U = (bf16*)(ws + ((l & 1) ? WS_U1 : WS_U0));
        for (int i = gw; i < 128; i += NGW) {
            const f32x4* src = (const f32x4*)(a.in[I_SSHIFT] + (size_t)((l + 2) * 128 + i) * DM);
            u32x2* ud = (u32x2*)(U + (size_t)(MREAL + i) * DM);
#pragma unroll
            for (int j = 0; j < 4; ++j) { const f32x4 v = src[lane + 64 * j]; u32x2 w; w.x = pk2(v[0], v[1]); w.y = pk2(v[2], v[3]); ud[lane + 64 * j] = w; }
        }
    }
    __syncthreads();
    LAS float* scr = (LAS float*)(lds + wave * 8448);
    if (blockIdx.x < 248) {
    const int NGW2 = 248 * NWV; int it = gw;
    transpose_job(a.in[I_WOUT] + (size_t)l * DM * DM, DM, DM, (bf16*)(ws + WS_WTOUT), it, NGW2, scr, lane);
    transpose_job(a.in[I_W1] + (size_t)l * DM * FF, DM, FF, (bf16*)(ws + WS_WT1), it, NGW2, scr, lane);
    transpose_job(a.in[I_W2] + (size_t)l * FF * DM, FF, DM, (bf16*)(ws + WS_WT2), it, NGW2, scr, lane);
    }
}

DEV void prep_tile_old(const Args& a, int l, int tt, LAS unsigned char* lds, bool do_gelu = true, int mi_lo = 0, int mi_hi = 4) {
    const int tid = otid(), lane = tid & 63, wave = __builtin_amdgcn_readfirstlane(tid >> 6);
    unsigned char* ws = a.ws;
    LAS bf16* AL = (LAS bf16*)lds;
    LAS bf16* XC = (LAS bf16*)(lds + 33792);
    bf16* P = (bf16*)(ws + WS_P);
    const bool samp = tt >= 256;
    const int row0 = tt * 64;
    const float* mu = a.in[I_MU] + l * 1408;
    LAS float* SPT = (LAS float*)(lds + 67584);
    if (tid < 256) SPT[tid] = log1pf(__expf(-a.in[I_LAM][l * 256 + tid]));
#ifndef SK_PREP_A
#pragma unroll 1
    for (int itx = mi_lo; itx < mi_hi; ++itx) {
        const int idx = itx * NT + tid, r = idx >> 5, col = (idx & 31) * 8, row = row0 + r, t = row & (TT - 1);
        float p[8], pp[8], x[8];
        {
            unpack8(*(const u32x4*)(P + (size_t)row * NP + 1152 + col), p);
            const bool valid = samp || t > 0; const int prow = samp ? row + 128 : row - 1;
            if (valid) unpack8(*(const u32x4*)(P + (size_t)prow * NP + 1152 + col), pp);
            else { _Pragma("unroll") for (int e = 0; e < 8; ++e) pp[e] = 0.f; }
            const f32x4 m0 = *(const f32x4*)(mu + 1152 + col), m1 = *(const f32x4*)(mu + 1152 + col + 4);
#pragma unroll
            for (int e = 0; e < 8; ++e) { const float m = e < 4 ? m0[e] : m1[e - 4]; x[e] = p[e] + m * (pp[e] - p[e]); }
            if (col < 64) { _Pragma("unroll") for (int e = 0; e < 8; ++e) x[e] = tanhf(x[e]); }
            else if (col >= 128) { _Pragma("unroll") for (int e = 0; e < 8; ++e) x[e] = sigm(x[e]); }
            u32x4 w; w.x = pk2(x[0], x[1]); w.y = pk2(x[2], x[3]); w.z = pk2(x[4], x[5]); w.w = pk2(x[6], x[7]);
            *(LAS u32x4*)(AL + r * 264 + col) = w;
        }
        {
            float xr[4][8];
            unpack8(*(const u32x4*)(P + (size_t)row * NP + 2944 + col), xr[0]);
            if (!samp) {
#pragma unroll
                for (int j = 1; j < 4; ++j) { if (t - j >= 0) unpack8(*(const u32x4*)(P + (size_t)(row - j) * NP + 2944 + col), xr[j]); else { _Pragma("unroll") for (int e = 0; e < 8; ++e) xr[j][e] = 0.f; } }
                if (t >= TT - 3) { float* pc = a.out + O_PCONV + ((size_t)((l * 8 + (row >> 11)) * 3 + (t - (TT - 3)))) * 256 + col;
                    *(f32x4*)pc = (f32x4){xr[0][0], xr[0][1], xr[0][2], xr[0][3]}; *(f32x4*)(pc + 4) = (f32x4){xr[0][4], xr[0][5], xr[0][6], xr[0][7]}; }
            } else {
                const int i = row - MP; const float* c0 = a.in[I_SCONV] + (size_t)((l * 128 + i) * 3) * 256 + col;
#pragma unroll
                for (int j = 1; j < 4; ++j) { const f32x4 q0 = *(const f32x4*)(c0 + (3 - j) * 256), q1 = *(const f32x4*)(c0 + (3 - j) * 256 + 4);
                    xr[j][0] = q0[0]; xr[j][1] = q0[1]; xr[j][2] = q0[2]; xr[j][3] = q0[3]; xr[j][4] = q1[0]; xr[j][5] = q1[1]; xr[j][6] = q1[2]; xr[j][7] = q1[3]; }
                float* sc = a.out + O_SCONV + (size_t)((l * 128 + i) * 3) * 256 + col;
                *(f32x4*)(sc) = (f32x4){xr[2][0], xr[2][1], xr[2][2], xr[2][3]}; *(f32x4*)(sc + 4) = (f32x4){xr[2][4], xr[2][5], xr[2][6], xr[2][7]};
                *(f32x4*)(sc + 256) = (f32x4){xr[1][0], xr[1][1], xr[1][2], xr[1][3]}; *(f32x4*)(sc + 260) = (f32x4){xr[1][4], xr[1][5], xr[1][6], xr[1][7]};
                *(f32x4*)(sc + 512) = (f32x4){xr[0][0], xr[0][1], xr[0][2], xr[0][3]}; *(f32x4*)(sc + 516) = (f32x4){xr[0][4], xr[0][5], xr[0][6], xr[0][7]};
            }
            const float* cw = a.in[I_CW] + (size_t)l * 4 * 256 + col; const float* cb = a.in[I_CB] + l * 256 + col;
            float xc[8];
#pragma unroll
            for (int e = 0; e < 8; ++e) xc[e] = cb[e] + cw[e] * xr[3][e] + cw[256 + e] * xr[2][e] + cw[512 + e] * xr[1][e] + cw[768 + e] * xr[0][e];
            u32x4 w; w.x = pk2(xc[0], xc[1]); w.y = pk2(xc[2], xc[3]); w.z = pk2(xc[4], xc[5]); w.w = pk2(xc[6], xc[7]);
            *(LAS u32x4*)(XC + r * 264 + col) = w;
            float gt8[8]; bf16* gp = P + (size_t)row * NP + 3200 + col;
            unpack8(*(const u32x4*)gp, gt8);
#pragma unroll
            for (int e = 0; e < 8; ++e) gt8[e] = gelu_t(gt8[e]);
            u32x4 gw; gw.x = pk2(gt8[0], gt8[1]); gw.y = pk2(gt8[2], gt8[3]); gw.z = pk2(gt8[4], gt8[5]); gw.w = pk2(gt8[6], gt8[7]);
        }
    }
#endif
    __syncthreads();
    const int fr = lane & 15, fq = lane >> 4;
    const bf16* WL = (const bf16*)(ws + WS_WLORA) + (size_t)l * WL_STRIDE;
#ifdef SK_PREP_R
    if (false) {
#else
    if (wave < 6) {
#endif
        const int h = wave;
        const float* w0 = a.in[I_W0] + l * 384; const float* a0 = a.in[I_A0] + l * 384; const float* kkp = a.in[I_KK] + l * 384; const float* kap = a.in[I_KA] + l * 384;
        bf16* G = (bf16*)(ws + WS_G);
        bf16x8 Ww[4][2], Wa2[4][2];
#pragma unroll
        for (int ni = 0; ni < 4; ++ni)
#pragma unroll
            for (int ks = 0; ks < 2; ++ks) { const int n = h * 64 + ni * 16 + fr; Ww[ni][ks] = *(const bf16x8*)(WL + n * 64 + ks * 32 + fq * 8); Wa2[ni][ks] = *(const bf16x8*)(WL + WL_AUP + n * 64 + ks * 32 + fq * 8); }
#pragma unroll 1
        for (int mi = mi_lo; mi < mi_hi; ++mi) {
            f32x4 aw[4], aa[4], ag[4];
#pragma unroll
            for (int ni = 0; ni < 4; ++ni) { aw[ni] = (f32x4){0.f, 0.f, 0.f, 0.f}; aa[ni] = aw[ni]; ag[ni] = aw[ni]; }
            const LAS bf16* arow = AL + (mi * 16 + fr) * 264 + fq * 8;
#pragma unroll
            for (int ks = 0; ks < 2; ++ks) { const bf16x8 Af = *(const LAS bf16x8*)(arow + ks * 32), Bf = *(const LAS bf16x8*)(arow + 64 + ks * 32);
#pragma unroll
                for (int ni = 0; ni < 4; ++ni) {
                    aw[ni] = __builtin_amdgcn_mfma_f32_16x16x32_bf16(Ww[ni][ks], Af, aw[ni], 0, 0, 0);
                    aa[ni] = __builtin_amdgcn_mfma_f32_16x16x32_bf16(Wa2[ni][ks], Bf, aa[ni], 0, 0, 0); } }
#pragma unroll
            for (int ks = 0; ks < 4; ++ks) { const bf16x8 Af = *(const LAS bf16x8*)(arow + 128 + ks * 32);
#pragma unroll
                for (int ni = 0; ni < 4; ++ni) { const int n = h * 64 + ni * 16 + fr;
                    ag[ni] = __builtin_amdgcn_mfma_f32_16x16x32_bf16(*(const bf16x8*)(WL + WL_GUP + n * 128 + ks * 32 + fq * 8), Af, ag[ni], 0, 0, 0); } }
            const int r = mi * 16 + fr, row = row0 + r, t = row & (TT - 1);
#pragma unroll
            for (int ni = 0; ni < 4; ++ni) { u32x2 gp; gp.x = pk2(ag[ni][0], ag[ni][1]); gp.y = pk2(ag[ni][2], ag[ni][3]); *(u32x2*)(G + (size_t)row * 384 + h * 64 + ni * 16 + fq * 4) = gp; }
            const bool valid = samp || t > 0; const int prow = samp ? row + 128 : row - 1;
            float ssq = 0.f;
#pragma unroll
            for (int ni = 0; ni < 4; ++ni) {
                const int c0 = h * 64 + ni * 16 + fq * 4;
                const u32x2 uk = *(const u32x2*)(P + (size_t)row * NP + 384 + c0);
                u32x2 qk = (u32x2){0u, 0u}; if (valid) qk = *(const u32x2*)(P + (size_t)prow * NP + 384 + c0);
                const f32x4 mk = *(const f32x4*)(mu + 384 + c0), kk4 = *(const f32x4*)(kkp + c0);
                const float ck[4] = {bflo(uk.x), bfhi(uk.x), bflo(uk.y), bfhi(uk.y)}, ek[4] = {bflo(qk.x), bfhi(qk.x), bflo(qk.y), bfhi(qk.y)};
#pragma unroll
                for (int j = 0; j < 4; ++j) { const float kr = (ck[j] + mk[j] * (ek[j] - ck[j])) * kk4[j]; ssq += kr * kr; }
            }
            ssq += __shfl_xor(ssq, 16); ssq += __shfl_xor(ssq, 32);
            const float inv = rsqrtf(fmaxf(ssq, 1e-24f));
            unsigned char* rec = samp ? ws + WS_SCANS + (size_t)((row - MP) * 6 + h) * REC
                                      : ws + WS_SCAN + ((size_t)((row >> 11) * 6 + h) * TT + t) * REC;
#pragma unroll
            for (int ni = 0; ni < 4; ++ni) {
                asm volatile("" ::: "memory");
                const int i0 = ni * 16 + fq * 4, c0 = h * 64 + i0;
                const bf16* pr = P + (size_t)row * NP + c0; const bf16* pq = P + (size_t)prow * NP + c0;
                const u32x2 ur = *(const u32x2*)pr, uk = *(const u32x2*)(pr + 384), uv = *(const u32x2*)(pr + 768);
                u32x2 qr = (u32x2){0u, 0u}, qk = qr, qv = qr;
                if (valid) { qr = *(const u32x2*)pq; qk = *(const u32x2*)(pq + 384); qv = *(const u32x2*)(pq + 768); }
                const f32x4 mr = *(const f32x4*)(mu + c0), mk = *(const f32x4*)(mu + 384 + c0), mv = *(const f32x4*)(mu + 768 + c0);
                const f32x4 w04 = *(const f32x4*)(w0 + c0), a04 = *(const f32x4*)(a0 + c0), kk4 = *(const f32x4*)(kkp + c0), ka4 = *(const f32x4*)(kap + c0);
                const float cr[4] = {bflo(ur.x), bfhi(ur.x), bflo(ur.y), bfhi(ur.y)}, ck[4] = {bflo(uk.x), bfhi(uk.x), bflo(uk.y), bfhi(uk.y)}, cv[4] = {bflo(uv.x), bfhi(uv.x), bflo(uv.y), bfhi(uv.y)};
                const float er[4] = {bflo(qr.x), bfhi(qr.x), bflo(qr.y), bfhi(qr.y)}, ek[4] = {bflo(qk.x), bfhi(qk.x), bflo(qk.y), bfhi(qk.y)}, ev[4] = {bflo(qv.x), bfhi(qv.x), bflo(qv.y), bfhi(qv.y)};
                f32x4 wq, kq, bq; float rv[4], kv[4], vv[4];
#pragma unroll
                for (int j = 0; j < 4; ++j) {
                    const float rr = cr[j] + mr[j] * (er[j] - cr[j]), kx = ck[j] + mk[j] * (ek[j] - ck[j]), vx = cv[j] + mv[j] * (ev[j] - cv[j]);
                    const float sg = sigm(w04[j] + aw[ni][j]);
                    wq[j] = __expf(-0.6065306597f * sg);
                    const float aj = sigm(a04[j] + aa[ni][j]);
                    kq[j] = kx * kk4[j] * inv; bq[j] = kq[j] * aj;
                    kv[j] = kx * (1.f + (aj - 1.f) * ka4[j]); rv[j] = rr; vv[j] = vx;
                }
                *(f32x4*)(rec + 4 * i0) = wq; *(f32x4*)(rec + 256 + 4 * i0) = kq; *(f32x4*)(rec + 512 + 4 * i0) = bq;
                u32x4 rk; rk.x = pk2(rv[0], rv[1]); rk.y = pk2(rv[2], rv[3]); rk.z = pk2(kv[0], kv[1]); rk.w = pk2(kv[2], kv[3]);
                *(u32x4*)(rec + 768 + 4 * i0) = rk;
                u32x2 vp; vp.x = pk2(vv[0], vv[1]); vp.y = pk2(vv[2], vv[3]);
                *(u32x2*)(rec + 1024 + 2 * i0) = vp;
            }
        }
    } else
#ifdef SK_PREP_L
    if (false)
#endif
    {
        const float* ba = a.in[I_BA] + l * 256; const float* bx = a.in[I_BX] + l * 256; const float* lam = a.in[I_LAM] + l * 256;
        bf16* LA = (bf16*)(ws + WS_LA); bf16* LU = (bf16*)(ws + WS_LU);
#pragma unroll 1
        for (int nn = 0; nn < 2; ++nn) {
            const int n = (wave - 6) * 2 + nn;
            bf16x8 Wa[4][2], Wx[4][2];
#pragma unroll
            for (int ni = 0; ni < 4; ++ni) { const int d = ni * 16 + fr;
#pragma unroll
                for (int ks = 0; ks < 2; ++ks) { Wa[ni][ks] = *(const bf16x8*)(WL + WL_WA + n * 4096 + d * 64 + ks * 32 + fq * 8); Wx[ni][ks] = *(const bf16x8*)(WL + WL_WX + n * 4096 + d * 64 + ks * 32 + fq * 8); }
            }
#pragma unroll 1
            for (int mi = mi_lo; mi < mi_hi; ++mi) {
                f32x4 ar[4], ax[4];
#pragma unroll
                for (int ni = 0; ni < 4; ++ni) { ar[ni] = (f32x4){0.f, 0.f, 0.f, 0.f}; ax[ni] = ar[ni]; }
#pragma unroll
                for (int ks = 0; ks < 2; ++ks) { const bf16x8 Af = *(const LAS bf16x8*)(XC + (mi * 16 + fr) * 264 + n * 64 + ks * 32 + fq * 8);
#pragma unroll
                    for (int ni = 0; ni < 4; ++ni) { ar[ni] = __builtin_amdgcn_mfma_f32_16x16x32_bf16(Wa[ni][ks], Af, ar[ni], 0, 0, 0); ax[ni] = __builtin_amdgcn_mfma_f32_16x16x32_bf16(Wx[ni][ks], Af, ax[ni], 0, 0, 0); } }
                const int r = mi * 16 + fr, row = row0 + r;
#pragma unroll
                for (int ni = 0; ni < 4; ++ni) {
                    const int c0 = n * 64 + ni * 16 + fq * 4;
                    const f32x4 ba4 = *(const f32x4*)(ba + c0), bx4 = *(const f32x4*)(bx + c0), sp4 = *(const LAS f32x4*)(SPT + c0);
                    const u32x2 xu = *(const LAS u32x2*)(XC + r * 264 + c0);
                    const float xcv[4] = {bflo(xu.x), bfhi(xu.x), bflo(xu.y), bfhi(xu.y)};
                    float la[4], uu[4];
#pragma unroll
                    for (int j = 0; j < 4; ++j) {
                        const float rr = sigm(ar[ni][j] + ba4[j]), ii = sigm(ax[ni][j] + bx4[j]);
                        la[j] = -8.f * rr * sp4[j];
                        uu[j] = xcv[j] * ii * sqrtf(fmaxf(-expm1f(2.f * la[j]), 1e-12f));
                    }
                    u32x2 o1, o2; o1.x = pk2(la[0], la[1]); o1.y = pk2(la[2], la[3]); o2.x = pk2(uu[0], uu[1]); o2.y = pk2(uu[2], uu[3]);
                    *(u32x2*)(LA + (size_t)row * 256 + c0) = o1; *(u32x2*)(LU + (size_t)row * 256 + c0) = o2;
                }
            }
        }
    }
    __syncthreads();
}

DEV void phase_prep_old(const Args& a, int l, LAS unsigned char* lds, bool do_gelu = true) {
    const int tid = otid(), lane = tid & 63, wave = tid >> 6;
    const int gw = blockIdx.x * NWV + wave, NGW = gridDim.x * NWV;
    unsigned char* ws = a.ws;
    prep_tile_old(a, l, blockIdx.x, lds, do_gelu);
    if (blockIdx.x >= 248) { const int q = blockIdx.x - 248; prep_tile_old(a, l, 256 + (q >> 2), lds, do_gelu, q & 3, (q & 3) + 1); }
    const float* rss = (const float*)(ws + WS_RSE);
    for (int r = gw; r < 136; r += NGW) {
        const int row = r < 8 ? r * TT + TT - 1 : MP + (r - 8);
        const f32x4* src = (const f32x4*)(row < MP ? a.out + (size_t)row * DM : (const float*)(ws + WS_XS) + (size_t)(row - MP) * DM);
        f32x4* dst = (f32x4*)(r < 8 ? a.out + O_PSHIFT + (size_t)(l * 8 + r) * DM : a.out + O_SSHIFT + (size_t)(l * 128 + (r - 8)) * DM);
        const f32x4* g4 = (const f32x4*)(a.in[I_N1G] + l * DM);
        const float s = row_scale(rss, row);
#pragma unroll
        for (int j = 0; j < 4; ++j) { const f32x4 v = src[lane + 64 * j], g = g4[lane + 64 * j]; dst[lane + 64 * j] = (f32x4){v[0] * s * g[0], v[1] * s * g[1], v[2] * s * g[2], v[3] * s * g[3]}; }
    }
    if (l + 2 < 4) {
        bf16* U = (bf16*)(ws + ((l & 1) ? WS_U1 : WS_U0));
        for (int i = gw; i < 128; i += NGW) {
            const f32x4* src = (const f32x4*)(a.in[I_SSHIFT] + (size_t)((l + 2) * 128 + i) * DM);
            u32x2* ud = (u32x2*)(U + (size_t)(MREAL + i) * DM);
#pragma unroll
            for (int j = 0; j < 4; ++j) { const f32x4 v = src[lane + 64 * j]; u32x2 w; w.x = pk2(v[0], v[1]); w.y = pk2(v[2], v[3]); ud[lane + 64 * j] = w; }
        }
    }
    __syncthreads();
    LAS float* scr = (LAS float*)(lds + wave * 8448);
    if (blockIdx.x < 248) {
    const int NGW2 = 248 * NWV; int it = gw;
    transpose_job(a.in[I_WOUT] + (size_t)l * DM * DM, DM, DM, (bf16*)(ws + WS_WTOUT), it, NGW2, scr, lane);
    transpose_job(a.in[I_W1] + (size_t)l * DM * FF, DM, FF, (bf16*)(ws + WS_WT1), it, NGW2, scr, lane);
    transpose_job(a.in[I_W2] + (size_t)l * FF * DM, FF, DM, (bf16*)(ws + WS_WT2), it, NGW2, scr, lane);
    }
#ifdef DUP_TR
    if (blockIdx.x < 248) { const int NGW2 = 248 * NWV; int it = gw;
    transpose_job(a.in[I_WOUT] + (size_t)l * DM * DM, DM, DM, (bf16*)(ws + WS_WTOUT), it, NGW2, scr, lane);
    transpose_job(a.in[I_W1] + (size_t)l * DM * FF, DM, FF, (bf16*)(ws + WS_WT1), it, NGW2, scr, lane);
    transpose_job(a.in[I_W2] + (size_t)l * FF * DM, FF, DM, (bf16*)(ws + WS_WT2), it, NGW2, scr, lane);
    }
#endif
}

DEV void rwkv_scan_block(const Args& a, int l, int blk, LAS unsigned char* lds) {
    const int tid = otid(), lane = tid & 63, wave = __builtin_amdgcn_readfirstlane(tid >> 6);
    unsigned char* ws = a.ws;
    const int bh = blk >> 2, rg = blk & 3;
    const unsigned char* recbase = ws + WS_SCAN + (size_t)bh * TT * REC;
    constexpr int CH = 32, CHB = CH * REC, NCH = TT / CH;
    const int lt = tid - 256;
    u32x4 ra[9], rb[9];
#define RW_LOAD(dst, chunk) do { const u32x4* src_ = (const u32x4*)(recbase + (size_t)(chunk) * CHB); _Pragma("unroll") for (int q = 0; q < 9; ++q) dst[q] = src_[lt + 256 * q]; } while (0)
#define RW_STORE(srcv, buf) do { LAS unsigned char* d_ = lds + (buf) * CHB; _Pragma("unroll") for (int q = 0; q < 9; ++q) *(LAS u32x4*)(d_ + (lt + 256 * q) * 16) = srcv[q]; } while (0)
    if (wave >= 4) { RW_LOAD(ra, 0); RW_LOAD(rb, 1); RW_STORE(ra, 0); RW_LOAD(ra, 2); }
    __syncthreads();
    const int g = lane >> 4, j = lane & 15, rowv = rg * 16 + (wave & 3) * 4 + g;
    float S0 = 0.f, S1 = 0.f, S2 = 0.f, S3 = 0.f, keep = 0.f;
    bf16* outr = (bf16*)(ws + WS_OUTR) + (size_t)(bh * 64 + rowv) * TT;
#define RW_LD(W, K, B, RK, V, tl) do { const LAS unsigned char* rec_ = buf + (tl) * REC; W = *(const LAS f32x4*)(rec_ + 16 * j); K = *(const LAS f32x4*)(rec_ + 256 + 16 * j); \
        B = *(const LAS f32x4*)(rec_ + 512 + 16 * j); RK = *(const LAS u32x4*)(rec_ + 768 + 16 * j); V = *(const LAS unsigned short*)(rec_ + 1024 + 2 * rowv); } while (0)
#define RW_SCAN(c) do { const LAS unsigned char* buf = lds + ((c) & 1) * CHB; \
        f32x4 w4, k4, b4, nw, nk, nb; u32x4 rk, nrk; unsigned short vs, nvs; \
        RW_LD(w4, k4, b4, rk, vs, 0); nw = w4; nk = k4; nb = b4; nrk = rk; nvs = vs; \
        _Pragma("unroll 16") for (int tl = 0; tl < CH; ++tl) { \
            if (tl + 1 < CH) RW_LD(nw, nk, nb, nrk, nvs, tl + 1); \
            const float vv = bf2f(vs); \
            float sa = (S0 * k4[0] + S1 * k4[1]) + (S2 * k4[2] + S3 * k4[3]); \
            sa = -red16(sa); \
            S0 = S0 * w4[0] + (sa * b4[0] + vv * bflo(rk.z)); S1 = S1 * w4[1] + (sa * b4[1] + vv * bfhi(rk.z)); \
            S2 = S2 * w4[2] + (sa * b4[2] + vv * bflo(rk.w)); S3 = S3 * w4[3] + (sa * b4[3] + vv * bfhi(rk.w)); \
            float o = (S0 * bflo(rk.x) + S1 * bfhi(rk.x)) + (S2 * bflo(rk.y) + S3 * bfhi(rk.y)); \
            o = red16(o); \
            if (j == (tl & 15)) keep = o; \
            if ((tl & 15) == 15) outr[(c) * CH + (tl - 15) + j] = f2bf(keep); \
            w4 = nw; k4 = nk; b4 = nb; rk = nrk; vs = nvs; } } while (0)
#pragma unroll 1
    for (int c = 0; c < NCH; c += 2) {
        if (wave >= 4) { RW_STORE(rb, 1); if (c + 3 < NCH) RW_LOAD(rb, c + 3); }
        else RW_SCAN(c);
        __syncthreads();
        if (wave >= 4) { if (c + 2 < NCH) { RW_STORE(ra, 0); if (c + 4 < NCH) RW_LOAD(ra, c + 4); } }
        else RW_SCAN(c + 1);
        __syncthreads();
    }
#undef RW_LOAD
#undef RW_STORE
#undef RW_SCAN
#undef RW_LD
    if (wave < 4) { float* so = a.out + O_PWKV + ((size_t)(l * 48 + bh) * 64 + rowv) * 64 + 4 * j; *(f32x4*)so = (f32x4){S0, S1, S2, S3}; }
}

DEV void hgrn_scan_block(const Args& a, int l, int bh, LAS unsigned char* lds) {
    const int tid = otid(), lane = tid & 63, wave = __builtin_amdgcn_readfirstlane(tid >> 6);
    unsigned char* ws = a.ws;
    const int b = bh / 6, h = bh % 6;
    const bf16* P = (const bf16*)(ws + WS_P);
    bf16* mix = (bf16*)(ws + (((l + 1) & 1) ? WS_U1 : WS_U0));
    constexpr int PT = 72, ARR = 64 * PT * 2;
    LAS bf16* Qm = (LAS bf16*)lds; LAS bf16* Km = Qm + 64 * PT; LAS bf16* Qb = Km + 64 * PT; LAS bf16* KbT = Qb + 64 * PT; LAS bf16* VT = KbT + 64 * PT;
    LAS bf16* AT = VT + 64 * PT; LAS bf16* ST0 = AT + 64 * PT;
    LAS float* O = (LAS float*)(lds + 8 * ARR);
    LAS float* GT = O + 4096;
    LAS float* EB = GT + 512;
    const int k = lane, tg = wave;
    const float lb = ((const float*)(ws + WS_LBT))[l * 384 + h * 64 + k];
    const float ng = a.in[I_HNG][l * 384 + h * 64 + lane];
    const int fr = lane & 15, fq = lane >> 4;
    f32x4 Sacc[2];
    Sacc[0] = (f32x4){0.f, 0.f, 0.f, 0.f}; Sacc[1] = Sacc[0];
    {
        for (int i = tid; i < 64 * PT / 2; i += NT) ((LAS unsigned*)ST0)[i] = 0u;
    }
    __syncthreads();
#define HG_BAR() asm volatile("s_waitcnt lgkmcnt(0)\n\ts_barrier" ::: "memory")
    unsigned short nq[8], nf[8], nv[8], ngt[8];
#define HG_PREF(chunk) do { _Pragma("unroll") for (int i = 0; i < 8; ++i) { const bf16* pr_ = P + (size_t)(b * TT + (chunk) * 64 + tg * 8 + i) * NP + 1408 + h * 64 + k; \
        nq[i] = pr_[0]; nf[i] = pr_[384]; nv[i] = pr_[768]; ngt[i] = pr_[1152]; } } while (0)
    HG_PREF(0);
#pragma unroll 1
    for (int c = 0; c < TT / 64; ++c) {
        const int rowc = b * TT + c * 64;
        LAS bf16* STr = ST0 + (c & 1) * 64 * PT; LAS bf16* STw = ST0 + ((c + 1) & 1) * 64 * PT;
        float q[8], kin[8], cs[8], iv[8], gcur[8];
#pragma unroll
        for (int i = 0; i < 8; ++i) {
            q[i] = bf2f(nq[i]); const float fp = bf2f(nf[i]); iv[i] = bf2f(nv[i]); gcur[i] = bf2f(ngt[i]);
            const float sg = sigm(fp); kin[i] = (1.f - lb) * sigm(-fp); const float f = lb + (1.f - lb) * sg;
            cs[i] = __logf(f) + (i ? cs[i - 1] : 0.f); }
        if (c + 1 < TT / 64) HG_PREF(c + 1);
        GT[tg * 64 + k] = cs[7];
        HG_BAR();
        float off = 0.f, m = 0.f, bl = 0.f;
#pragma unroll
        for (int g2 = 0; g2 < 8; ++g2) { const float gv = GT[g2 * 64 + k]; if (g2 < tg) off += gv; if (g2 < 4) m += gv; bl += gv; }
        if (tg == 0) EB[k] = __expf(bl);
        {
            unsigned kb8[8], vt8[8];
#pragma unroll
            for (int i = 0; i < 8; ++i) { const int t = tg * 8 + i; const float bb = off + cs[i];
                Qm[t * PT + k] = f2bf(q[i] * __expf(bb - m)); Km[t * PT + k] = f2bf(kin[i] * __expf(m - bb)); Qb[t * PT + k] = f2bf(q[i] * __expf(bb));
                kb8[i] = f2bf(kin[i] * __expf(bl - bb)); vt8[i] = f2bf(iv[i]); }
            u32x4 w1, w2; w1.x = kb8[0] | (kb8[1] << 16); w1.y = kb8[2] | (kb8[3] << 16); w1.z = kb8[4] | (kb8[5] << 16); w1.w = kb8[6] | (kb8[7] << 16);
            w2.x = vt8[0] | (vt8[1] << 16); w2.y = vt8[2] | (vt8[3] << 16); w2.z = vt8[4] | (vt8[5] << 16); w2.w = vt8[6] | (vt8[7] << 16);
            *(LAS u32x4*)(KbT + k * PT + tg * 8) = w1; *(LAS u32x4*)(VT + k * PT + tg * 8) = w2;
        }
        HG_BAR();
        {
            const int tr = wave >> 1;
#pragma unroll
            for (int i = 0; i < 2; ++i) { const int sc = (wave & 1) * 2 + i;
                f32x4 acc = (f32x4){0.f, 0.f, 0.f, 0.f};
                if (sc <= tr) {
#pragma unroll
                    for (int ks = 0; ks < 2; ++ks) { const bf16x8 af = *(const LAS bf16x8*)(Km + (sc * 16 + fr) * PT + ks * 32 + fq * 8), bfr = *(const LAS bf16x8*)(Qm + (tr * 16 + fr) * PT + ks * 32 + fq * 8);
                        acc = __builtin_amdgcn_mfma_f32_16x16x32_bf16(af, bfr, acc, 0, 0, 0); }
                }
                const int t = tr * 16 + fr, s0 = sc * 16 + fq * 4;
                u32x2 w; w.x = pk2(s0 <= t ? acc[0] : 0.f, s0 + 1 <= t ? acc[1] : 0.f); w.y = pk2(s0 + 2 <= t ? acc[2] : 0.f, s0 + 3 <= t ? acc[3] : 0.f);
                *(LAS u32x2*)(AT + t * PT + s0) = w; }
        }
        HG_BAR();
        {
            const int tr = wave >> 1, kb = wave >> 1;
#pragma unroll
            for (int i = 0; i < 2; ++i) { const int vb = (wave & 1) * 2 + i;
                f32x4 acc = (f32x4){0.f, 0.f, 0.f, 0.f};
#pragma unroll
                for (int ks = 0; ks < 2; ++ks) {
                    if (ks * 2 <= tr) { const bf16x8 af = *(const LAS bf16x8*)(VT + (vb * 16 + fr) * PT + ks * 32 + fq * 8), bfr = *(const LAS bf16x8*)(AT + (tr * 16 + fr) * PT + ks * 32 + fq * 8);
                        acc = __builtin_amdgcn_mfma_f32_16x16x32_bf16(af, bfr, acc, 0, 0, 0); }
                    const bf16x8 a2 = *(const LAS bf16x8*)(STr + (vb * 16 + fr) * PT + ks * 32 + fq * 8), b2 = *(const LAS bf16x8*)(Qb + (tr * 16 + fr) * PT + ks * 32 + fq * 8);
                    acc = __builtin_amdgcn_mfma_f32_16x16x32_bf16(a2, b2, acc, 0, 0, 0); }
                *(LAS f32x4*)(O + (tr * 16 + fr) * 64 + vb * 16 + fq * 4) = acc;
                f32x4 kv = (f32x4){0.f, 0.f, 0.f, 0.f};
#pragma unroll
                for (int ks = 0; ks < 2; ++ks) { const bf16x8 af = *(const LAS bf16x8*)(KbT + (kb * 16 + fr) * PT + ks * 32 + fq * 8), bfr = *(const LAS bf16x8*)(VT + (vb * 16 + fr) * PT + ks * 32 + fq * 8);
                    kv = __builtin_amdgcn_mfma_f32_16x16x32_bf16(af, bfr, kv, 0, 0, 0); }
                const f32x4 eb = *(const LAS f32x4*)(EB + kb * 16 + fq * 4);
                Sacc[i][0] = eb[0] * Sacc[i][0] + kv[0]; Sacc[i][1] = eb[1] * Sacc[i][1] + kv[1]; Sacc[i][2] = eb[2] * Sacc[i][2] + kv[2]; Sacc[i][3] = eb[3] * Sacc[i][3] + kv[3];
                u32x2 w; w.x = pk2(Sacc[i][0], Sacc[i][1]); w.y = pk2(Sacc[i][2], Sacc[i][3]);
                *(LAS u32x2*)(STw + (vb * 16 + fr) * PT + kb * 16 + fq * 4) = w; }
        }
        HG_BAR();
#pragma unroll
        for (int itx = 0; itx < 8; ++itx) { const int t = wave * 8 + itx, row = rowc + t;
            const float o = O[t * 64 + lane];
            const float ss = wave_sum(o * o);
            const float gte = gcur[itx];
            mix[(size_t)row * DM + 384 + h * 64 + lane] = f2bf(o * rsqrtf(ss * (1.f / 64.f) + EPS) * ng * (gte * sigm(gte))); }
    }
#undef HG_BAR
#undef HG_PREF
    {
        const int kb = wave >> 1;
#pragma unroll
        for (int i = 0; i < 2; ++i) { const int vb = (wave & 1) * 2 + i;
            float* so = a.out + O_PHGRN + ((size_t)(l * 48 + bh) * 64 + kb * 16 + fq * 4) * 64 + vb * 16 + fr;
            so[0] = Sacc[i][0]; so[64] = Sacc[i][1]; so[128] = Sacc[i][2]; so[192] = Sacc[i][3]; }
    }
}

DEV void lru_scan_block(const Args& a, int l, int i, LAS unsigned char* lds) {
    const int tid = otid();
    unsigned char* ws = a.ws;
    const int b = i >> 1, cb = (i & 1) * 128;
    const bf16* P = (const bf16*)(ws + WS_P); const bf16* LA = (const bf16*)(ws + WS_LA); const bf16* LU = (const bf16*)(ws + WS_LU);
    bf16* mix = (bf16*)(ws + (((l + 1) & 1) ? WS_U1 : WS_U0));
    constexpr int TILE = 64 * 128 * 2;
    u32x4 rg[6];
#define LRU_LOAD(tile) do { _Pragma("unroll") for (int q = 0; q < 2; ++q) { const int p = tid + 512 * q; const size_t row = (size_t)b * TT + (tile) * 64 + (p >> 4); const int cc = cb + (p & 15) * 8; \
        rg[q] = *(const u32x4*)(LA + row * 256 + cc); rg[2 + q] = *(const u32x4*)(LU + row * 256 + cc); rg[4 + q] = *(const u32x4*)(P + row * NP + 3200 + cc); } } while (0)
#define LRU_STORE(buf) do { _Pragma("unroll") for (int q = 0; q < 2; ++q) { const int p = tid + 512 * q; \
        *(LAS u32x4*)(lds + (buf) * 3 * TILE + p * 16) = rg[q]; *(LAS u32x4*)(lds + (buf) * 3 * TILE + TILE + p * 16) = rg[2 + q]; { float g8_[8]; unpack8(rg[4 + q], g8_); _Pragma("unroll") for (int e_ = 0; e_ < 8; ++e_) g8_[e_] = gelu_t(g8_[e_]); u32x4 gw_; gw_.x = pk2(g8_[0], g8_[1]); gw_.y = pk2(g8_[2], g8_[3]); gw_.z = pk2(g8_[4], g8_[5]); gw_.w = pk2(g8_[6], g8_[7]); \
          *(LAS u32x4*)(lds + (buf) * 3 * TILE + 2 * TILE + p * 16) = gw_; } } } while (0)
    LRU_LOAD(0); LRU_STORE(0);
    __syncthreads();
    float h = 0.f;
#pragma unroll 1
    for (int tile = 0; tile < TT / 64; ++tile) {
        if (tile + 1 < TT / 64) LRU_LOAD(tile + 1);
        if (tid < 128) {
            const LAS unsigned short* la = (const LAS unsigned short*)(lds + (tile & 1) * 3 * TILE) + tid; const LAS unsigned short* lu = la + TILE / 2; const LAS unsigned short* gg = lu + TILE / 2;
            bf16* mo = mix + ((size_t)b * TT + tile * 64) * DM + 768 + cb + tid;
#pragma unroll 8
            for (int t = 0; t < 64; ++t) { h = __expf(bf2f(la[t * 128])) * h + bf2f(lu[t * 128]); mo[(size_t)t * DM] = f2bf(h * bf2f(gg[t * 128])); }
        }
        if (tile + 1 < TT / 64) LRU_STORE((tile + 1) & 1);
        __syncthreads();
    }
#undef LRU_LOAD
#undef LRU_STORE
    if (tid < 128) a.out[O_PLRU + (size_t)(l * 8 + b) * 256 + cb + tid] = h;
}

DEV void phase_post(const Args& a, int l, LAS unsigned char* lds) {
    const int tid = otid(), lane = tid & 63, wave = __builtin_amdgcn_readfirstlane(tid >> 6);
    unsigned char* ws = a.ws;
    const bf16* P = (const bf16*)(ws + WS_P); const bf16* G = (const bf16*)(ws + WS_G);
    bf16* mix = (bf16*)(ws + (((l + 1) & 1) ? WS_U1 : WS_U0));
    LAS unsigned short* OT = (LAS unsigned short*)lds;
    const float* lnw = a.in[I_LNW] + l * 384; const float* lnb = a.in[I_LNB] + l * 384; const float* rkp = a.in[I_RK] + l * 384;
#pragma unroll 1
    for (int item = blockIdx.x; item < 1536; item += gridDim.x) {
        const int b = item / 192, rem = item % 192, h = rem >> 5, t0 = (rem & 31) * 64, bh = b * 6 + h;
        { const int v = tid >> 3, seg = tid & 7; const u32x4 u = *(const u32x4*)((const bf16*)(ws + WS_OUTR) + (size_t)(bh * 64 + v) * TT + t0 + seg * 8);
          LAS unsigned* d = (LAS unsigned*)(OT + v * 66 + seg * 8); d[0] = u.x; d[1] = u.y; d[2] = u.z; d[3] = u.w; }
        __syncthreads();
        const float w_ = lnw[h * 64 + lane], b_ = lnb[h * 64 + lane], rk_ = rkp[h * 64 + lane];
#pragma unroll 2
        for (int q = 0; q < 8; ++q) {
            const int tt = wave * 8 + q, row = b * TT + t0 + tt;
            const float o = bf2f(OT[lane * 66 + tt]);
            const float mean = wave_sum(o) * (1.f / 64.f), d = o - mean, var = wave_sum(d * d) * (1.f / 64.f);
            const float gn = d * rsqrtf(var + 64e-5f) * w_ + b_;
            const unsigned char* rec = ws + WS_SCAN + ((size_t)bh * TT + t0 + tt) * REC;
            const float rr = bf2f(*(const unsigned short*)(rec + 768 + 16 * (lane >> 2) + 2 * (lane & 3))), kk = bf2f(*(const unsigned short*)(rec + 776 + 16 * (lane >> 2) + 2 * (lane & 3)));
            const float cb = wave_sum(rr * kk * rk_), vv = bf2f(*(const unsigned short*)(rec + 1024 + 2 * lane));
            const float gg = bf2f(G[(size_t)row * 384 + h * 64 + lane]);
            mix[(size_t)row * DM + h * 64 + lane] = f2bf((gn + cb * vv) * gg);
        }
        __syncthreads();
    }
    const int gw = __builtin_amdgcn_readfirstlane(blockIdx.x * NWV + wave), NGW = gridDim.x * NWV;
#pragma unroll 1
    for (int it = gw; it < 1664; it += NGW) {
        if (it < 768) {
            const int i = it / 6, h = it % 6, row = MP + i;
            const unsigned char* rec = ws + WS_SCANS + (size_t)(i * 6 + h) * REC;
            const float* s0 = a.in[I_SWKV] + ((size_t)((l * 128 + i) * 6 + h) * 64 + lane) * 64;
            float* s1 = a.out + O_SWKV + ((size_t)((l * 128 + i) * 6 + h) * 64 + lane) * 64;
            float sa = 0.f;
#pragma unroll 4
            for (int k4 = 0; k4 < 16; ++k4) { const f32x4 v = *(const f32x4*)(s0 + 4 * k4), kq = *(const f32x4*)(rec + 256 + 16 * k4);
                sa -= (v[0] * kq[0] + v[1] * kq[1]) + (v[2] * kq[2] + v[3] * kq[3]); }
            const float vv = bf2f(*(const unsigned short*)(rec + 1024 + 2 * lane));
            float o = 0.f, cb = 0.f;
#pragma unroll 4
            for (int k4 = 0; k4 < 16; ++k4) {
                f32x4 v = *(const f32x4*)(s0 + 4 * k4); const f32x4 w = *(const f32x4*)(rec + 16 * k4), bb = *(const f32x4*)(rec + 512 + 16 * k4), rk4 = *(const f32x4*)(rkp + h * 64 + 4 * k4);
                const u32x4 rk = *(const u32x4*)(rec + 768 + 16 * k4);
                const float rr[4] = {bflo(rk.x), bfhi(rk.x), bflo(rk.y), bfhi(rk.y)}, kx[4] = {bflo(rk.z), bfhi(rk.z), bflo(rk.w), bfhi(rk.w)};
#pragma unroll
                for (int e = 0; e < 4; ++e) { v[e] = v[e] * w[e] + (sa * bb[e] + vv * kx[e]); o += v[e] * rr[e]; cb += rr[e] * kx[e] * rk4[e]; }
                *(f32x4*)(s1 + 4 * k4) = v; }
            const float mean = wave_sum(o) * (1.f / 64.f), d = o - mean, var = wave_sum(d * d) * (1.f / 64.f);
            const float gn = d * rsqrtf(var + 64e-5f) * lnw[h * 64 + lane] + lnb[h * 64 + lane];
            const float gg = bf2f(G[(size_t)row * 384 + h * 64 + lane]);
            mix[(size_t)row * DM + h * 64 + lane] = f2bf((gn + cb * vv) * gg);
        } else if (it < 1536) {
            const int i = (it - 768) / 6, h = (it - 768) % 6, row = MP + i;
            const bf16* pr = P + (size_t)row * NP + 1408 + h * 64;
            const float* s0 = a.in[I_SHGRN] + (size_t)((l * 128 + i) * 6 + h) * 4096 + lane;
            float* s1 = a.out + O_SHGRN + (size_t)((l * 128 + i) * 6 + h) * 4096 + lane;
            const float* lbt = (const float*)(ws + WS_LBT) + l * 384 + h * 64;
            const float iv = bf2f(pr[768 + lane]); float o = 0.f;
#pragma unroll 8
            for (int k = 0; k < 64; ++k) { const float q = bf2f(pr[k]), fp = bf2f(pr[384 + k]), lb = lbt[k];
                const float f = lb + (1.f - lb) * sigm(fp), ki = (1.f - lb) * sigm(-fp);
                const float s = f * s0[k * 64] + ki * iv; s1[k * 64] = s; o += q * s; }
            const float ss = wave_sum(o * o), gte = bf2f(pr[1152 + lane]);
            mix[(size_t)row * DM + 384 + h * 64 + lane] = f2bf(o * rsqrtf(ss * (1.f / 64.f) + EPS) * a.in[I_HNG][l * 384 + h * 64 + lane] * (gte * sigm(gte)));
        } else {
            const int i = it - 1536, row = MP + i;
#pragma unroll
            for (int q = 0; q < 4; ++q) { const int c = lane + 64 * q;
                const float la = bf2f(((const bf16*)(ws + WS_LA))[(size_t)row * 256 + c]), u = bf2f(((const bf16*)(ws + WS_LU))[(size_t)row * 256 + c]);
                const float hh = __expf(la) * a.in[I_SLRU][(size_t)(l * 128 + i) * 256 + c] + u;
                a.out[O_SLRU + (size_t)(l * 128 + i) * 256 + c] = hh;
                mix[(size_t)row * DM + 768 + c] = f2bf(hh * gelu_t(bf2f(P[(size_t)row * NP + 3200 + c]))); }
        }
    }
    if (l + 1 < 4) {
        __syncthreads();
        LAS float* scr = (LAS float*)(lds + wave * 8448);
        int it = gw;
        transpose_job(a.in[I_WIN] + (size_t)(l + 1) * DM * 3456, DM, 3456, (bf16*)(ws + WS_WTIN), it, NGW, scr, lane);
    }
}

DEV void phase_final(const Args& a) {
    const int tid = otid(), lane = tid & 63, wave = tid >> 6;
    const int gw = blockIdx.x * NWV + wave, NGW = gridDim.x * NWV;
    const float* rss = (const float*)(a.ws + WS_RSE);
    const f32x4* g4 = (const f32x4*)a.in[I_FG];
    for (int row = gw; row < MREAL; row += NGW) {
        const f32x4* src = (const f32x4*)(row < MP ? a.out + (size_t)row * DM : (const float*)(a.ws + WS_XS) + (size_t)(row - MP) * DM);
        f32x4* dst = (f32x4*)(a.out + (size_t)row * DM);
        const float s = row_scale(rss, row);
#pragma unroll
        for (int j = 0; j < 4; ++j) { const f32x4 v = src[lane + 64 * j], g = g4[lane + 64 * j]; dst[lane + 64 * j] = (f32x4){v[0] * s * g[0], v[1] * s * g[1], v[2] * s * g[2], v[3] * s * g[3]}; }
    }
}

constexpr size_t WS_PART = 232 * MiB;
struct EpiPart {
    static constexpr bool PERM = false, AFTER_DRAIN = false;
    float* O;
    DEV void operator()(const pg8::f32x4 (&acc)[2][2][4][2], const pg8::Unit& u, int wr, int wc, int fr, int fq) const {
        const int col0 = u.pn * 256 + wc * 32 + 4 * fq;
#pragma unroll
        for (int m = 0; m < 4; ++m) { const int row = wr * 64 + fr + m * 16;
            float* rp_ = O + (size_t)row * DM + col0;
#pragma unroll
            for (int bj = 0; bj < 2; ++bj)
#pragma unroll
                for (int n = 0; n < 2; ++n) { const pg8::f32x4 v = acc[0][bj][m][n]; *(f32x4*)(rp_ + bj * 128 + n * 16) = (f32x4){v[0], v[1], v[2], v[3]}; } }
    }
};
struct OneUnit {
    int pn;
    DEV bool next(int i, pg8::Unit& u) const { if (i) return false; u.pm = 0; u.pn = pn; return true; }
    DEV void a_ready(const pg8::Unit&) const {}
    DEV void done(const pg8::Unit&) const {}
};
DEV void phase_sample_reduce(const Args& a, bf16* U, const float* g, float* rs) {
    const int tid = otid(), lane = tid & 63, wave = tid >> 6;
    const int gw = blockIdx.x * NWV + wave;
    if (gw >= 128) return;
    const float* part = (const float*)(a.ws + WS_PART);
    f32x4* xr = (f32x4*)((float*)(a.ws + WS_XS) + (size_t)gw * DM);
    u32x2* ud = (u32x2*)(U + (size_t)(MP + gw) * DM);
    const f32x4* g4 = (const f32x4*)g;
    float ss = 0.f;
#pragma unroll
    for (int j = 0; j < 4; ++j) { const int o = lane + 64 * j;
        f32x4 x = xr[o];
        const f32x4 p0 = ((const f32x4*)(part + (size_t)(0 * 128 + gw) * DM))[o], p1 = ((const f32x4*)(part + (size_t)(1 * 128 + gw) * DM))[o],
                    p2 = ((const f32x4*)(part + (size_t)(2 * 128 + gw) * DM))[o], p3 = ((const f32x4*)(part + (size_t)(3 * 128 + gw) * DM))[o];
#pragma unroll
        for (int e = 0; e < 4; ++e) x[e] += (p0[e] + p1[e]) + (p2[e] + p3[e]);
        xr[o] = x; ss += (x[0] * x[0] + x[1] * x[1]) + (x[2] * x[2] + x[3] * x[3]);
        const f32x4 gv = g4[o]; u32x2 w; w.x = pk2(x[0] * gv[0], x[1] * gv[1]); w.y = pk2(x[2] * gv[2], x[3] * gv[3]); ud[o] = w; }
    ss = wave_sum(ss);
    if (lane < 16) rs[(size_t)(MP + gw) * 16 + lane] = lane == 0 ? ss : 0.f;
}

#define XB_TMO      128
#define XB_XCNT(j)  (256  + 64 * (j))
#define XB_XSUB(j)  (1280 + 64 * (j))
#define XB_XGEN(j)  (2304 + 64 * (j))
#define XB_TOP      3328
#define XB_TOPGEN   3392
#define XCD_BAR_WORDS 3456
#define XB_SPIN_CAP (1u << 22)

__device__ __forceinline__ unsigned xb_ld(unsigned* p)              { return __hip_atomic_load(p, __ATOMIC_RELAXED, __HIP_MEMORY_SCOPE_AGENT); }
__device__ __forceinline__ unsigned xb_add(unsigned* p, unsigned v) { return __hip_atomic_fetch_add(p, v, __ATOMIC_RELAXED, __HIP_MEMORY_SCOPE_AGENT); }
__device__ __forceinline__ unsigned xb_xcc_id() { return (unsigned)__builtin_amdgcn_s_getreg((3 << 11) | 20) & 0xFu; }
#define XB_SPIN(cond, bar) do { unsigned _sp = 0; while (cond) { __builtin_amdgcn_s_sleep(1); \
    if ((++_sp & 255u) == 0u) { if (xb_ld(&(bar)[XB_TMO])) break; if (_sp > XB_SPIN_CAP) { atomicAdd(&(bar)[XB_TMO], 1u); break; } } } } while (0)

struct XcdBarrier {
    unsigned* bar; unsigned x;
    volatile LAS unsigned* st;
};

__device__ __forceinline__ XcdBarrier xcd_barrier_post(unsigned* bar, volatile LAS unsigned* st) {
    XcdBarrier b; b.bar = bar; b.x = xb_xcc_id(); b.st = st;
    if (threadIdx.x == 0) (void)xb_add(&bar[XB_XCNT(b.x)], 1u);
    return b;
}
__device__ __forceinline__ void xcd_barrier_complete(unsigned* bar, unsigned x, unsigned& nloc, unsigned& nx) {
    const unsigned G = gridDim.x * gridDim.y * gridDim.z;
    unsigned sum, cnt, mine, sp = 0u;
    for (;;) {
        sum = 0u; cnt = 0u; mine = 0u;
#pragma unroll
        for (unsigned j = 0; j < 16; ++j) { const unsigned c = xb_ld(&bar[XB_XCNT(j)]); sum += c; cnt += (c > 0u) ? 1u : 0u; mine = (j == x) ? c : mine; }
        if (sum == G) break;
        __builtin_amdgcn_s_sleep(1);
        if ((++sp & 255u) == 0u) { if (xb_ld(&bar[XB_TMO])) break; if (sp > XB_SPIN_CAP) { atomicAdd(&bar[XB_TMO], 1u); break; } }
    }
    nloc = mine > 0u ? mine : 1u; nx = cnt > 0u ? cnt : 1u;
}

__device__ __forceinline__ void xcd_barrier(const XcdBarrier& b) {
    asm volatile("s_waitcnt vmcnt(0)" ::: "memory");
    __syncthreads();
    if (otid() == 0) {
        unsigned* bar = b.bar;
        __builtin_amdgcn_s_waitcnt(0);
        unsigned nloc = b.st[0], nx = b.st[1];
        if (nloc == 0u) { xcd_barrier_complete(bar, b.x, nloc, nx); b.st[0] = nloc; b.st[1] = nx; }
        const unsigned old = xb_add(&bar[XB_XSUB(b.x)], 1u);
        const unsigned gen = old / nloc;
        if (old + 1u == (gen + 1u) * nloc) {
            __builtin_amdgcn_fence(__ATOMIC_RELEASE, "agent");
            asm volatile("s_waitcnt vmcnt(0)" ::: "memory");
            const unsigned og = xb_add(&bar[XB_TOP], 1u);
            const unsigned tg = og / nx;
            if (og + 1u == (tg + 1u) * nx) xb_add(&bar[XB_TOPGEN], 1u);
            else XB_SPIN(xb_ld(&bar[XB_TOPGEN]) == tg, bar);
            __builtin_amdgcn_fence(__ATOMIC_ACQUIRE, "agent");
            xb_add(&bar[XB_XGEN(b.x)], 1u);
            asm volatile("s_waitcnt vmcnt(0)" ::: "memory");
        } else {
            XB_SPIN(xb_ld(&bar[XB_XGEN(b.x)]) == gen, bar);
            __builtin_amdgcn_fence(__ATOMIC_ACQUIRE, "agent");
            asm volatile("s_waitcnt vmcnt(0)" ::: "memory");
        }
    }
    __syncthreads();
}

__global__ void __launch_bounds__(NT, 2) mega_fwd(Args a) {
    extern __shared__ __attribute__((aligned(16))) unsigned char lds_raw[];
    LAS unsigned char* lds = (LAS unsigned char*)lds_raw;
    cg::grid_group grid = cg::this_grid();
    volatile LAS unsigned* st = (volatile LAS unsigned*)(lds + LDS_BYTES - 16);
    if (threadIdx.x < 4) st[threadIdx.x] = 0u;
    __syncthreads();
    { const XcdBarrier b0 = xcd_barrier_post((unsigned*)(a.ws + WS_BAR), st); if (threadIdx.x == 0) st[2] = b0.x; }
#define GRID_BAR() do { XcdBarrier b_; b_.bar = (unsigned*)(a.ws + WS_BAR); b_.st = (volatile LAS unsigned*)(lds + LDS_BYTES - 16); b_.x = otid() == 0 ? b_.st[2] : 0u; xcd_barrier(b_); } while (0)
    grid.sync();
#ifndef SK_P0
    phase0(a, lds);
#endif
    GRID_BAR();
#pragma unroll 1
    for (int l = 0; l < 4; ++l) {
#define Ua ((bf16*)(a.ws + ((l & 1) ? WS_U1 : WS_U0)))
#define Ub ((bf16*)(a.ws + ((l & 1) ? WS_U0 : WS_U1)))
#define rse ((float*)(a.ws + WS_RSE))
#define rso ((float*)(a.ws + WS_RSO))
        {
            pg8::Gemm g{Ua, (const bf16*)(a.ws + WS_WTIN), MT, NP, DM}; pg8::StaticOrder S; S.init(MT, NP, gridDim.x, oblk());
            EpiP E{(bf16*)(a.ws + WS_P), rse};
#ifndef SK_G1
            pg8::gemm_phase<EpiP, pg8::StaticOrder, true, true>(lds, g, S, E);
#ifdef DUP_G1
            GRID_BAR(); pg8::gemm_phase<EpiP, pg8::StaticOrder, true, true>(lds, g, S, E);
#endif
#endif
        }
        GRID_BAR();
#ifndef SK_PREP
#ifdef OLD_FIRST
        phase_prep_old(a, l, lds); GRID_BAR();
#endif
#ifdef ONLY_OLD
        phase_prep_old(a, l, lds);
#else
        phase_prep(a, l, lds);
#endif
#ifdef OLD_AFTER
        GRID_BAR(); phase_prep_old(a, l, lds);
#endif
#ifdef DUP_PREP
        GRID_BAR(); phase_prep(a, l, lds, false);
#endif
#endif
        GRID_BAR();
#ifndef SK_RWKV
        if (oblk() < 192) rwkv_scan_block(a, l, oblk(), lds);
#endif
#ifndef SK_HGRN
        if (oblk() >= 192 && oblk() < 240) hgrn_scan_block(a, l, oblk() - 192, lds);
#endif
#ifndef SK_LRU
        if (oblk() >= 240) lru_scan_block(a, l, oblk() - 240, lds);
#endif
#ifdef DUP_RWKV
        GRID_BAR(); if (oblk() < 192) rwkv_scan_block(a, l, oblk(), lds);
#endif
#ifdef DUP_HGRN
        GRID_BAR(); if (oblk() >= 192 && oblk() < 240) hgrn_scan_block(a, l, oblk() - 192, lds);
#endif
#ifdef DUP_LRU
        GRID_BAR(); if (oblk() >= 240) lru_scan_block(a, l, oblk() - 240, lds);
#endif
        GRID_BAR();
#ifndef SK_POST
        phase_post(a, l, lds);
#ifdef DUP_POST
        GRID_BAR(); phase_post(a, l, lds);
#endif
#endif
        GRID_BAR();
        {
            pg8::Gemm g{Ub, (const bf16*)(a.ws + WS_WTOUT), MP, DM, DM}; pg8::StaticOrder S; S.init(MP, DM, gridDim.x, oblk());
            EpiX E{a.out, (float*)(a.ws + WS_XS), Ua, a.in[I_N2G] + l * DM, rso};
#ifndef SK_GX
            pg8::gemm_phase<EpiX, pg8::StaticOrder, true, true, 64>(lds, g, S, E);
#endif
            if (oblk() < 16) {
                const int ks = oblk() >> 2;
                pg8::Gemm g2{Ub + (size_t)MP * DM + ks * 256, (const bf16*)(a.ws + WS_WTOUT) + ks * 256, 256, DM, 256, DM};
                OneUnit S2{oblk() & 3}; EpiPart E2{(float*)(a.ws + WS_PART) + (size_t)ks * 128 * DM};
                pg8::gemm_phase<EpiPart, OneUnit, true, true, 0>(lds, g2, S2, E2);
            }
        }
        GRID_BAR();
        phase_sample_reduce(a, Ua, a.in[I_N2G] + l * DM, rso);
        GRID_BAR();
        {
            pg8::Gemm g{Ua, (const bf16*)(a.ws + WS_WT1), MT, FF, DM}; pg8::StaticOrder S; S.init(MT, FF, gridDim.x, oblk());
            EpiH E{(bf16*)(a.ws + WS_H), rso};
#ifndef SK_G6
            pg8::gemm_phase<EpiH, pg8::StaticOrder, true, true, 64>(lds, g, S, E);
#ifdef DUP_G6
            GRID_BAR(); pg8::gemm_phase<EpiH, pg8::StaticOrder, true, true, 64>(lds, g, S, E);
#endif
#endif
        }
        GRID_BAR();
        {
            pg8::Gemm g{(const bf16*)(a.ws + WS_H), (const bf16*)(a.ws + WS_WT2), MP, DM, FF}; pg8::StaticOrder S; S.init(MP, DM, gridDim.x, oblk());
            EpiX E{a.out, (float*)(a.ws + WS_XS), Ub, l < 3 ? a.in[I_N1G] + (l + 1) * DM : a.in[I_FG], rse};
#ifndef SK_GX
            pg8::gemm_phase<EpiX, pg8::StaticOrder, true, true, 64>(lds, g, S, E);
#endif
            if (oblk() < 16) {
                const int ks = oblk() >> 2;
                pg8::Gemm g2{(const bf16*)(a.ws + WS_H) + (size_t)MP * FF + ks * 1024, (const bf16*)(a.ws + WS_WT2) + ks * 1024, 256, DM, 1024, FF};
                OneUnit S2{oblk() & 3}; EpiPart E2{(float*)(a.ws + WS_PART) + (size_t)ks * 128 * DM};
                pg8::gemm_phase<EpiPart, OneUnit, true, true, 0>(lds, g2, S2, E2);
            }
        }
        GRID_BAR();
        phase_sample_reduce(a, Ub, l < 3 ? a.in[I_N1G] + (l + 1) * DM : a.in[I_FG], rse);
        GRID_BAR();
    }
    phase_final(a);
}

extern "C" void kernel_launch(void* const* d_in, const int* in_sizes, int n_in, void* d_out, int out_size, void* d_ws, size_t ws_size, hipStream_t stream) {
    static int grid = 0;
    if (grid == 0) {
        int dev = 0, cus = 0;
        if (n_in != N_IN || ws_size < WS_END || out_size != 44761088) { fprintf(stderr, "kernel_launch: unexpected problem: n_in %d ws %zu (need %zu) out %d\n", n_in, ws_size, (size_t)WS_END, out_size); grid = -1; return; }
        if (hipGetDevice(&dev) != hipSuccess || hipDeviceGetAttribute(&cus, hipDeviceAttributeMultiprocessorCount, dev) != hipSuccess) { grid = -1; return; }
        if (hipFuncSetAttribute((const void*)mega_fwd, hipFuncAttributeMaxDynamicSharedMemorySize, LDS_BYTES) != hipSuccess) { fprintf(stderr, "kernel_launch: hipFuncSetAttribute failed\n"); grid = -1; return; }
        if (cus != 256) fprintf(stderr, "kernel_launch: %d CUs (built for 256)\n", cus);
        grid = 256;
    }
    if (grid < 0) return;
#ifdef DBG_POISON
    (void)hipMemsetAsync(d_ws, 0xAA, WS_END, stream); (void)hipMemsetAsync(d_out, 0xAA, (size_t)out_size * 4, stream);
#endif
    if (hipMemsetAsync((char*)d_ws + WS_BAR, 0, BAR_BYTES, stream) != hipSuccess) { fprintf(stderr, "kernel_launch: memset failed\n"); return; }
    Args a{};
    for (int i = 0; i < N_IN; ++i) a.in[i] = (const float*)d_in[i];
    a.out = (float*)d_out; a.ws = (unsigned char*)d_ws;
    void* args[] = {&a};
    hipError_t e = hipLaunchCooperativeKernel((const void*)mega_fwd, dim3(grid), dim3(NT), args, LDS_BYTES, stream);
    if (e != hipSuccess) fprintf(stderr, "kernel_launch: cooperative launch failed: %s\n", hipGetErrorString(e));
}
```
